# Optimizing an MI355X kernel written in HIP

```python
import math
import jax, jax.numpy as jnp
from jax import lax
import numpy as np

D_MODEL = 2048
BATCH = 8
SEQ = 2048
DEPTH = 4
DEC_BATCH = 32
DEC_SEQ = 64
PAST_LEN = 4096

CHUNK = 64
N_EVEN = (DEPTH + 1) // 2
N_ODD = DEPTH // 2
MLA_HEADS = 8
Q_RANK = 512
KV_RANK = 512
NOPE_DIM = 128
ROPE_DIM = 64
V_DIM = 128
ROPE_THETA = 10000.0
MLA_SCALE = (NOPE_DIM + ROPE_DIM) ** -0.5
MLA_QBLK = 128
MASK_NEG = -1e30
POOL_WINDOWS = (2, 4, 8, 16)
POOL_GROUPS = len(POOL_WINDOWS)
POOL_WIDTH = D_MODEL - MLA_HEADS * V_DIM
POOL_GROUP_DIM = POOL_WIDTH // POOL_GROUPS
POOL_KEEP = max(POOL_WINDOWS) - 1
IN_EVEN = Q_RANK + KV_RANK + ROPE_DIM + POOL_WIDTH
C_HEADS = 16
HEAD_F = 128
HEAD_I = D_MODEL // C_HEADS
C_FDIM = C_HEADS * HEAD_F
C_IDIM = C_HEADS * HEAD_I
IN_ODD = 2 * C_FDIM + 2 * C_IDIM
HGRN_BLK = 32
F_MIN = 1e-30
D_FF = 5632
CONV_W = 3
EPS = 1e-6

kernel_name = "mla_pool_hgrn2_convffn_stream_step"

F32 = jnp.float32


def rmsnorm(x, g):
    xf = x.astype(F32)
    y = xf * lax.rsqrt(jnp.mean(xf * xf, axis=-1, keepdims=True) + EPS)
    return (y * g.astype(F32)).astype(x.dtype)


def rope_angles(pos):
    inv = ROPE_THETA ** (-jnp.arange(0, ROPE_DIM, 2, dtype=F32) / ROPE_DIM)
    ang = pos.astype(F32)[:, None] * inv[None, :]
    return jnp.cos(ang), jnp.sin(ang)


def apply_rope(x, cos, sin):
    xf = x.astype(F32)
    x1, x2 = jnp.split(xf, 2, axis=-1)
    return jnp.concatenate([x1 * cos - x2 * sin, x1 * sin + x2 * cos], axis=-1).astype(x.dtype)


def mla_attend(q_lat, q_pe, lat, k_pe, q_pos, k_pos):
    s = (jnp.einsum('bqhr,bkr->bhqk', q_lat, lat) +
         jnp.einsum('bqhe,bke->bhqk', q_pe, k_pe)).astype(F32) * MLA_SCALE
    visible = (k_pos[None, :] // CHUNK) <= (q_pos[:, None] // CHUNK)
    s = jnp.where(visible[None, None], s, MASK_NEG)
    p = jax.nn.softmax(s, axis=-1).astype(lat.dtype)
    return jnp.einsum('bhqk,bkr->bqhr', p, lat)


def pool_mix(z, z_past, w_pool, pool_scale):
    B, L, C = z.shape
    ext = z if z_past is None else jnp.concatenate([z_past.astype(z.dtype), z], axis=1)
    P = ext.shape[1] - L
    cs = jnp.concatenate([jnp.zeros((B, 1, C), F32), jnp.cumsum(ext.astype(F32), axis=1)], axis=1)
    hi = np.arange(P + 1, P + L + 1)
    outs = []
    for gi, w in enumerate(POOL_WINDOWS):
        lo = np.maximum(hi - w, 0)
        sl = slice(gi * POOL_GROUP_DIM, (gi + 1) * POOL_GROUP_DIM)
        cnt = jnp.asarray(hi - lo, F32)[None, :, None]
        mean = (cs[:, hi, sl] - cs[:, lo, sl]) / cnt
        outs.append(mean - z[..., sl].astype(F32))
    p = jnp.stack(outs, axis=2).astype(z.dtype)
    y = jnp.einsum('blgc,gcd->blgd', p, w_pool).reshape(B, L, C) * pool_scale
    return y, ext


def even_mixer(u, pos, lat_past, kpe_past, pool_past, w_in, g_qa, w_qb, g_kva, w_uk, w_uv,
               w_pool, pool_scale, w_out):
    B, L, _ = u.shape
    h = u @ w_in
    o1, o2, o3 = Q_RANK, Q_RANK + KV_RANK, Q_RANK + KV_RANK + ROPE_DIM
    c_q, c_kv, k_pe, z = h[..., :o1], h[..., o1:o2], h[..., o2:o3], h[..., o3:]
    q = (rmsnorm(c_q, g_qa) @ w_qb).reshape(B, L, MLA_HEADS, NOPE_DIM + ROPE_DIM)
    cos, sin = rope_angles(pos)
    q_pe = apply_rope(q[..., NOPE_DIM:], cos[:, None], sin[:, None])
    q_lat = jnp.einsum('blhd,rhd->blhr', q[..., :NOPE_DIM], w_uk)
    lat = rmsnorm(c_kv, g_kva)
    k_pe = apply_rope(k_pe, cos, sin)
    if lat_past is None:
        keys_lat, keys_pe, k_pos = lat, k_pe, pos
    else:
        keys_lat = jnp.concatenate([lat_past.astype(lat.dtype), lat], axis=1)
        keys_pe = jnp.concatenate([kpe_past.astype(k_pe.dtype), k_pe], axis=1)
        k_pos = jnp.arange(lat_past.shape[1] + L)
    if L > MLA_QBLK:
        nb = L // MLA_QBLK
        def blk(a):
            return a.reshape((B, nb, MLA_QBLK) + a.shape[2:]).swapaxes(0, 1)
        o = lax.map(lambda t: mla_attend(t[0], t[1], keys_lat, keys_pe, t[2], k_pos),
                    (blk(q_lat), blk(q_pe), pos.reshape(nb, MLA_QBLK)))
        o_lat = o.swapaxes(0, 1).reshape(B, L, MLA_HEADS, KV_RANK)
    else:
        o_lat = mla_attend(q_lat, q_pe, keys_lat, keys_pe, pos, k_pos)
    y_mla = jnp.einsum('blhr,rhd->blhd', o_lat, w_uv).reshape(B, L, MLA_HEADS * V_DIM)
    y_pool, z_ext = pool_mix(z, pool_past, w_pool, pool_scale)
    y = jnp.concatenate([y_mla, y_pool], axis=-1) @ w_out
    return y, lat, k_pe, z_ext[:, -POOL_KEEP:]


def gla_chunkwise(q, k, v, log_f, S0):
    B, L, H, Dk = q.shape
    Dv = v.shape[-1]
    blk = math.gcd(L, HGRN_BLK)
    n = L // blk
    causal = np.tril(np.ones((blk, blk), dtype=bool))

    def blocks(a):
        return a.reshape(B, n, blk, H, a.shape[-1]).swapaxes(0, 1)

    def step(S, inp):
        qb, kb, vb, gb = inp
        b = jnp.cumsum(gb, axis=1)
        o_inter = jnp.einsum('bthk,bhkv->bthv', qb * jnp.exp(b), S)
        diff = b[:, :, None] - b[:, None, :]
        decay = jnp.exp(jnp.where(causal[None, :, :, None, None], diff, MASK_NEG))
        A = jnp.einsum('bthk,btshk,bshk->bhts', qb, decay, kb)
        o_intra = jnp.einsum('bhts,bshv->bthv', A, vb)
        b_last = b[:, -1]
        S_new = jnp.exp(b_last)[..., None] * S + jnp.einsum(
            'bshk,bshv->bhkv', kb * jnp.exp(b_last[:, None] - b), vb)
        return S_new, o_inter + o_intra

    S, o = lax.scan(step, S0, (blocks(q), blocks(k), blocks(v), blocks(log_f)))
    return o.swapaxes(0, 1).reshape(B, L, H, Dv), S


def odd_mixer(u, S0, lb, w_in, g_onorm, w_out):
    B, L, _ = u.shape
    h = u @ w_in
    q = jax.nn.silu(h[..., :C_FDIM]).astype(F32)
    fz = h[..., C_FDIM:2 * C_FDIM].astype(F32)
    v = h[..., 2 * C_FDIM:2 * C_FDIM + C_IDIM].astype(F32)
    g = h[..., 2 * C_FDIM + C_IDIM:]
    f = lb + (1.0 - lb) * jax.nn.sigmoid(fz)
    log_f = jnp.log(jnp.maximum(f, F_MIN))
    k = 1.0 - f
    o, S = gla_chunkwise(q.reshape(B, L, C_HEADS, HEAD_F), k.reshape(B, L, C_HEADS, HEAD_F),
                         v.reshape(B, L, C_HEADS, HEAD_I), log_f.reshape(B, L, C_HEADS, HEAD_F),
                         S0.astype(F32))
    o = rmsnorm(o, g_onorm).reshape(B, L, C_IDIM).astype(u.dtype) * jax.nn.silu(g)
    return o @ w_out, S


def conv_ffn(u, conv_past, w_up, conv_w, conv_b, w_down):
    L = u.shape[1]
    h = u @ w_up
    ext = jnp.concatenate([conv_past.astype(h.dtype), h], axis=1)
    c = conv_b + sum(ext[:, j:j + L] * conv_w[j] for j in range(CONV_W))
    a, b = jnp.split(c, 2, axis=-1)
    return (jax.nn.silu(a) * b) @ w_down, ext[:, -(CONV_W - 1):]


def setup_inputs(seed: int = 0) -> dict:
    key = jax.random.key(seed)
    ks = jax.random.split(key, 32)
    nrm = lambda k, shape, s: jax.random.normal(k, shape, F32) * s
    return {
        "x_prompt": nrm(ks[0], (BATCH, SEQ, D_MODEL), 1.0),
        "x_sample": nrm(ks[1], (DEC_BATCH, DEC_SEQ, D_MODEL), 1.0),
        "cache_mla_latent": nrm(ks[2], (N_EVEN, DEC_BATCH, PAST_LEN, KV_RANK), 1.0),
        "cache_mla_krope": nrm(ks[3], (N_EVEN, DEC_BATCH, PAST_LEN, ROPE_DIM), 1.0),
        "state_pool": nrm(ks[4], (N_EVEN, DEC_BATCH, POOL_KEEP, POOL_WIDTH), 1.0),
        "state_hgrn": nrm(ks[5], (N_ODD, DEC_BATCH, C_HEADS, HEAD_F, HEAD_I), 0.5),
        "state_ffn_conv": nrm(ks[6], (DEPTH, DEC_BATCH, CONV_W - 1, 2 * D_FF), 1.0),
        "g_mix": 1.0 + nrm(ks[7], (DEPTH, D_MODEL), 0.05),
        "g_ffn": 1.0 + nrm(ks[8], (DEPTH, D_MODEL), 0.05),
        "g_final": 1.0 + nrm(ks[9], (D_MODEL,), 0.05),
        "w_in_a": nrm(ks[10], (N_EVEN, D_MODEL, IN_EVEN), D_MODEL ** -0.5),
        "g_qa": 1.0 + nrm(ks[11], (N_EVEN, Q_RANK), 0.05),
        "w_qb": nrm(ks[12], (N_EVEN, Q_RANK, MLA_HEADS * (NOPE_DIM + ROPE_DIM)), Q_RANK ** -0.5),
        "g_kva": 1.0 + nrm(ks[13], (N_EVEN, KV_RANK), 0.05),
        "w_uk": nrm(ks[14], (N_EVEN, KV_RANK, MLA_HEADS, NOPE_DIM), KV_RANK ** -0.5),
        "w_uv": nrm(ks[15], (N_EVEN, KV_RANK, MLA_HEADS, V_DIM), KV_RANK ** -0.5),
        "w_pool": nrm(ks[16], (N_EVEN, POOL_GROUPS, POOL_GROUP_DIM, POOL_GROUP_DIM), POOL_GROUP_DIM ** -0.5),
        "pool_scale": 1.0 + nrm(ks[17], (N_EVEN, POOL_WIDTH), 0.1),
        "w_out_a": nrm(ks[18], (N_EVEN, MLA_HEADS * V_DIM + POOL_WIDTH, D_MODEL), D_MODEL ** -0.5),
        "w_in_c": nrm(ks[19], (N_ODD, D_MODEL, IN_ODD), D_MODEL ** -0.5),
        "lb_param": nrm(ks[20], (N_ODD, C_FDIM), 0.5),
        "g_onorm": 1.0 + nrm(ks[21], (N_ODD, HEAD_I), 0.05),
        "w_out_c": nrm(ks[22], (N_ODD, C_IDIM, D_MODEL), C_IDIM ** -0.5),
        "w_up": nrm(ks[23], (DEPTH, D_MODEL, 2 * D_FF), D_MODEL ** -0.5),
        "conv_w": nrm(ks[24], (DEPTH, CONV_W, 2 * D_FF), CONV_W ** -0.5),
        "conv_b": nrm(ks[25], (DEPTH, 2 * D_FF), 0.02),
        "w_down": nrm(ks[26], (DEPTH, D_FF, D_MODEL), D_FF ** -0.5),
    }


def reference(x_prompt, x_sample, cache_mla_latent, cache_mla_krope, state_pool, state_hgrn,
              state_ffn_conv, g_mix, g_ffn, g_final, w_in_a, g_qa, w_qb, g_kva, w_uk, w_uv,
              w_pool, pool_scale, w_out_a, w_in_c, lb_param, g_onorm, w_out_c, w_up, conv_w,
              conv_b, w_down):
    Bp, Lp, _ = x_prompt.shape
    Bs, Ls, _ = x_sample.shape
    past = cache_mla_latent.shape[2]
    pos_p = jnp.arange(Lp)
    pos_s = past + jnp.arange(Ls)
    sm = jax.nn.softmax(lb_param.astype(F32), axis=0)
    lbs = jnp.clip(jnp.cumsum(sm, axis=0) - sm[0:1], 0.0, 1.0)

    xp, xs = x_prompt, x_sample
    lat_p, kpe_p, pool_p, hg_p, cv_p = [], [], [], [], []
    lat_s, kpe_s, pool_s, hg_s, cv_s = [], [], [], [], []
    for layer in range(DEPTH):
        i = layer // 2
        up, us = rmsnorm(xp, g_mix[layer]), rmsnorm(xs, g_mix[layer])
        if layer % 2 == 0:
            wa = (w_in_a[i], g_qa[i], w_qb[i], g_kva[i], w_uk[i], w_uv[i], w_pool[i], pool_scale[i], w_out_a[i])
            yp, a, b, c = even_mixer(up, pos_p, None, None, None, *wa)
            lat_p.append(a); kpe_p.append(b); pool_p.append(c)
            ys, a, b, c = even_mixer(us, pos_s, cache_mla_latent[i], cache_mla_krope[i], state_pool[i], *wa)
            lat_s.append(a); kpe_s.append(b); pool_s.append(c)
        else:
            wc = (lbs[i], w_in_c[i], g_onorm[i], w_out_c[i])
            S0 = jnp.zeros((Bp, C_HEADS, HEAD_F, HEAD_I), F32)
            yp, Sp = odd_mixer(up, S0, *wc)
            ys, Ss = odd_mixer(us, state_hgrn[i], *wc)
            hg_p.append(Sp); hg_s.append(Ss)
        xp = xp + yp
        xs = xs + ys
        wf = (w_up[layer], conv_w[layer], conv_b[layer], w_down[layer])
        fp, cp = conv_ffn(rmsnorm(xp, g_ffn[layer]), jnp.zeros((Bp, CONV_W - 1, 2 * D_FF), xp.dtype), *wf)
        fs, cs = conv_ffn(rmsnorm(xs, g_ffn[layer]), state_ffn_conv[layer], *wf)
        cv_p.append(cp); cv_s.append(cs)
        xp = xp + fp
        xs = xs + fs

    y_prompt = rmsnorm(xp, g_final)
    y_sample = rmsnorm(xs, g_final)
    return (y_prompt, y_sample,
            jnp.stack(lat_p), jnp.stack(kpe_p), jnp.stack(pool_p), jnp.stack(hg_p), jnp.stack(cv_p),
            jnp.stack(lat_s), jnp.stack(kpe_s), jnp.stack(pool_s), jnp.stack(hg_s), jnp.stack(cv_s))
```

```cpp
#include <hip/hip_runtime.h>
#include <cstdio>
#include <cstdint>

#define GAS __attribute__((address_space(1)))
#define LAS __attribute__((address_space(3)))
typedef unsigned short bf16_t;
typedef short bf16x8 __attribute__((ext_vector_type(8)));
typedef short s16x4 __attribute__((ext_vector_type(4)));
typedef float f32x4 __attribute__((ext_vector_type(4)));
typedef float f32x2 __attribute__((ext_vector_type(2)));
typedef float f32x16 __attribute__((ext_vector_type(16)));
typedef unsigned u32x4 __attribute__((ext_vector_type(4)));
typedef unsigned u32x2 __attribute__((ext_vector_type(2)));

constexpr int DM = 2048, BATCH = 8, SEQ = 2048, DEPTH = 4, DECB = 32, DECS = 64, PAST = 4096;
constexpr int MP = BATCH * SEQ, MS = DECB * DECS, MT = MP + MS;
constexpr int NEVEN = 2, NODD = 2;
constexpr int HEADS = 8, QR = 512, KVR = 512, NOPE = 128, ROPE = 64, VD = 128, QKD = NOPE + ROPE;
constexpr int POOLW = 1024, POOLKEEP = 15;
constexpr int INA = 2112, INA_PAD = 2304;
constexpr int CHD = 16, HF = 128, HI = 128, INC = 8192;
constexpr int DFF = 5632, DFF2 = 11264;
constexpr int KVW = KVR + ROPE;
constexpr float EPS = 1e-6f;
constexpr int NPOS = SEQ + DECS;

constexpr size_t O_YP = 0;
constexpr size_t O_YS = O_YP + (size_t)MP * DM;
constexpr size_t O_LATP = O_YS + (size_t)MS * DM;
constexpr size_t O_KPEP = O_LATP + (size_t)NEVEN * MP * KVR;
constexpr size_t O_POOLP = O_KPEP + (size_t)NEVEN * MP * ROPE;
constexpr size_t O_HGP = O_POOLP + (size_t)NEVEN * BATCH * POOLKEEP * POOLW;
constexpr size_t O_CVP = O_HGP + (size_t)NODD * BATCH * CHD * HF * HI;
constexpr size_t O_LATS = O_CVP + (size_t)DEPTH * BATCH * 2 * DFF2;
constexpr size_t O_KPES = O_LATS + (size_t)NEVEN * MS * KVR;
constexpr size_t O_POOLS = O_KPES + (size_t)NEVEN * MS * ROPE;
constexpr size_t O_HGS = O_POOLS + (size_t)NEVEN * DECB * POOLKEEP * POOLW;
constexpr size_t O_CVS = O_HGS + (size_t)NODD * DECB * CHD * HF * HI;
constexpr size_t O_END = O_CVS + (size_t)DEPTH * DECB * 2 * DFF2;
static_assert(O_END == 84787200, "output size");

enum { I_XP = 0, I_XS, I_CLAT, I_CKPE, I_SPOOL, I_SHGRN, I_SCONV, I_GMIX, I_GFFN, I_GFINAL, I_WINA, I_GQA, I_WQB, I_GKVA, I_WUK, I_WUV,
       I_WPOOL, I_PSCALE, I_WOUTA, I_WINC, I_LB, I_GONORM, I_WOUTC, I_WUP, I_CONVW, I_CONVB, I_WDOWN, N_IN };

constexpr size_t al256(size_t x) { return (x + 255) / 256 * 256; }
constexpr size_t WS_CTL = 0, CTL_BYTES = 1u << 20;
constexpr size_t WS_WINA = WS_CTL + CTL_BYTES;
constexpr size_t WS_WQB = WS_WINA + al256((size_t)NEVEN * INA_PAD * DM * 2);
constexpr size_t WS_WKV = WS_WQB + al256((size_t)NEVEN * 1536 * QR * 2);
constexpr size_t WS_WUKBD = WS_WKV + al256((size_t)NEVEN * 2048 * KVR * 2);
constexpr size_t WS_WUVBD = WS_WUKBD + al256((size_t)NEVEN * 4096 * 1024 * 2);
constexpr size_t WS_WPOOL = WS_WUVBD + al256((size_t)NEVEN * 1024 * 4096 * 2);
constexpr size_t WS_WOUTA = WS_WPOOL + al256((size_t)NEVEN * 1024 * 256 * 2);
constexpr size_t WS_WINC = WS_WOUTA + al256((size_t)NEVEN * DM * DM * 2);
constexpr size_t WS_WOUTC = WS_WINC + al256((size_t)NODD * INC * DM * 2);
constexpr size_t WS_WUP = WS_WOUTC + al256((size_t)NODD * DM * DM * 2);
constexpr size_t WS_WDOWN = WS_WUP + al256((size_t)DEPTH * DFF2 * DM * 2);
constexpr size_t WS_KVC = WS_WDOWN + al256((size_t)DEPTH * DM * DFF * 2);
constexpr size_t WS_ROPE = WS_KVC + al256((size_t)NEVEN * DECB * PAST * KVW * 2);
constexpr size_t WS_LBS = WS_ROPE + al256((size_t)NPOS * 32 * 8);
constexpr size_t WS_SSQP = WS_LBS + al256((size_t)NODD * 2048 * 4);
constexpr size_t WS_RSTD = WS_SSQP + al256((size_t)9 * 32 * MT * 4);
constexpr size_t WS_SSQQ = WS_RSTD + al256((size_t)9 * MT * 4);
constexpr size_t WS_SSQKV = WS_SSQQ + al256((size_t)NEVEN * 8 * MT * 4);
constexpr size_t WS_HALO = WS_SSQKV + al256((size_t)NEVEN * 8 * MT * 4);
constexpr size_t WS_X = WS_HALO + al256((size_t)(MT / 256) * 4 * DFF2 * 4);
constexpr size_t WS_XB = WS_X + al256((size_t)MT * DM * 4);
constexpr size_t WS_YCAT = WS_XB + al256((size_t)MT * DM * 2);
constexpr size_t WS_BIG = WS_YCAT + al256((size_t)MT * DM * 2);
constexpr size_t WS_CQB = WS_BIG;
constexpr size_t WS_ZB = WS_CQB + al256((size_t)MT * QR * 2);
constexpr size_t WS_PB = WS_ZB + al256((size_t)MT * POOLW * 2);
constexpr size_t WS_KVN = WS_PB + al256((size_t)MT * POOLW * 2);
constexpr size_t WS_QP = WS_KVN + al256((size_t)MT * KVW * 2);
constexpr size_t WS_KP = WS_QP + al256((size_t)MP * HEADS * QKD * 2);
constexpr size_t WS_VP = WS_KP + al256((size_t)MP * HEADS * QKD * 2);
constexpr size_t WS_QNS = WS_VP + al256((size_t)MP * HEADS * VD * 2);
constexpr size_t WS_QS = WS_QNS + al256((size_t)MS * 1024 * 2);
constexpr size_t WS_OLAT = WS_QS + al256((size_t)MS * HEADS * KVW * 2);
constexpr size_t WS_EVEN_END = WS_OLAT + al256((size_t)MS * HEADS * KVR * 2);
constexpr size_t WS_FG = WS_BIG;
constexpr size_t WS_QSIL = WS_FG + al256((size_t)MT * 2048 * 4);
constexpr size_t WS_VB = WS_QSIL + al256((size_t)MT * 2048 * 2);
constexpr size_t WS_GS = WS_VB + al256((size_t)MT * 2048 * 2);
constexpr size_t WS_ODD_END = WS_GS + al256((size_t)MT * 2048 * 2);
constexpr size_t WS_HB = WS_BIG;
constexpr size_t WS_ACT = WS_HB + al256((size_t)MT * DFF2 * 2);
constexpr size_t WS_FFN_END = WS_ACT + al256((size_t)MT * DFF * 2);
constexpr size_t WS_END = WS_FFN_END > WS_EVEN_END ? (WS_FFN_END > WS_ODD_END ? WS_FFN_END : WS_ODD_END) : (WS_EVEN_END > WS_ODD_END ? WS_EVEN_END : WS_ODD_END);
static_assert(WS_END <= (size_t)2147483648u, "workspace map must fit 4 x largest input");

constexpr int CW_BAR = 4096;

constexpr int RING_BYTES = 159744;
constexpr int EPI_LDS = 131072;
constexpr int EPI_CW = EPI_LDS + 8192;
constexpr int EPI_RS = EPI_CW + 8192;
static_assert(EPI_RS + 2048 <= RING_BYTES, "epilogue LDS");
constexpr int MISC_OFF = RING_BYTES;
constexpr int LDS_BYTES = RING_BYTES + 256;
constexpr int NWAVES = 8;

#define LDS_WAIT() asm volatile("s_waitcnt lgkmcnt(0)" ::: "memory")
#define VM_WAIT() asm volatile("s_waitcnt vmcnt(0)" ::: "memory")
typedef __bf16 bf16x2_t __attribute__((ext_vector_type(2)));
__device__ __forceinline__ unsigned cvt_pk_bf16(float lo, float hi) { const f32x2 v = {lo, hi}; unsigned r = __builtin_bit_cast(unsigned, __builtin_convertvector(v, bf16x2_t)); asm volatile("" : "+v"(r)); return r; }
__device__ __forceinline__ float bf_lo(unsigned w) { return __uint_as_float(w << 16); }
__device__ __forceinline__ float bf_hi(unsigned w) { return __uint_as_float(w & 0xffff0000u); }
__device__ __forceinline__ float wave_sum(float v) {
#pragma unroll
    for (int o = 1; o < 64; o <<= 1) v += __shfl_xor(v, o);
    return v;
}
__device__ __forceinline__ float row4_sum(float x) {
    { const auto r = __builtin_amdgcn_permlane16_swap(__float_as_uint(x), __float_as_uint(x), false, false); x = __uint_as_float(r[0]) + __uint_as_float(r[1]); }
    { const auto r = __builtin_amdgcn_permlane32_swap(__float_as_uint(x), __float_as_uint(x), false, false); x = __uint_as_float(r[0]) + __uint_as_float(r[1]); }
    return x;
}
__device__ __forceinline__ float silu_f(float x) { return x * __builtin_amdgcn_rcpf(1.0f + __expf(-x)); }
__device__ __forceinline__ float sigmoid_f(float x) { return __builtin_amdgcn_rcpf(1.0f + __expf(-x)); }
template <class T> __device__ __forceinline__ T* as_global(T* p) { return (T*)(T GAS*)(unsigned long long)p; }
template <class T> __device__ __forceinline__ T* lau_s(T* p) { asm volatile("" : "+s"(p)); return as_global(p); }
template <class T> __device__ __forceinline__ T* lau_vp(T* p) { asm volatile("" : "+v"(p)); return as_global(p); }
__device__ __forceinline__ int lau_v(int x) { asm volatile("" : "+v"(x)); return x; }
__device__ __forceinline__ int lau_si(int x) { asm volatile("" : "+s"(x)); return x; }
__device__ __forceinline__ int lane_id() { int l; asm volatile("v_mbcnt_lo_u32_b32 %0, -1, 0\n\tv_mbcnt_hi_u32_b32 %0, -1, %0" : "=v"(l)); return l; }
#define XB_TMO      128
#define XB_XCNT(j)  (256  + 64 * (j))
#define XB_XSUB(j)  (1280 + 64 * (j))
#define XB_XGEN(j)  (2304 + 64 * (j))
#define XB_TOP      3328
#define XB_TOPGEN   3392
#define XCD_BAR_WORDS 3456
#define XB_SPIN_CAP (1u << 18)

__device__ __forceinline__ unsigned xb_ld(unsigned* p)              { return __hip_atomic_load(p, __ATOMIC_RELAXED, __HIP_MEMORY_SCOPE_AGENT); }
__device__ __forceinline__ unsigned xb_add(unsigned* p, unsigned v) { return __hip_atomic_fetch_add(p, v, __ATOMIC_RELAXED, __HIP_MEMORY_SCOPE_AGENT); }
__device__ __forceinline__ unsigned xb_xcc_id() { return (unsigned)__builtin_amdgcn_s_getreg((3 << 11) | 20) & 0xFu; }
#define XB_SPIN(cond, bar) do { unsigned _sp = 0; while (cond) { __builtin_amdgcn_s_sleep(1); \
    if ((++_sp & 255u) == 0u) { if (xb_ld(&(bar)[XB_TMO])) break; if (_sp > XB_SPIN_CAP) { atomicAdd(&(bar)[XB_TMO], 1u); break; } } } } while (0)

struct XcdBarrier {
    unsigned* bar; unsigned x;
    volatile LAS unsigned* st;
};

__device__ __forceinline__ XcdBarrier xcd_barrier_post(unsigned* bar, volatile LAS unsigned* st) {
    XcdBarrier b; b.bar = bar; b.x = xb_xcc_id(); b.st = st;
    if (threadIdx.x == 0) (void)xb_add(&bar[XB_XCNT(b.x)], 1u);
    return b;
}
__device__ __forceinline__ void xcd_barrier_complete(unsigned* bar, unsigned x, unsigned& nloc, unsigned& nx) {
    const unsigned G = gridDim.x * gridDim.y * gridDim.z;
    unsigned sum, cnt, mine, sp = 0u;
    for (;;) {
        sum = 0u; cnt = 0u; mine = 0u;
#pragma unroll
        for (unsigned j = 0; j < 16; ++j) { const unsigned c = xb_ld(&bar[XB_XCNT(j)]); sum += c; cnt += (c > 0u) ? 1u : 0u; mine = (j == x) ? c : mine; }
        if (sum == G) break;
        __builtin_amdgcn_s_sleep(1);
        if ((++sp & 255u) == 0u) { if (xb_ld(&bar[XB_TMO])) break; if (sp > XB_SPIN_CAP) { atomicAdd(&bar[XB_TMO], 1u); break; } }
    }
    nloc = mine > 0u ? mine : 1u; nx = cnt > 0u ? cnt : 1u;
}

__device__ __forceinline__ void xcd_barrier(const XcdBarrier& b) {
    asm volatile("s_waitcnt vmcnt(0)" ::: "memory");
    __syncthreads();
    if (threadIdx.x == 0) {
        unsigned* bar = b.bar;
        __builtin_amdgcn_s_waitcnt(0);
        unsigned nloc = b.st[0], nx = b.st[1];
        if (nloc == 0u) { xcd_barrier_complete(bar, b.x, nloc, nx); b.st[0] = nloc; b.st[1] = nx; }
        const unsigned old = xb_add(&bar[XB_XSUB(b.x)], 1u);
        const unsigned gen = old / nloc;
        if (old + 1u == (gen + 1u) * nloc) {
            __builtin_amdgcn_fence(__ATOMIC_RELEASE, "agent");
            asm volatile("s_waitcnt vmcnt(0)" ::: "memory");
            const unsigned og = xb_add(&bar[XB_TOP], 1u);
            const unsigned tg = og / nx;
            if (og + 1u == (tg + 1u) * nx) xb_add(&bar[XB_TOPGEN], 1u);
            else XB_SPIN(xb_ld(&bar[XB_TOPGEN]) == tg, bar);
            __builtin_amdgcn_fence(__ATOMIC_ACQUIRE, "agent");
            xb_add(&bar[XB_XGEN(b.x)], 1u);
            asm volatile("s_waitcnt vmcnt(0)" ::: "memory");
        } else {
            XB_SPIN(xb_ld(&bar[XB_XGEN(b.x)]) == gen, bar);
            __builtin_amdgcn_fence(__ATOMIC_ACQUIRE, "agent");
            asm volatile("s_waitcnt vmcnt(0)" ::: "memory");
        }
    }
    __syncthreads();
}

namespace pg8 {
constexpr int BM = 256, BK = 64, HALF = 128, HTB = HALF * BK * 2, STAGE_BYTES = 8 * HTB, NXCD = 8, WGM = 8;
__host__ __device__ __forceinline__ int lds_byte(int r, int c) { const int st = (r >> 4) * 2 + (c >> 5), rr = r & 15, cc = c & 31, ob = rr * 64 + cc * 2; return st * 1024 + (ob ^ (((ob >> 9) & 1) << 5)); }
__host__ __device__ __forceinline__ void stage_rc(int b, int& R, int& C) { const int st = b / 1024, sb = b % 1024, swz = sb ^ (((sb >> 9) & 1) << 5); R = (st >> 1) * 16 + swz / 64; C = (st & 1) * 32 + (swz % 64) / 2; }
__host__ __device__ __forceinline__ int perm32(int rho) { const int n = rho >> 4, i = rho & 15; return 8 * (i >> 2) + 4 * n + (i & 3); }

struct Unit { int pm, pn, par; };
struct Gemm { const bf16_t* A; const bf16_t* Bt; int lda, ldb, K; };

struct StaticOrder {
    int nM, nN, nwg, G, c, lda, ldb, bm;
    __device__ void init(int nM_, int nN_, int G_, int c_, int lda_, int ldb_, int bm_ = BM) { nM = nM_; nN = nN_; nwg = nM * nN; G = G_; c = c_; lda = lda_; ldb = ldb_; bm = bm_; }
    __device__ bool next(int i, Unit& u) const {
        const long L = (long)i * G + c; if (L >= nwg) return false;
        int wgid = (int)L; { const int q = nwg / NXCD, r = nwg % NXCD, xcd = wgid % NXCD, off = wgid / NXCD; wgid = (xcd < r ? xcd * (q + 1) : r * (q + 1) + (xcd - r) * q) + off; }
        const int nig = WGM * nN, gid = wgid / nig, fm = gid * WGM, gsz = (nM - fm) < WGM ? (nM - fm) : WGM;
        u.pm = fm + ((wgid % nig) % gsz); u.pn = (wgid % nig) / gsz; return true;
    }
    __device__ __forceinline__ size_t aoff(const Unit& u) const { return (size_t)u.pm * bm * lda * 2; }
    __device__ __forceinline__ size_t boff(const Unit& u) const { return (size_t)u.pn * BM * ldb * 2; }
};
struct GroupOrder {
    int nM, ng, nwg, G, c, lda, ldb, akoff;
    __device__ void init(int nM_, int ng_, int G_, int c_, int lda_, int ldb_, int akoff_) { nM = nM_; ng = ng_; nwg = nM * ng; G = G_; c = c_; lda = lda_; ldb = ldb_; akoff = akoff_; }
    __device__ bool next(int i, Unit& u) const {
        const long L = (long)i * G + c; if (L >= nwg) return false;
        u.pm = (int)(L / ng); u.pn = (int)(L % ng); return true;
    }
    __device__ __forceinline__ size_t aoff(const Unit& u) const { return ((size_t)u.pm * BM * lda + (size_t)u.pn * akoff) * 2; }
    __device__ __forceinline__ size_t boff(const Unit& u) const { return (size_t)u.pn * BM * ldb * 2; }
};

struct HeadOrder {
    int nM, nt, nwg, G, c, lda, ldb, akoff;
    __device__ void init(int nM_, int nt_, int G_, int c_, int lda_, int ldb_, int akoff_) { nM = nM_; nt = nt_; nwg = nM * nt; G = G_; c = c_; lda = lda_; ldb = ldb_; akoff = akoff_; }
    __device__ bool next(int i, Unit& u) const {
        const long L = (long)i * G + c; if (L >= nwg) return false;
        u.pm = (int)(L / nt); u.pn = (int)(L % nt); return true;
    }
    __device__ __forceinline__ size_t aoff(const Unit& u) const { return ((size_t)u.pm * BM * lda + (size_t)(u.pn >> 1) * akoff) * 2; }
    __device__ __forceinline__ size_t boff(const Unit& u) const { return (size_t)u.pn * BM * ldb * 2; }
};

template <class Epi, class Sched, bool ALIGN_EPI = true, bool SP2 = true, int NM = 4>
__device__ __forceinline__ void gemm_phase(LAS unsigned char* lds, const Gemm g, const Sched& S, const Epi& E, int wid) {
    const int lane = lau_v(lane_id()), tid = wid * 64 + lane, wr = wid >> 2, wc = wid & 3, fr = lane & 15, fq = lane >> 4;
    const int K = g.K, nt = K / BK;
    unsigned voffA[2], voffB[2];
#pragma unroll
    for (int i = 0; i < 2; ++i) { int R, C; stage_rc(tid * 16 + i * 8192, R, C); const int Rb = Epi::PERM ? ((R & ~31) + perm32(R & 31)) : R;
        voffA[i] = (unsigned)(R * g.lda + C) * 2u; voffB[i] = (unsigned)(Rb * g.ldb + C) * 2u; }
    const size_t kstep = (size_t)(BK * 2);
    const size_t hstepA = (size_t)(32 * NM) * g.lda * 2, hstepB = (size_t)HALF * g.ldb * 2;
    const unsigned ldsw = (unsigned)wid * 1024u;
    const int aoff = lds_byte(wr * (16 * NM) + fr, fq * 8), boff = lds_byte(wc * 32 + fr, fq * 8);
#define PG8_SA(b, h) (((b) * 2 + (h)) * HTB)
#define PG8_SB(b, h) ((4 + (b) * 2 + (h)) * HTB)
#define PG8_STAGE(bufoff, gbase, voff) do { _Pragma("unroll") for (int _i = 0; _i < 2; ++_i) \
        __builtin_amdgcn_global_load_lds((const unsigned*)((const char*)(gbase) + (voff)[_i]), (LAS unsigned*)(lds + (bufoff) + ldsw + _i * 8192), 16, 0, 0); } while (0)
#define PG8_LDA(dst, b, h) do { _Pragma("unroll") for (int m = 0; m < NM; ++m) _Pragma("unroll") for (int k = 0; k < 2; ++k) dst[m][k] = *(const LAS bf16x8*)(lds + PG8_SA(b, h) + aoff + m * 2048 + k * 1024); } while (0)
#define PG8_LDB(dst, b, h) do { _Pragma("unroll") for (int n = 0; n < 2; ++n) _Pragma("unroll") for (int k = 0; k < 2; ++k) dst[n][k] = *(const LAS bf16x8*)(lds + PG8_SB(b, h) + boff + n * 2048 + k * 1024); } while (0)
#define PG8_MMA(ai, bj, At, Bt) do { __builtin_amdgcn_s_setprio(1); _Pragma("unroll") for (int m = 0; m < NM; ++m) _Pragma("unroll") for (int n = 0; n < 2; ++n) _Pragma("unroll") for (int k = 0; k < 2; ++k) \
        acc[ai][bj][m][n] = __builtin_amdgcn_mfma_f32_16x16x32_bf16(Bt[n][k], At[m][k], acc[ai][bj][m][n], 0, 0, 0); __builtin_amdgcn_s_setprio(0); } while (0)
#define PG8_WAIT_V(n) asm volatile("s_waitcnt vmcnt(" #n ")" ::: "memory")
#define PG8_WAIT_L(n) asm volatile("s_waitcnt lgkmcnt(" #n ")" ::: "memory")
#define PG8_BAR __builtin_amdgcn_s_barrier()
#define PG8_SCHED __builtin_amdgcn_sched_barrier(0)
    Unit cur, nxt; int ui = 0;
    if (!S.next(0, cur)) return;
    cur.par = 0;
    f32x4 acc[2][2][NM][2];
#pragma unroll
    for (int a = 0; a < 2; ++a)
#pragma unroll
        for (int b = 0; b < 2; ++b)
#pragma unroll
            for (int m = 0; m < NM; ++m)
#pragma unroll
                for (int n = 0; n < 2; ++n) acc[a][b][m][n] = (f32x4){0.f, 0.f, 0.f, 0.f};
    bf16x8 At[NM][2], B0[2][2], B1[2][2];
    const char* cA = (const char*)g.A + S.aoff(cur); const char* cB = (const char*)g.Bt + S.boff(cur);
    if constexpr (SP2) {
        PG8_STAGE(PG8_SB(0, 0), cB, voffB); PG8_STAGE(PG8_SB(0, 1), cB + hstepB, voffB); PG8_STAGE(PG8_SA(0, 0), cA, voffA); PG8_STAGE(PG8_SA(0, 1), cA + hstepA, voffA);
        if (wr == 1) PG8_BAR;
        PG8_WAIT_V(2); PG8_BAR;
        PG8_STAGE(PG8_SB(1, 0), cB + kstep, voffB); PG8_STAGE(PG8_SA(1, 0), cA + kstep, voffA); PG8_STAGE(PG8_SB(1, 1), cB + hstepB + kstep, voffB);
        PG8_WAIT_V(6); PG8_BAR;
    } else {
        PG8_STAGE(PG8_SB(0, 0), cB, voffB); PG8_STAGE(PG8_SA(0, 0), cA, voffA); PG8_STAGE(PG8_SB(0, 1), cB + hstepB, voffB); PG8_STAGE(PG8_SA(0, 1), cA + hstepA, voffA);
        if (wr == 1) PG8_BAR;
        PG8_WAIT_V(4); PG8_BAR;
        PG8_STAGE(PG8_SB(1, 0), cB + kstep, voffB); PG8_STAGE(PG8_SA(1, 0), cA + kstep, voffA); PG8_STAGE(PG8_SB(1, 1), cB + hstepB + kstep, voffB);
        PG8_WAIT_V(6); PG8_BAR;
    }
    for (;;) {
        const bool has_next = S.next(ui + 1, nxt);
        const char* nA = has_next ? (const char*)g.A + S.aoff(nxt) : cA; const char* nB = has_next ? (const char*)g.Bt + S.boff(nxt) : cB;
        if constexpr (Epi::PRE) E.pre(lds, cur, wid);
        for (int t = 0; t < nt; t += 2) {
            const bool last = (t == nt - 2);
            const char* a1 = cA + (size_t)(t + 1) * kstep;
            const char* a2 = last ? nA : cA + (size_t)(t + 2) * kstep; const char* b2 = last ? nB : cB + (size_t)(t + 2) * kstep;
            const char* a3 = a2 + kstep; const char* b3 = b2 + kstep;
            if constexpr (SP2) {
            PG8_LDB(B0, 0, 0); PG8_LDB(B1, 0, 1); PG8_SCHED; PG8_LDA(At, 0, 0); PG8_STAGE(PG8_SA(1, 1), a1 + hstepA, voffA);
            PG8_WAIT_V(8); PG8_WAIT_L(0); PG8_BAR; PG8_MMA(0, 0, At, B0); PG8_MMA(0, 1, At, B1); PG8_BAR; PG8_SCHED;
            PG8_LDA(At, 0, 1); PG8_STAGE(PG8_SB(0, 0), b2, voffB); PG8_STAGE(PG8_SB(0, 1), b2 + hstepB, voffB); PG8_STAGE(PG8_SA(0, 0), a2, voffA);
            PG8_WAIT_V(8); PG8_WAIT_L(0); PG8_BAR; PG8_MMA(1, 0, At, B0); PG8_MMA(1, 1, At, B1); PG8_BAR; PG8_SCHED;
            PG8_LDB(B0, 1, 0); PG8_LDB(B1, 1, 1); PG8_SCHED; PG8_LDA(At, 1, 0); PG8_STAGE(PG8_SA(0, 1), a2 + hstepA, voffA);
            PG8_WAIT_V(8); PG8_WAIT_L(0); PG8_BAR; PG8_MMA(0, 0, At, B0); PG8_MMA(0, 1, At, B1); PG8_BAR; PG8_SCHED;
            PG8_LDA(At, 1, 1); PG8_STAGE(PG8_SB(1, 0), b3, voffB); PG8_STAGE(PG8_SB(1, 1), b3 + hstepB, voffB); PG8_STAGE(PG8_SA(1, 0), a3, voffA);
            PG8_WAIT_V(8); PG8_WAIT_L(0); PG8_BAR; PG8_MMA(1, 0, At, B0); PG8_MMA(1, 1, At, B1); PG8_BAR; PG8_SCHED;
            } else {
            PG8_LDB(B0, 0, 0); PG8_SCHED; PG8_LDA(At, 0, 0); PG8_STAGE(PG8_SA(1, 1), a1 + hstepA, voffA);
            PG8_WAIT_L(8); PG8_BAR; PG8_WAIT_L(0); PG8_MMA(0, 0, At, B0); PG8_BAR; PG8_SCHED;
            PG8_LDB(B1, 0, 1); PG8_STAGE(PG8_SB(0, 0), b2, voffB);
            PG8_BAR; PG8_WAIT_L(0); PG8_MMA(0, 1, At, B1); PG8_BAR;
            PG8_LDA(At, 0, 1); PG8_STAGE(PG8_SA(0, 0), a2, voffA);
            PG8_BAR; PG8_WAIT_L(0); PG8_MMA(1, 0, At, B0); PG8_BAR; PG8_SCHED;
            PG8_STAGE(PG8_SB(0, 1), b2 + hstepB, voffB);
            PG8_WAIT_V(6); PG8_BAR; PG8_MMA(1, 1, At, B1); PG8_BAR;
            PG8_LDB(B0, 1, 0); PG8_SCHED; PG8_LDA(At, 1, 0); PG8_STAGE(PG8_SA(0, 1), a2 + hstepA, voffA);
            PG8_WAIT_L(8); PG8_BAR; PG8_WAIT_L(0); PG8_MMA(0, 0, At, B0); PG8_BAR; PG8_SCHED;
            PG8_LDB(B1, 1, 1); PG8_STAGE(PG8_SB(1, 0), b3, voffB);
            PG8_BAR; PG8_WAIT_L(0); PG8_MMA(0, 1, At, B1); PG8_BAR;
            PG8_LDA(At, 1, 1); PG8_STAGE(PG8_SA(1, 0), a3, voffA);
            PG8_BAR; PG8_WAIT_L(0); PG8_MMA(1, 0, At, B0); PG8_BAR; PG8_SCHED;
            PG8_STAGE(PG8_SB(1, 1), b3 + hstepB, voffB);
            PG8_WAIT_V(6); PG8_BAR; PG8_MMA(1, 1, At, B1); PG8_BAR;
            }
        }
        if constexpr (ALIGN_EPI) { if (wr == 0) PG8_BAR; }
        E(acc, cur, wr, wc, fr, fq);
        if (!has_next) break;
#pragma unroll
        for (int a = 0; a < 2; ++a)
#pragma unroll
            for (int b = 0; b < 2; ++b)
#pragma unroll
                for (int m = 0; m < NM; ++m)
#pragma unroll
                    for (int n = 0; n < 2; ++n) acc[a][b][m][n] = (f32x4){0.f, 0.f, 0.f, 0.f};
        cur = nxt; cA = nA; cB = nB; ++ui; cur.par = ui & 1;
        if constexpr (ALIGN_EPI) { if (wr == 1) PG8_BAR; }
    }
    PG8_WAIT_V(0);
    if constexpr (!ALIGN_EPI) { if (wr == 0) PG8_BAR; }
    PG8_BAR;
#undef PG8_SA
#undef PG8_SB
#undef PG8_STAGE
#undef PG8_LDA
#undef PG8_LDB
#undef PG8_MMA
#undef PG8_WAIT_V
#undef PG8_WAIT_L
#undef PG8_BAR
#undef PG8_SCHED
}
}
struct Frame {
    LAS unsigned char* lds;
    volatile LAS unsigned* MISC;
    unsigned* ctl;
    float* ctlf;
    int wave;
    int vcu, G;
};
struct Args { const float* in[N_IN]; float* out; unsigned char* ws; int ph_lo, ph_hi; };
typedef const Args __attribute__((address_space(4))) KArgs;
__device__ __forceinline__ KArgs* kargs() { KArgs* p = (KArgs*)__builtin_amdgcn_kernarg_segment_ptr(); asm volatile("" : "+s"(p)); return p; }
__device__ __forceinline__ int rope_row(int r) { return r < MP ? (r & (SEQ - 1)) : SEQ + ((r - MP) & (DECS - 1)); }

__device__ __forceinline__ void tr_item(const float* W, int ldn, int k0, int n0, const float* ks, const float* ns, bf16_t* WT, size_t dld, int rbase, int rstride, int dcol0, LAS float* scr, int lane) {
    f32x4 v[8];
#pragma unroll
    for (int i = 0; i < 8; ++i) v[i] = *(const f32x4*)(W + (size_t)(k0 + 8 * i + (lane >> 3)) * ldn + n0 + 4 * (lane & 7));
#pragma unroll
    for (int i = 0; i < 8; ++i) { const int kk = 8 * i + (lane >> 3); const float s = ks ? ks[k0 + kk] : 1.0f; LAS float* d = scr + kk * 33 + 4 * (lane & 7);
        d[0] = v[i][0] * s; d[1] = v[i][1] * s; d[2] = v[i][2] * s; d[3] = v[i][3] * s; }
    LDS_WAIT(); asm volatile("" ::: "memory");
    const int c = lane & 7;
#pragma unroll
    for (int j = 0; j < 4; ++j) { const int n = (lane >> 3) + 8 * j; const LAS float* s = scr + (8 * c) * 33 + n; const float sc = ns ? ns[n] : 1.0f;
        u32x4 o; o.x = cvt_pk_bf16(s[0 * 33] * sc, s[1 * 33] * sc); o.y = cvt_pk_bf16(s[2 * 33] * sc, s[3 * 33] * sc); o.z = cvt_pk_bf16(s[4 * 33] * sc, s[5 * 33] * sc); o.w = cvt_pk_bf16(s[6 * 33] * sc, s[7 * 33] * sc);
        *(u32x4*)(WT + (size_t)(rbase + rstride * n) * dld + dcol0 + k0 + 8 * c) = o; }
    LDS_WAIT(); asm volatile("" ::: "memory");
}
struct TrMat { const float* W; int K, N; const float* ks; bf16_t* WT; size_t dld; int mode; const float* ns; };
__device__ __forceinline__ void tr_mat_item(const TrMat& t, int it, LAS float* scr, int lane) {
    const int nblk = t.N / 32, kb = it / nblk, nb = it % nblk, k0 = 64 * kb, n0 = 32 * nb;
    int rbase = n0, rstride = 1, dcol0 = 0;
    if (t.mode == 1) { rbase = n0 < 1024 ? n0 : (n0 < 1088 ? 2048 + (n0 - 1024) : 1024 + (n0 - 1088)); }
    else if (t.mode == 2) { const int h = n0 / 192, c = n0 % 192; if (c >= 128) { const int j0 = c - 128; rbase = h * 192 + 128 + (j0 >= 32 ? 1 : 0); rstride = 2; } }
    else if (t.mode == 3) { dcol0 = (n0 / 128) * 512; }
    else if (t.mode == 5) { const int isb = n0 >= DFF ? 1 : 0, j0 = n0 - isb * DFF; rbase = (j0 / 128) * 256 + isb * 128 + (j0 % 128); }
    tr_item(t.W, t.N, k0, n0, t.ks, t.ns ? t.ns + n0 : nullptr, t.WT, t.dld, rbase, rstride, dcol0, scr, lane);
}
__device__ __forceinline__ void sincos_red(float ang, float& sn, float& cs) {
    const double a = (double)ang, k = rint(a * 0.63661977236758134308), r = a - k * 1.57079632679489661923;
    const float x = (float)r, x2 = x * x;
    const float s = x + x * x2 * (-1.6666667e-1f + x2 * (8.3333333e-3f + x2 * (-1.9841270e-4f + x2 * 2.7557319e-6f)));
    const float c = 1.0f + x2 * (-0.5f + x2 * (4.1666667e-2f + x2 * (-1.3888889e-3f + x2 * (2.4801587e-5f + x2 * -2.7557319e-7f))));
    const int q = ((int)k) & 3;
    sn = (q == 0) ? s : (q == 1) ? c : (q == 2) ? -s : -c;
    cs = (q == 0) ? c : (q == 1) ? -s : (q == 2) ? -c : s;
}
enum { CM_WINA = 0, CM_WQB = 2, CM_WUK = 4, CM_WUV = 6, CM_WPOOL = 8, CM_WOUTA = 16, CM_WINC = 18, CM_WOUTC = 20, CM_WUP = 22, CM_WDOWN = 26, CM_FILL = 30 };
constexpr unsigned cm_attn(int i) { return (1u << (CM_WINA + i)) | (1u << (CM_WQB + i)) | (1u << (CM_WUK + i)) | (1u << (CM_WUV + i)) | (0xFu << (CM_WPOOL + 4 * i)) | (1u << (CM_WOUTA + i)) | (1u << (CM_FILL + i)); }
__device__ __forceinline__ TrMat conv_mat(KArgs* A_k, unsigned char* ws, int id) {
    TrMat t{};
    if (id < CM_WQB) { const int i = id - CM_WINA; t = TrMat{as_global(A_k->in[I_WINA]) + (size_t)i * DM * INA, DM, INA, as_global(A_k->in[I_GMIX]) + (size_t)(2 * i) * DM, (bf16_t*)(ws + WS_WINA) + (size_t)i * INA_PAD * DM, (size_t)DM, 1, nullptr}; }
    else if (id < CM_WUK) { const int i = id - CM_WQB; t = TrMat{as_global(A_k->in[I_WQB]) + (size_t)i * QR * 1536, QR, 1536, as_global(A_k->in[I_GQA]) + (size_t)i * QR, (bf16_t*)(ws + WS_WQB) + (size_t)i * 1536 * QR, (size_t)QR, 2, nullptr}; }
    else if (id < CM_WUV) { const int i = id - CM_WUK; t = TrMat{as_global(A_k->in[I_WUK]) + (size_t)i * KVR * 1024, KVR, 1024, nullptr, (bf16_t*)(ws + WS_WKV) + (size_t)i * 2048 * KVR, (size_t)KVR, 0, nullptr}; }
    else if (id < CM_WPOOL) { const int i = id - CM_WUV; t = TrMat{as_global(A_k->in[I_WUV]) + (size_t)i * KVR * 1024, KVR, 1024, nullptr, (bf16_t*)(ws + WS_WKV) + (size_t)i * 2048 * KVR + (size_t)1024 * KVR, (size_t)KVR, 0, nullptr}; }
    else if (id < CM_WOUTA) { const int ig = id - CM_WPOOL; t = TrMat{as_global(A_k->in[I_WPOOL]) + (size_t)ig * 256 * 256, 256, 256, nullptr, (bf16_t*)(ws + WS_WPOOL) + (size_t)ig * 256 * 256, (size_t)256, 0, as_global(A_k->in[I_PSCALE]) + (size_t)ig * 256}; }
    else if (id < CM_WINC) { const int i = id - CM_WOUTA; t = TrMat{as_global(A_k->in[I_WOUTA]) + (size_t)i * DM * DM, DM, DM, nullptr, (bf16_t*)(ws + WS_WOUTA) + (size_t)i * DM * DM, (size_t)DM, 0, nullptr}; }
    else if (id < CM_WOUTC) { const int i = id - CM_WINC; t = TrMat{as_global(A_k->in[I_WINC]) + (size_t)i * DM * INC, DM, INC, as_global(A_k->in[I_GMIX]) + (size_t)(2 * i + 1) * DM, (bf16_t*)(ws + WS_WINC) + (size_t)i * INC * DM, (size_t)DM, 0, nullptr}; }
    else if (id < CM_WUP) { const int i = id - CM_WOUTC; t = TrMat{as_global(A_k->in[I_WOUTC]) + (size_t)i * DM * DM, DM, DM, nullptr, (bf16_t*)(ws + WS_WOUTC) + (size_t)i * DM * DM, (size_t)DM, 0, nullptr}; }
    else if (id < CM_WDOWN) { const int l = id - CM_WUP; t = TrMat{as_global(A_k->in[I_WUP]) + (size_t)l * DM * DFF2, DM, DFF2, as_global(A_k->in[I_GFFN]) + (size_t)l * DM, (bf16_t*)(ws + WS_WUP) + (size_t)l * DFF2 * DM, (size_t)DM, 5, nullptr}; }
    else { const int l = id - CM_WDOWN; t = TrMat{as_global(A_k->in[I_WDOWN]) + (size_t)l * DFF * DM, DFF, DM, nullptr, (bf16_t*)(ws + WS_WDOWN) + (size_t)l * DM * DFF, (size_t)DFF, 0, nullptr}; }
    return t;
}
__device__ __forceinline__ void conv_run(const Frame& F, KArgs* A_k, unsigned mask, int widx, int nw) {
    LAS float* scr = (LAS float*)(F.lds + F.wave * 16384);
    const int lane = lau_v(lane_id()); unsigned char* ws = lau_s(A_k->ws);
    int first = widx;
#pragma unroll 1
    for (int id = 0; id < CM_FILL; ++id) {
        if (!((mask >> id) & 1u)) continue;
        const TrMat t = conv_mat(A_k, ws, id); const int n = (t.K / 64) * (t.N / 32);
        int it = first;
#pragma unroll 1
        for (; it < n; it += nw) tr_mat_item(t, it, scr, lane);
        first = it - n;
    }
#pragma unroll 1
    for (int i = 0; i < NEVEN; ++i) {
        if (!((mask >> (CM_FILL + i)) & 1u)) continue;
        const unsigned tix = (unsigned)(widx * 64 + lau_v(lane)), nthr = (unsigned)nw * 64u; const unsigned z_ = (unsigned)lau_v(0); const u32x4 z4 = {z_, z_, z_, z_};
        for (unsigned c = tix; c < (unsigned)((INA_PAD - INA) * DM / 8); c += nthr) *(u32x4*)((bf16_t*)(ws + WS_WINA) + ((size_t)i * INA_PAD + INA) * DM + (size_t)c * 8) = z4;
        for (unsigned c = tix; c < 4096u * 16u; c += nthr) {
            const int row = (int)(c / 16), d0 = (int)(c % 16) * 8, h = row / 512, r = row % 512;
            const float* s = as_global(A_k->in[I_WUK]) + (((size_t)i * KVR + r) * HEADS + h) * NOPE + d0; const f32x4 a = *(const f32x4*)s, b = *(const f32x4*)(s + 4);
            u32x4 o; o.x = cvt_pk_bf16(a[0], a[1]); o.y = cvt_pk_bf16(a[2], a[3]); o.z = cvt_pk_bf16(b[0], b[1]); o.w = cvt_pk_bf16(b[2], b[3]);
            *(u32x4*)((bf16_t*)(ws + WS_WUKBD) + (size_t)i * 4096 * 128 + (size_t)row * 128 + d0) = o; }
    }
}
constexpr unsigned CJ_PROLOGUE = cm_attn(0) | (1u << (CM_WUP + 0)) | (1u << (CM_WINC + 0)) | (1u << (CM_WINC + 1)) | (1u << (CM_WUP + 2));
constexpr unsigned CJ_INA0 = (1u << (CM_WOUTC + 0)), CJ_INA2 = (1u << (CM_WOUTC + 1));
constexpr unsigned CJ_UP0 = (1u << (CM_WDOWN + 0)), CJ_UP1 = (1u << (CM_WDOWN + 1)), CJ_UP2 = (1u << (CM_WDOWN + 2));
constexpr unsigned CJ_GLA1 = (1u << (CM_WUP + 1)) | cm_attn(1), CJ_GLA3 = (1u << (CM_WUP + 3)) | (1u << (CM_WDOWN + 3));
static_assert((CJ_PROLOGUE | CJ_INA0 | CJ_INA2 | CJ_UP0 | CJ_UP1 | CJ_UP2 | CJ_GLA1 | CJ_GLA3) == 0xFFFFFFFFu, "every matrix is converted exactly once");
static_assert((CJ_PROLOGUE ^ CJ_INA0 ^ CJ_INA2 ^ CJ_UP0 ^ CJ_UP1 ^ CJ_UP2 ^ CJ_GLA1 ^ CJ_GLA3) == 0xFFFFFFFFu, "every matrix is converted exactly once");
__device__ __forceinline__ void p0_prologue(const Frame& F, KArgs* A_k) {
    LAS float* scr = (LAS float*)(F.lds + F.wave * 16384);
    const int lane = lau_v(lane_id());
    const int gw = lau_si(F.vcu * NWAVES + F.wave), NGW = F.G * NWAVES;
    const size_t gt = (size_t)gw * 64 + lane, NGT = (size_t)NGW * 64;
    unsigned char* ws = lau_s(A_k->ws);
    conv_run(F, A_k, CJ_PROLOGUE, gw, NGW);
    for (size_t c = gt; c < (size_t)NPOS * 32; c += NGT) {
        const int pr = (int)(c / 32), j = (int)(c % 32); const float pos = (float)(pr < SEQ ? pr : PAST + (pr - SEQ));
        const float inv = exp2f(-((float)(2 * j) / 64.0f) * 13.287712379549449f); const float ang = pos * inv; float sn, cs; sincos_red(ang, sn, cs);
        ((f32x2*)(ws + WS_ROPE))[c] = (f32x2){cs, sn}; }
    for (size_t c = gt; c < (size_t)2048; c += NGT) {
        const float p0 = as_global(A_k->in[I_LB])[c], p1 = as_global(A_k->in[I_LB])[2048 + c], mx = fmaxf(p0, p1), e0 = expf(p0 - mx), e1 = expf(p1 - mx), s0 = e0 / (e0 + e1), s1 = e1 / (e0 + e1);
        float* lb = (float*)(ws + WS_LBS); lb[c] = fminf(fmaxf(s0 - s0, 0.f), 1.f); lb[2048 + c] = fminf(fmaxf((s0 + s1) - s0, 0.f), 1.f); }
    for (int r = gw; r < MT; r += NGW) {
        const float* xr = r < MP ? as_global(A_k->in[I_XP]) + (size_t)r * DM : as_global(A_k->in[I_XS]) + (size_t)(r - MP) * DM;
        bf16_t* xb = (bf16_t*)(ws + WS_XB) + (size_t)r * DM; float s = 0.f;
#pragma unroll
        for (int j = 0; j < 8; ++j) { const f32x4 v = *(const f32x4*)(xr + (64 * j + lane) * 4); s += (v[0] * v[0] + v[1] * v[1]) + (v[2] * v[2] + v[3] * v[3]);
            u32x2 o; o.x = cvt_pk_bf16(v[0], v[1]); o.y = cvt_pk_bf16(v[2], v[3]); *(u32x2*)(xb + (64 * j + lane) * 4) = o; }
        s = wave_sum(s); if (lane == 0) ((float*)(ws + WS_RSTD))[r] = rsqrtf(s * (1.0f / DM) + EPS);
    }
}
#define EPI_ROWS(u) { const int _l = lane_id(); fr = _l & 15; fq = _l >> 4; } const int row0 = (u).pm * 256 + wr * 64 + fr
#define EPI_ROW(ai, m) (row0 + (ai) * 128 + (m) * 16)

struct EpiInA {
    static constexpr bool PERM = false, PRE = true;
    unsigned char* ws; float* out; int li; LAS unsigned char* lds;
    __device__ __forceinline__ void pre(LAS unsigned char* l, const pg8::Unit& u, int wid) const {
        if (wid == 4) { const float* src = (const float*)(ws + WS_RSTD) + (size_t)(4 * li) * MT + u.pm * 256 + lane_id() * 4;
            __builtin_amdgcn_global_load_lds((const unsigned*)src, (LAS unsigned*)(l + EPI_RS + u.par * 1024), 16, 0, 0); }
    }
    __device__ __forceinline__ void operator()(const f32x4 (&acc)[2][2][4][2], const pg8::Unit& u, int wr, int wc, int fr, int fq) const {
        EPI_ROWS(u); const int pn = u.pn, cb = wc * 32 + 4 * fq;
        const LAS float* rsl = (const LAS float*)(lds + EPI_RS + u.par * 1024) + wr * 64 + fr; float* ssqq = (float*)(ws + WS_SSQQ) + (size_t)(li * 8 + (pn & 1) * 4 + wc) * MT; float* ssqkv = (float*)(ws + WS_SSQKV) + (size_t)(li * 8 + (pn & 1) * 4 + wc) * MT;
        bf16_t* cqb = (bf16_t*)(ws + WS_CQB); bf16_t* zb = (bf16_t*)(ws + WS_ZB);
#pragma unroll
        for (int ai = 0; ai < 2; ++ai)
#pragma unroll
            for (int m = 0; m < 4; ++m) {
                const int r = EPI_ROW(ai, m); const float rs = rsl[ai * 128 + m * 16];
                f32x4 v[2][2]; float sq = 0.f;
#pragma unroll
                for (int bj = 0; bj < 2; ++bj)
#pragma unroll
                    for (int n = 0; n < 2; ++n) { v[bj][n] = acc[ai][bj][m][n] * rs; sq += (v[bj][n][0] * v[bj][n][0] + v[bj][n][1] * v[bj][n][1]) + (v[bj][n][2] * v[bj][n][2] + v[bj][n][3] * v[bj][n][3]); }
                if (pn < 2) {
                    bf16_t* o = cqb + (size_t)r * QR + pn * 256 + cb;
#pragma unroll
                    for (int bj = 0; bj < 2; ++bj)
#pragma unroll
                        for (int n = 0; n < 2; ++n) { u32x2 w; w.x = cvt_pk_bf16(v[bj][n][0], v[bj][n][1]); w.y = cvt_pk_bf16(v[bj][n][2], v[bj][n][3]); *(u32x2*)(o + bj * 128 + n * 16) = w; }
                    sq = row4_sum(sq); if (fq == 0) ssqq[r] = sq;
                } else if (pn < 4) {
                    float* o = (r < MP ? out + O_LATP + ((size_t)li * MP + r) * KVR : out + O_LATS + ((size_t)li * MS + (r - MP)) * KVR) + (pn - 2) * 256 + cb;
#pragma unroll
                    for (int bj = 0; bj < 2; ++bj)
#pragma unroll
                        for (int n = 0; n < 2; ++n) *(f32x4*)(o + bj * 128 + n * 16) = v[bj][n];
                    sq = row4_sum(sq); if (fq == 0) ssqkv[r] = sq;
                } else if (pn < 8) {
                    bf16_t* o = zb + (size_t)r * POOLW + (pn - 4) * 256 + cb;
#pragma unroll
                    for (int bj = 0; bj < 2; ++bj)
#pragma unroll
                        for (int n = 0; n < 2; ++n) { u32x2 w; w.x = cvt_pk_bf16(v[bj][n][0], v[bj][n][1]); w.y = cvt_pk_bf16(v[bj][n][2], v[bj][n][3]); *(u32x2*)(o + bj * 128 + n * 16) = w; }
                    float* po = nullptr;
                    if (r < MP) { const int t = r & (SEQ - 1); if (t >= SEQ - POOLKEEP) po = out + O_POOLP + (((size_t)li * BATCH + (r >> 11)) * POOLKEEP + (t - (SEQ - POOLKEEP))) * POOLW; }
                    else { const int rr = r - MP, t = rr & (DECS - 1); if (t >= DECS - POOLKEEP) po = out + O_POOLS + (((size_t)li * DECB + (rr >> 6)) * POOLKEEP + (t - (DECS - POOLKEEP))) * POOLW; }
                    if (po) { po += (pn - 4) * 256 + cb;
#pragma unroll
                        for (int bj = 0; bj < 2; ++bj)
#pragma unroll
                            for (int n = 0; n < 2; ++n) *(f32x4*)(po + bj * 128 + n * 16) = v[bj][n]; }
                } else {
                    float* o = (r < MP ? out + O_KPEP + ((size_t)li * MP + r) * ROPE : out + O_KPES + ((size_t)li * MS + (r - MP)) * ROPE) + cb;
                    if (cb < 64) {
#pragma unroll
                        for (int n = 0; n < 2; ++n) *(f32x4*)(o + n * 16) = v[0][n]; }
                }
            }
    }
};

__device__ __forceinline__ void post_a_phase(const Frame& F, KArgs* A_, int li) {
    const int lane = lau_v(lane_id()); struct { unsigned char* ws; float* out; } A{lau_s(A_->ws), lau_s(A_->out)};
    const int gw = lau_si(F.vcu * NWAVES + F.wave), NGW = F.G * NWAVES;
    const float* ssqkv = (const float*)(A.ws + WS_SSQKV) + (size_t)li * 8 * MT; const float* gk = as_global(A_->in[I_GKVA]) + (size_t)li * KVR;
    bf16_t* kvn = (bf16_t*)(A.ws + WS_KVN); bf16_t* kp = (bf16_t*)(A.ws + WS_KP); const f32x2* rope = (const f32x2*)(A.ws + WS_ROPE);
    const f32x4 g0 = *(const f32x4*)(gk + lane * 8), g1 = *(const f32x4*)(gk + lane * 8 + 4);
    for (int r = gw; r < MT; r += NGW) {
        float sk = 0.f;
#pragma unroll
        for (int s = 0; s < 8; ++s) sk += ssqkv[(size_t)s * MT + r];
        const float rs = rsqrtf(sk * (1.0f / KVR) + EPS);
        float* lp = (r < MP ? A.out + O_LATP + ((size_t)li * MP + r) * KVR : A.out + O_LATS + ((size_t)li * MS + (r - MP)) * KVR) + lane * 8;
        f32x4 a = *(const f32x4*)lp, b = *(const f32x4*)(lp + 4); a = a * rs * g0; b = b * rs * g1;
        *(f32x4*)lp = a; *(f32x4*)(lp + 4) = b;
        u32x4 o; o.x = cvt_pk_bf16(a[0], a[1]); o.y = cvt_pk_bf16(a[2], a[3]); o.z = cvt_pk_bf16(b[0], b[1]); o.w = cvt_pk_bf16(b[2], b[3]);
        *(u32x4*)(kvn + (size_t)r * KVW + lane * 8) = o;
        float* kq = (r < MP ? A.out + O_KPEP + ((size_t)li * MP + r) * ROPE : A.out + O_KPES + ((size_t)li * MS + (r - MP)) * ROPE);
        if (lane < 32) {
            const float x1 = kq[lane], x2 = kq[32 + lane]; const f32x2 cs = rope[(size_t)rope_row(r) * 32 + lane];
            const float o1 = x1 * cs.x - x2 * cs.y, o2 = x1 * cs.y + x2 * cs.x;
            kq[lane] = o1; kq[32 + lane] = o2;
            const unsigned pk = cvt_pk_bf16(o1, o2);
            *(unsigned*)(kvn + (size_t)r * KVW + KVR + 2 * lane) = pk;
            if (r < MP) {
#pragma unroll
                for (int h = 0; h < HEADS; ++h) *(unsigned*)(kp + ((size_t)r * HEADS + h) * QKD + NOPE + 2 * lane) = pk; }
        }
    }
}

__device__ __forceinline__ void pool_prep_phase(const Frame& F, KArgs* A_, int li) {
    const int lane = lau_v(lane_id()); struct { unsigned char* ws; } A{lau_s(A_->ws)};
    const int gw = lau_si(F.vcu * NWAVES + F.wave), NGW = F.G * NWAVES;
    const size_t gt = (size_t)gw * 64 + lane, NGT = (size_t)NGW * 64;
    const bf16_t* zb = (const bf16_t*)(A.ws + WS_ZB); bf16_t* pb = (bf16_t*)(A.ws + WS_PB);
    const float* sp = as_global(A_->in[I_SPOOL]) + (size_t)li * DECB * POOLKEEP * POOLW;
    for (size_t it = gt; it < (size_t)(MT / 16) * 128; it += NGT) {
        const int rb = (int)(it / 128), cg = (int)(it % 128), col = cg * 8, w = 2 << (cg >> 5);
        const int r0 = rb * 16; const bool prompt = r0 < MP;
        const int t0 = prompt ? (r0 & (SEQ - 1)) : ((r0 - MP) & (DECS - 1)); const int seqrow0 = r0 - t0;
        const int bs = prompt ? 0 : (r0 - MP) >> 6;
        float sum[8];
#pragma unroll
        for (int e = 0; e < 8; ++e) sum[e] = 0.f;
        auto loadz = [&](int t, float (&z)[8]) {
            if (t >= 0) { const u32x4 q = *(const u32x4*)(zb + (size_t)(seqrow0 + t) * POOLW + col);
                z[0] = bf_lo(q.x); z[1] = bf_hi(q.x); z[2] = bf_lo(q.y); z[3] = bf_hi(q.y); z[4] = bf_lo(q.z); z[5] = bf_hi(q.z); z[6] = bf_lo(q.w); z[7] = bf_hi(q.w); }
            else if (prompt) {
#pragma unroll
                for (int e = 0; e < 8; ++e) z[e] = 0.f; }
            else { const float* s = sp + ((size_t)bs * POOLKEEP + (POOLKEEP + t)) * POOLW + col; const f32x4 a = *(const f32x4*)s, b = *(const f32x4*)(s + 4);
                z[0] = a[0]; z[1] = a[1]; z[2] = a[2]; z[3] = a[3]; z[4] = b[0]; z[5] = b[1]; z[6] = b[2]; z[7] = b[3]; }
        };
        for (int j = 1; j < w; ++j) { float z[8]; loadz(t0 - j, z);
#pragma unroll
            for (int e = 0; e < 8; ++e) sum[e] += z[e]; }
        for (int tt = 0; tt < 16; ++tt) {
            const int t = t0 + tt; float z[8], zo[8]; loadz(t, z); loadz(t - w + 1, zo);
            const float cnt = prompt ? (float)((t + 1) < w ? (t + 1) : w) : (float)w; const float ic = 1.0f / cnt;
            float p[8];
#pragma unroll
            for (int e = 0; e < 8; ++e) { sum[e] += z[e]; p[e] = sum[e] * ic - z[e]; sum[e] -= zo[e]; }
            u32x4 o; o.x = cvt_pk_bf16(p[0], p[1]); o.y = cvt_pk_bf16(p[2], p[3]); o.z = cvt_pk_bf16(p[4], p[5]); o.w = cvt_pk_bf16(p[6], p[7]);
            *(u32x4*)(pb + (size_t)(r0 + tt) * POOLW + col) = o;
        }
    }
}
__device__ __forceinline__ u32x4 pack8(const f32x4 a, const f32x4 b) { u32x4 w; w.x = cvt_pk_bf16(a[0], a[1]); w.y = cvt_pk_bf16(a[2], a[3]); w.z = cvt_pk_bf16(b[0], b[1]); w.w = cvt_pk_bf16(b[2], b[3]); return w; }

template <int MODE> struct EpiStore {
    static constexpr bool PERM = true, PRE = false;
    unsigned char* ws;
    __device__ __forceinline__ void operator()(const f32x4 (&acc)[2][2][4][2], const pg8::Unit& u, int wr, int wc, int fr, int fq) const {
        EPI_ROWS(u); const int cl = wc * 32 + 8 * fq;
#pragma unroll
        for (int bj = 0; bj < 2; ++bj) {
            bf16_t* base; size_t ldc;
            if (MODE == 0) { if (u.pn < 4) { base = (bf16_t*)(ws + WS_KP) + (2 * u.pn + bj) * QKD; ldc = HEADS * QKD; } else { base = (bf16_t*)(ws + WS_VP) + (u.pn - 4) * 256 + bj * 128; ldc = HEADS * VD; } }
            else if (MODE == 1) { base = (bf16_t*)(ws + WS_QS) + (u.pn >> 1) * KVW + (u.pn & 1) * 256 + bj * 128; ldc = HEADS * KVW; }
            else if (MODE == 2) { base = (bf16_t*)(ws + WS_YCAT) + 1024 + u.pn * 256 + bj * 128; ldc = DM; }
            else { base = (bf16_t*)(ws + WS_YCAT) + (size_t)MP * DM + u.pn * 256 + bj * 128; ldc = DM; }
#pragma unroll
            for (int ai = 0; ai < 2; ++ai)
#pragma unroll
                for (int m = 0; m < 4; ++m) *(u32x4*)(base + (size_t)EPI_ROW(ai, m) * ldc + cl) = pack8(acc[ai][bj][m][0], acc[ai][bj][m][1]);
        }
    }
};

struct EpiQ {
    static constexpr bool PERM = true, PRE = true;
    unsigned char* ws; int li; LAS unsigned char* lds;
    __device__ __forceinline__ void pre(LAS unsigned char* l, const pg8::Unit& u, int wid) const {
        const float* src = (const float*)(ws + WS_SSQQ) + ((size_t)li * 8 + wid) * MT + u.pm * 256 + lane_id() * 4;
        __builtin_amdgcn_global_load_lds((const unsigned*)src, (LAS unsigned*)(l + EPI_LDS + u.par * 8192 + wid * 1024), 16, 0, 0);
    }
    __device__ __forceinline__ void operator()(const f32x4 (&acc)[2][2][4][2], const pg8::Unit& u, int wr, int wc, int fr, int fq) const {
        EPI_ROWS(u); const LAS float* sql = (const LAS float*)(lds + EPI_LDS + u.par * 8192) + wr * 64 + fr; const f32x4* rope = (const f32x4*)(ws + WS_ROPE);
        bf16_t* qp = (bf16_t*)(ws + WS_QP); bf16_t* qns = (bf16_t*)(ws + WS_QNS); bf16_t* qs = (bf16_t*)(ws + WS_QS);
        int hh[2], cc[2];
#pragma unroll
        for (int bj = 0; bj < 2; ++bj) { const int c = u.pn * 256 + bj * 128 + wc * 32 + 8 * fq; hh[bj] = c / QKD; cc[bj] = c - hh[bj] * QKD; }
        f32x4 T[2][2] = {}, Tn[2][2] = {};
#define EPIQ_ROPE(dst, ai_, m_) do { const int rr_ = rope_row(EPI_ROW(ai_, m_)); _Pragma("unroll") for (int bj = 0; bj < 2; ++bj) if (cc[bj] >= NOPE) { \
            const size_t ix_ = ((size_t)rr_ * 32 + ((cc[bj] - NOPE) >> 1)) >> 1; dst[bj][0] = rope[ix_]; dst[bj][1] = rope[ix_ + 1]; } } while (0)
        EPIQ_ROPE(T, 0, 0);
#pragma unroll
        for (int k = 0; k < 8; ++k) {
            const int ai = k >> 2, m = k & 3;
            if (k < 7) EPIQ_ROPE(Tn, (k + 1) >> 2, (k + 1) & 3);
            asm volatile("" ::: "memory");
            const int r = EPI_ROW(ai, m); float sk = 0.f;
#pragma unroll
            for (int s = 0; s < 8; ++s) sk += sql[s * 256 + ai * 128 + m * 16];
            const float rs = rsqrtf(sk * (1.0f / QR) + EPS);
#pragma unroll
            for (int bj = 0; bj < 2; ++bj) {
                const int h = hh[bj], c2 = cc[bj];
                f32x4 a = acc[ai][bj][m][0] * rs, b = acc[ai][bj][m][1] * rs;
                if (c2 >= NOPE) {
                    const f32x4 t0 = T[bj][0], t1 = T[bj][1];
                    f32x4 ra, rb;
                    ra[0] = a[0] * t0[0] - a[1] * t0[1]; ra[1] = a[0] * t0[1] + a[1] * t0[0]; ra[2] = a[2] * t0[2] - a[3] * t0[3]; ra[3] = a[2] * t0[3] + a[3] * t0[2];
                    rb[0] = b[0] * t1[0] - b[1] * t1[1]; rb[1] = b[0] * t1[1] + b[1] * t1[0]; rb[2] = b[2] * t1[2] - b[3] * t1[3]; rb[3] = b[2] * t1[3] + b[3] * t1[2];
                    a = ra; b = rb;
                }
                const u32x4 w = pack8(a, b);
                if (r < MP) *(u32x4*)(qp + ((size_t)r * HEADS + h) * QKD + c2) = w;
                else if (c2 < NOPE) *(u32x4*)(qns + (size_t)(r - MP) * 1024 + h * NOPE + c2) = w;
                else *(u32x4*)(qs + ((size_t)(r - MP) * HEADS + h) * KVW + KVR + (c2 - NOPE)) = w;
            }
#pragma unroll
            for (int bj = 0; bj < 2; ++bj) { T[bj][0] = Tn[bj][0]; T[bj][1] = Tn[bj][1]; }
        }
#undef EPIQ_ROPE
    }
};

template <int NM> struct EpiRes {
    static constexpr bool PERM = true, PRE = false;
    unsigned char* ws; const float* xp; const float* xs; int first; int nidx;
    __device__ __forceinline__ void operator()(const f32x4 (&acc)[2][2][NM][2], const pg8::Unit& u, int wr, int wc, int fr, int fq) const {
        { const int _l = lane_id(); fr = _l & 15; fq = _l >> 4; } const int row0 = u.pm * (64 * NM) + wr * (16 * NM) + fr;
        const int c0 = u.pn * 256 + wc * 32 + 8 * fq; bf16_t* XB = (bf16_t*)(ws + WS_XB); float* ssq = (float*)(ws + WS_SSQP) + (size_t)(nidx * 32 + u.pn * 4 + wc) * MT;
        u32x4 q[2][NM][2];
        if (!first) {
#pragma unroll
            for (int ai = 0; ai < 2; ++ai)
#pragma unroll
                for (int m = 0; m < NM; ++m)
#pragma unroll
                    for (int bj = 0; bj < 2; ++bj) q[ai][m][bj] = *(const u32x4*)(XB + (size_t)(row0 + ai * (32 * NM) + m * 16) * DM + c0 + bj * 128);
            asm volatile("" ::: "memory");
        }
        float sqv[2][NM];
#pragma unroll
        for (int ai = 0; ai < 2; ++ai)
#pragma unroll
            for (int m = 0; m < NM; ++m) {
                const int r = row0 + ai * (32 * NM) + m * 16; float sq = 0.f;
#pragma unroll
                for (int bj = 0; bj < 2; ++bj) { const int c = c0 + bj * 128; f32x4 a, b;
                    if (first) { const float* xo = (r < MP ? xp + (size_t)r * DM : xs + (size_t)(r - MP) * DM) + c; a = *(const f32x4*)xo; b = *(const f32x4*)(xo + 4); }
                    else { const u32x4 w = q[ai][m][bj]; a = (f32x4){bf_lo(w.x), bf_hi(w.x), bf_lo(w.y), bf_hi(w.y)}; b = (f32x4){bf_lo(w.z), bf_hi(w.z), bf_lo(w.w), bf_hi(w.w)}; }
                    a = a + acc[ai][bj][m][0]; b = b + acc[ai][bj][m][1];
                    *(u32x4*)(XB + (size_t)r * DM + c) = pack8(a, b);
                    sq += ((a[0] * a[0] + a[1] * a[1]) + (a[2] * a[2] + a[3] * a[3])) + ((b[0] * b[0] + b[1] * b[1]) + (b[2] * b[2] + b[3] * b[3])); }
                sqv[ai][m] = sq;
            }
#pragma unroll
        for (int ai = 0; ai < 2; ++ai)
#pragma unroll
            for (int m = 0; m < NM; ++m) { const float sq = row4_sum(sqv[ai][m]); if (fq == 0) ssq[row0 + ai * (32 * NM) + m * 16] = sq; }
    }
};

__device__ __forceinline__ float dpp_ror1(float x) { return __builtin_bit_cast(float, __builtin_amdgcn_update_dpp(0, __builtin_bit_cast(int, x), 0x121, 0xf, 0xf, true)); }
__device__ __forceinline__ float dpp_ror2(float x) { return __builtin_bit_cast(float, __builtin_amdgcn_update_dpp(0, __builtin_bit_cast(int, x), 0x122, 0xf, 0xf, true)); }
struct EpiUp {
    static constexpr bool PERM = true, PRE = true;
    unsigned char* ws; float* out; const float* cw; const float* cb; const float* past; LAS unsigned char* lds; int layer;
    __device__ __forceinline__ void pre(LAS unsigned char* l, const pg8::Unit& u, int wid) const {
        const int lane = lane_id();
        if (wid < 4) { const int seg = 2 * wid + (lane >> 5), bj = seg & 1; const float* src = (seg < 6 ? cw + (size_t)(seg >> 1) * DFF2 : cb) + bj * DFF + u.pn * 128 + (lane & 31) * 4;
            __builtin_amdgcn_global_load_lds((const unsigned*)src, (LAS unsigned*)(l + EPI_CW + u.par * 4096 + wid * 1024), 16, 0, 0); }
        else if (wid == 4) { const float* src = (const float*)(ws + WS_RSTD) + (size_t)(2 * layer + 1) * MT + u.pm * 256 + lane * 4;
            __builtin_amdgcn_global_load_lds((const unsigned*)src, (LAS unsigned*)(l + EPI_RS + u.par * 1024), 16, 0, 0); }
    }
    __device__ __forceinline__ void operator()(const f32x4 (&acc_)[2][2][4][2], const pg8::Unit& u, int wr, int wc, int fr, int fq) const {
        f32x4 (&acc)[2][2][4][2] = const_cast<f32x4 (&)[2][2][4][2]>(acc_);
        EPI_ROWS(u); const LAS float* rsl = (const LAS float*)(lds + EPI_RS + u.par * 1024) + wr * 64 + fr; const LAS float* cwl = (const LAS float*)(lds + EPI_CW + u.par * 4096) + wc * 32 + 8 * fq; bf16_t* act = (bf16_t*)(ws + WS_ACT); float* halo = (float*)(ws + WS_HALO) + (size_t)u.pm * 4 * DFF2;
        const int ch = u.pn * 128 + wc * 32 + 8 * fq;
        const bool prompt = u.pm < MP / 256;
        LAS float* hl = (LAS float*)(lds + EPI_LDS);
#pragma unroll
        for (int ai = 0; ai < 2; ++ai)
#pragma unroll
            for (int m = 0; m < 4; ++m) {
                const int r = EPI_ROW(ai, m); const float rs = rsl[ai * 128 + m * 16];
#pragma unroll
                for (int bj = 0; bj < 2; ++bj) { acc[ai][bj][m][0] = acc[ai][bj][m][0] * rs; acc[ai][bj][m][1] = acc[ai][bj][m][1] * rs; }
                float* so = nullptr;
                if (prompt) { const int t = r & (SEQ - 1); if (t >= SEQ - 2) so = out + O_CVP + (((size_t)layer * BATCH + (r >> 11)) * 2 + (t - (SEQ - 2))) * DFF2; }
                else { const int rr = r - MP, t = rr & (DECS - 1); if (t >= DECS - 2) so = out + O_CVS + (((size_t)layer * DECB + (rr >> 6)) * 2 + (t - (DECS - 2))) * DFF2; }
                if (so) {
#pragma unroll
                    for (int bj = 0; bj < 2; ++bj) { *(f32x4*)(so + bj * DFF + ch) = acc[ai][bj][m][0]; *(f32x4*)(so + bj * DFF + ch + 4) = acc[ai][bj][m][1]; } }
                if (m == 3 && fr >= 14) {
#pragma unroll
                    for (int bj = 0; bj < 2; ++bj) { LAS float* d = hl + ((((ai * 2 + wr) * 4 + wc) * 2 + (fr - 14)) * 4 + fq) * 16 + bj * 8; *(LAS f32x4*)d = acc[ai][bj][m][0]; *(LAS f32x4*)(d + 4) = acc[ai][bj][m][1]; } }
                if (prompt) { int sel = -1; if (ai == 0 && wr == 0 && m == 0 && fr < 2) sel = fr; if (ai == 1 && wr == 1 && m == 3 && fr >= 14) sel = fr - 12;
                    if (sel >= 0) {
#pragma unroll
                        for (int bj = 0; bj < 2; ++bj) { float* d = halo + (size_t)sel * DFF2 + bj * DFF + ch; *(f32x4*)d = acc[ai][bj][m][0]; *(f32x4*)(d + 4) = acc[ai][bj][m][1]; } } }
            }
        asm volatile("s_waitcnt lgkmcnt(0)" ::: "memory"); __builtin_amdgcn_s_barrier(); asm volatile("" ::: "memory");
#pragma unroll
        for (int ai = 0; ai < 2; ++ai) {
            const int blk0 = u.pm * 256 + ai * 128 + wr * 64;
#pragma unroll
            for (int eh = 0; eh < 2; ++eh) {
                f32x4 w[2][3], bia[2], hm1[2], hm2[2];
#pragma unroll
                for (int bj = 0; bj < 2; ++bj) {
                    const int cc = bj * DFF + ch + 4 * eh;
#pragma unroll
                    for (int j = 0; j < 3; ++j) w[bj][j] = *(const LAS f32x4*)(cwl + (2 * j + bj) * 128 + 4 * eh);
                    bia[bj] = *(const LAS f32x4*)(cwl + (6 + bj) * 128 + 4 * eh);
                    if (!prompt) { const float* ps = past + (size_t)((blk0 - MP) >> 6) * 2 * DFF2 + cc; hm2[bj] = *(const f32x4*)ps; hm1[bj] = *(const f32x4*)(ps + DFF2); }
                    else if (ai == 0 && wr == 0) { hm1[bj] = (f32x4){0.f, 0.f, 0.f, 0.f}; hm2[bj] = hm1[bj]; }
                    else { const int pb = ai * 2 + wr - 1; const LAS float* s = hl + (((pb * 4 + wc) * 2 + 0) * 4 + fq) * 16 + bj * 8 + 4 * eh; hm2[bj] = *(const LAS f32x4*)s; hm1[bj] = *(const LAS f32x4*)(s + 64); }
                }
                u32x2 pk[4]; f32x4 pr1[2], pr2[2];
#pragma unroll
                for (int bj = 0; bj < 2; ++bj)
#pragma unroll
                    for (int e = 0; e < 4; ++e) { pr1[bj][e] = hm1[bj][e]; pr2[bj][e] = (fr == 0) ? hm2[bj][e] : hm1[bj][e]; }
#pragma unroll
                for (int m = 0; m < 4; ++m) {
                    f32x4 c[2];
#pragma unroll
                    for (int bj = 0; bj < 2; ++bj) {
                        const f32x4 h0 = acc[ai][bj][m][eh]; f32x4 p1, p2;
#pragma unroll
                        for (int e = 0; e < 4; ++e) {
                            const float r1 = dpp_ror1(h0[e]), r2 = dpp_ror2(h0[e]);
                            p1[e] = (fr >= 1) ? r1 : pr1[bj][e]; p2[e] = (fr >= 2) ? r2 : pr2[bj][e];
                            pr1[bj][e] = r1; pr2[bj][e] = r2;
                        }
                        c[bj] = bia[bj] + w[bj][0] * p2 + w[bj][1] * p1 + w[bj][2] * h0;
                    }
                    f32x4 o;
#pragma unroll
                    for (int e = 0; e < 4; ++e) o[e] = silu_f(c[0][e]) * c[1][e];
                    pk[m].x = cvt_pk_bf16(o[0], o[1]); pk[m].y = cvt_pk_bf16(o[2], o[3]);
                }
#pragma unroll
                for (int m = 0; m < 4; ++m) *(u32x2*)(act + (size_t)(blk0 + 16 * m + fr) * DFF + ch + 4 * eh) = pk[m];
            }
        }
    }
};

struct EpiInC {
    static constexpr bool PERM = true, PRE = true;
    unsigned char* ws; int layer; LAS unsigned char* lds;
    __device__ __forceinline__ void pre(LAS unsigned char* l, const pg8::Unit& u, int wid) const {
        if (wid == 4) { const float* src = (const float*)(ws + WS_RSTD) + (size_t)(2 * layer) * MT + u.pm * 256 + lane_id() * 4;
            __builtin_amdgcn_global_load_lds((const unsigned*)src, (LAS unsigned*)(l + EPI_RS + u.par * 1024), 16, 0, 0); }
    }
    __device__ __forceinline__ void operator()(const f32x4 (&acc)[2][2][4][2], const pg8::Unit& u, int wr, int wc, int fr, int fq) const {
        EPI_ROWS(u); const LAS float* rsl = (const LAS float*)(lds + EPI_RS + u.par * 1024) + wr * 64 + fr; const int sec = u.pn >> 3, c0 = (u.pn & 7) * 256 + wc * 32 + 8 * fq;
        const float* lbs = (const float*)(ws + WS_LBS) + (layer >> 1) * 2048;
        f32x4 lb[2][2] = {};
        if (sec == 1) {
#pragma unroll
            for (int bj = 0; bj < 2; ++bj) { lb[bj][0] = *(const f32x4*)(lbs + c0 + bj * 128); lb[bj][1] = *(const f32x4*)(lbs + c0 + bj * 128 + 4); }
            asm volatile("" ::: "memory"); }
#pragma unroll
        for (int ai = 0; ai < 2; ++ai)
#pragma unroll
            for (int m = 0; m < 4; ++m) {
                const int r = EPI_ROW(ai, m); const float rs = rsl[ai * 128 + m * 16];
#pragma unroll
                for (int bj = 0; bj < 2; ++bj) { f32x4 a = acc[ai][bj][m][0] * rs, b = acc[ai][bj][m][1] * rs; const int c = c0 + bj * 128;
                    if (sec == 1) { const f32x4 l0 = lb[bj][0], l1 = lb[bj][1];
#pragma unroll
                        for (int e = 0; e < 4; ++e) { a[e] = (1.0f - l0[e]) * sigmoid_f(-a[e]); b[e] = (1.0f - l1[e]) * sigmoid_f(-b[e]); }
                        bf16_t* o = (bf16_t*)(ws + WS_FG) + (size_t)r * 2048 + c; *(u32x4*)o = pack8(a, b); }
                    else { if (sec != 2) {
#pragma unroll
                            for (int e = 0; e < 4; ++e) { a[e] = silu_f(a[e]); b[e] = silu_f(b[e]); } }
                        bf16_t* o = (bf16_t*)(ws + (sec == 0 ? WS_QSIL : sec == 2 ? WS_VB : WS_GS)) + (size_t)r * 2048 + c; *(u32x4*)o = pack8(a, b); }
                }
            }
    }
};

__device__ __forceinline__ void act_fix_phase(const Frame& F, KArgs* A_, int layer) {
    const int lane = lau_v(lane_id()); unsigned char* ws = lau_s(A_->ws);
    const int gw = lau_si(F.vcu * NWAVES + F.wave), NGW = F.G * NWAVES;
    const size_t gt = (size_t)gw * 64 + lane, NGT = (size_t)NGW * 64;
    const float* halo = (const float*)(ws + WS_HALO); bf16_t* act = (bf16_t*)(ws + WS_ACT);
    const float* cw = as_global(A_->in[I_CONVW]) + (size_t)layer * 3 * DFF2; const float* cbias = as_global(A_->in[I_CONVB]) + (size_t)layer * DFF2;
    constexpr int NT = MP / 256, CG = DFF / 4;
    for (size_t it = gt; it < (size_t)NT * 2 * CG; it += NGT) {
        const int pm = (int)(it / (2 * CG)), rem = (int)(it % (2 * CG)), i = rem / CG, col = (rem % CG) * 4;
        if ((pm & 7) == 0) continue;
        const float* H = halo + (size_t)pm * 4 * DFF2; const float* Hp = H - (size_t)4 * DFF2;
        const float* h0p = H + (size_t)i * DFF2; const float* h1p = i == 0 ? Hp + (size_t)3 * DFF2 : H; const float* h2p = i == 0 ? Hp + (size_t)2 * DFF2 : Hp + (size_t)3 * DFF2;
        f32x4 c[2];
#pragma unroll
        for (int s = 0; s < 2; ++s) { const int cc = s * DFF + col;
            c[s] = *(const f32x4*)(cbias + cc) + *(const f32x4*)(cw + cc) * *(const f32x4*)(h2p + cc) + *(const f32x4*)(cw + DFF2 + cc) * *(const f32x4*)(h1p + cc) + *(const f32x4*)(cw + 2 * DFF2 + cc) * *(const f32x4*)(h0p + cc); }
        u32x2 pk; pk.x = cvt_pk_bf16(silu_f(c[0][0]) * c[1][0], silu_f(c[0][1]) * c[1][1]); pk.y = cvt_pk_bf16(silu_f(c[0][2]) * c[1][2], silu_f(c[0][3]) * c[1][3]);
        *(u32x2*)(act + (size_t)(pm * 256 + i) * DFF + col) = pk;
    }
}

__device__ __forceinline__ void final_phase(const Frame& F, KArgs* A_) {
    const int lane = lau_v(lane_id()); unsigned char* ws = lau_s(A_->ws); float* out = lau_s(A_->out);
    const int gw = lau_si(F.vcu * NWAVES + F.wave), NGW = F.G * NWAVES;
    const float* rstd = (const float*)(ws + WS_RSTD) + 8 * MT; const bf16_t* XB = (const bf16_t*)(ws + WS_XB); const float* g = as_global(A_->in[I_GFINAL]);
    for (int r = gw; r < MT; r += NGW) {
        const float rs = rstd[r];
#pragma unroll
        for (int j = 0; j < 4; ++j) { const int c = (64 * j + lane) * 8; const u32x4 q = *(const u32x4*)(XB + (size_t)r * DM + c); const f32x4 g0 = *(const f32x4*)(g + c), g1 = *(const f32x4*)(g + c + 4);
            const f32x4 a = (f32x4){bf_lo(q.x), bf_hi(q.x), bf_lo(q.y), bf_hi(q.y)} * rs * g0, b = (f32x4){bf_lo(q.z), bf_hi(q.z), bf_lo(q.w), bf_hi(q.w)} * rs * g1;
            *(f32x4*)(out + (size_t)r * DM + c) = a; *(f32x4*)(out + (size_t)r * DM + c + 4) = b; }
    }
}

__device__ __forceinline__ void rstd_phase(const Frame& F, KArgs* A_, int nidx) {
    const int lane = lau_v(lane_id()); unsigned char* ws = lau_s(A_->ws);
    const int gw = lau_si(F.vcu * NWAVES + F.wave), NGW = F.G * NWAVES;
    const float* part = (const float*)(ws + WS_SSQP) + (size_t)nidx * 32 * MT; float* rstd = (float*)(ws + WS_RSTD) + (size_t)nidx * MT;
    for (int r = gw * 64 + lane; r < MT; r += NGW * 64) { float s = 0.f;
#pragma unroll 8
        for (int k = 0; k < 32; ++k) s += part[(size_t)k * MT + r];
        rstd[r] = rsqrtf(s * (1.0f / DM) + EPS); }
}
constexpr float MLA_SCALE = 0.07216878364870322f;

template <bool SAMPLE>
__device__ __forceinline__ void naive_attn_phase(const Frame& F, KArgs* A_, int li) {
    constexpr int DQ = SAMPLE ? KVW : QKD, DV = SAMPLE ? KVR : VD, NKMAX = SAMPLE ? PAST + DECS : SEQ, EV = DV / 64;
    const int lane = lau_v(lane_id()); unsigned char* ws = lau_s(A_->ws);
    const int gw = lau_si(F.vcu * NWAVES + F.wave), NGW = F.G * NWAVES;
    LAS float* qf = (LAS float*)(F.lds + F.wave * ((DQ + NKMAX) * 4)); LAS float* sc = qf + DQ;
    const int nitems = (SAMPLE ? MS : MP) * HEADS;
    for (int it = gw; it < nitems; it += NGW) {
        const int r = it >> 3, h = it & 7;
        const bf16_t* qrow; int nk, b;
        if (SAMPLE) { qrow = (const bf16_t*)(ws + WS_QS) + ((size_t)r * HEADS + h) * KVW; nk = PAST + DECS; b = r >> 6; }
        else { qrow = (const bf16_t*)(ws + WS_QP) + ((size_t)r * HEADS + h) * QKD; const int t = r & (SEQ - 1); nk = ((t >> 6) + 1) * 64; b = r >> 11; }
        for (int d = lane; d < DQ; d += 64) qf[d] = __uint_as_float(((unsigned)qrow[d]) << 16);
        LDS_WAIT(); asm volatile("" ::: "memory");
        auto krow = [&](int k) -> const bf16_t* {
            if (SAMPLE) return k < PAST ? (const bf16_t*)(ws + WS_KVC) + (((size_t)li * DECB + b) * PAST + k) * KVW : (const bf16_t*)(ws + WS_KVN) + ((size_t)MP + (size_t)b * DECS + (k - PAST)) * KVW;
            return (const bf16_t*)(ws + WS_KP) + (((size_t)b * SEQ + k) * HEADS + h) * QKD; };
        float mx = -3.0e38f;
        for (int k = lane; k < nk; k += 64) {
            const bf16_t* kr = krow(k); float dot = 0.f;
#pragma unroll 4
            for (int c = 0; c < DQ / 8; ++c) { const u32x4 w = *(const u32x4*)(kr + c * 8); const f32x4 q0 = *(const LAS f32x4*)(qf + c * 8), q1 = *(const LAS f32x4*)(qf + c * 8 + 4);
                dot += bf_lo(w.x) * q0[0] + bf_hi(w.x) * q0[1] + bf_lo(w.y) * q0[2] + bf_hi(w.y) * q0[3] + bf_lo(w.z) * q1[0] + bf_hi(w.z) * q1[1] + bf_lo(w.w) * q1[2] + bf_hi(w.w) * q1[3]; }
            dot *= MLA_SCALE; sc[k] = dot; mx = fmaxf(mx, dot);
        }
#pragma unroll
        for (int o = 1; o < 64; o <<= 1) mx = fmaxf(mx, __shfl_xor(mx, o));
        float sum = 0.f;
        for (int k = lane; k < nk; k += 64) { const float p = __expf(sc[k] - mx); sc[k] = p; sum += p; }
        sum = wave_sum(sum);
        LDS_WAIT(); asm volatile("" ::: "memory");
        float o[EV];
#pragma unroll
        for (int e = 0; e < EV; ++e) o[e] = 0.f;
        for (int k = 0; k < nk; ++k) {
            const float p = sc[k];
            const bf16_t* vr = SAMPLE ? krow(k) : (const bf16_t*)(ws + WS_VP) + (((size_t)b * SEQ + k) * HEADS + h) * VD;
            if constexpr (!SAMPLE) { const unsigned w = *(const unsigned*)(vr + lane * 2); o[0] += p * bf_lo(w); o[1] += p * bf_hi(w); }
            else { const u32x4 w = *(const u32x4*)(vr + lane * 8); o[0] += p * bf_lo(w.x); o[1] += p * bf_hi(w.x); o[2] += p * bf_lo(w.y); o[3] += p * bf_hi(w.y);
                o[4] += p * bf_lo(w.z); o[5] += p * bf_hi(w.z); o[6] += p * bf_lo(w.w); o[7] += p * bf_hi(w.w); }
        }
        const float inv = 1.0f / sum;
        if constexpr (!SAMPLE) *(unsigned*)((bf16_t*)(ws + WS_YCAT) + (size_t)r * DM + h * VD + lane * 2) = cvt_pk_bf16(o[0] * inv, o[1] * inv);
        else { u32x4 w; w.x = cvt_pk_bf16(o[0] * inv, o[1] * inv); w.y = cvt_pk_bf16(o[2] * inv, o[3] * inv); w.z = cvt_pk_bf16(o[4] * inv, o[5] * inv); w.w = cvt_pk_bf16(o[6] * inv, o[7] * inv);
            *(u32x4*)((bf16_t*)(ws + WS_OLAT) + ((size_t)r * HEADS + h) * KVR + lane * 8) = w; }
        LDS_WAIT(); asm volatile("" ::: "memory");
    }
}

__device__ __forceinline__ void naive_gla_phase(const Frame& F, KArgs* A_, int li) {
    const int lane = lau_v(lane_id()), wave = F.wave, tid = wave * 64 + lane; unsigned char* ws = lau_s(A_->ws); float* out = lau_s(A_->out);
    LAS float* fL = (LAS float*)F.lds;
    LAS float* qL = fL + 16 * 128;
    LAS float* vL = qL + 16 * 128;
    LAS float* oL = vL + 16 * 128;
    const float* FG = (const float*)(ws + WS_FG); const bf16_t* QS = (const bf16_t*)(ws + WS_QSIL); const bf16_t* VB = (const bf16_t*)(ws + WS_VB); const bf16_t* GS = (const bf16_t*)(ws + WS_GS);
    bf16_t* yc = (bf16_t*)(ws + WS_YCAT); const float* gon = as_global(A_->in[I_GONORM]) + (size_t)li * HI;
    const int col = tid & 127, kg = tid >> 7;
    const int nitems = (BATCH + DECB) * CHD;
    for (int it = F.vcu; it < nitems; it += F.G) {
        const bool prompt = it < BATCH * CHD; const int sq = prompt ? it / CHD : (it - BATCH * CHD) / CHD, h = it % CHD;
        const int row0 = prompt ? sq * SEQ : MP + sq * DECS, L = prompt ? SEQ : DECS;
        float S[32];
        float* so = prompt ? out + O_HGP + ((((size_t)li * BATCH + sq) * CHD + h) * HF) * HI : out + O_HGS + ((((size_t)li * DECB + sq) * CHD + h) * HF) * HI;
        if (prompt) {
#pragma unroll
            for (int i = 0; i < 32; ++i) S[i] = 0.f; }
        else { const float* s0 = as_global(A_->in[I_SHGRN]) + ((((size_t)li * DECB + sq) * CHD + h) * HF) * HI;
#pragma unroll
            for (int i = 0; i < 32; ++i) S[i] = s0[(size_t)(kg * 32 + i) * HI + col]; }
        for (int c0 = 0; c0 < L; c0 += 16) {
            __syncthreads();
            for (int e = tid; e < 16 * 128; e += 512) { const int tt = e >> 7, k = e & 127; const size_t g = (size_t)(row0 + c0 + tt) * 2048 + h * 128 + k;
                fL[e] = FG[g]; qL[e] = __uint_as_float(((unsigned)QS[g]) << 16); vL[e] = __uint_as_float(((unsigned)VB[g]) << 16); }
            __syncthreads();
            for (int tt = 0; tt < 16; ++tt) {
                const float v = vL[tt * 128 + col]; float acc = 0.f;
#pragma unroll
                for (int i4 = 0; i4 < 8; ++i4) { const f32x4 f4 = *(const LAS f32x4*)(fL + tt * 128 + kg * 32 + i4 * 4), q4 = *(const LAS f32x4*)(qL + tt * 128 + kg * 32 + i4 * 4);
#pragma unroll
                    for (int e = 0; e < 4; ++e) { const float f = f4[e]; S[i4 * 4 + e] = fmaxf(f, 1e-30f) * S[i4 * 4 + e] + (1.0f - f) * v; acc += q4[e] * S[i4 * 4 + e]; } }
                oL[(tt * 4 + kg) * 128 + col] = acc;
            }
            __syncthreads();
            for (int tt = wave; tt < 16; tt += 8) {
                const int r = row0 + c0 + tt; float o0 = 0.f, o1 = 0.f;
#pragma unroll
                for (int g = 0; g < 4; ++g) { const f32x2 p = *(const LAS f32x2*)(oL + (tt * 4 + g) * 128 + lane * 2); o0 += p.x; o1 += p.y; }
                const float ms = wave_sum(o0 * o0 + o1 * o1) * (1.0f / HI), rs = rsqrtf(ms + EPS);
                const unsigned gw2 = *(const unsigned*)(GS + (size_t)r * 2048 + h * 128 + lane * 2); const f32x2 gn = *(const f32x2*)(gon + lane * 2);
                *(unsigned*)(yc + (size_t)r * DM + h * 128 + lane * 2) = cvt_pk_bf16(o0 * rs * gn.x * bf_lo(gw2), o1 * rs * gn.y * bf_hi(gw2));
            }
        }
#pragma unroll
        for (int i = 0; i < 32; ++i) so[(size_t)(kg * 32 + i) * HI + col] = S[i];
    }
}
namespace attnp {
constexpr int NW = 8, QBLK = 32, KVBLK = 64, DQK = QKD, DVV = VD, ND0 = DQK / 16;
constexpr int LDQ = HEADS * QKD, LDKK = HEADS * QKD, LDV = HEADS * VD, LDO = DM;
constexpr size_t SHM_V = KVBLK * DVV * 2, SHM_K = KVBLK * DQK * 2;
constexpr size_t SHM_ATTN = 2 * SHM_V + 2 * SHM_K + NW * 64 * 4;
constexpr float C_EXP = MLA_SCALE * 1.4426950408889634f;
constexpr float THR = 8.f;
#define AP_KSWZ(row, colB) ((row) * 384 + ((colB) ^ ((((row) >> 1) & 7) << 4)))
#define AP_SBAR() __builtin_amdgcn_sched_barrier(0)
__device__ __forceinline__ int crow(int r, int hi) { return (r & 3) + 8 * (r >> 2) + 4 * hi; }

__device__ __forceinline__ void partialSM(f32x16& p0, f32x16& p1, float& m_reg, float& mn, float& alpha) {
  float pmax = p0[0];
#pragma unroll
  for (int r = 1; r < 16; ++r) pmax = fmaxf(pmax, p0[r]);
#pragma unroll
  for (int r = 0; r < 16; ++r) pmax = fmaxf(pmax, p1[r]);
  { auto rr = __builtin_amdgcn_permlane32_swap(__float_as_uint(pmax), __float_as_uint(pmax), false, false);
    pmax = fmaxf(__uint_as_float(rr[0]), __uint_as_float(rr[1])); }
  if (__builtin_expect(__all(pmax - m_reg <= THR / MLA_SCALE), 1)) { mn = m_reg; alpha = 1.f; }
  else { mn = fmaxf(m_reg, pmax); alpha = __builtin_amdgcn_exp2f((m_reg - mn) * C_EXP); m_reg = mn; }
  const float mnC = -mn * C_EXP;
#pragma unroll
  for (int r = 0; r < 16; ++r) p0[r] = fmaf(p0[r], C_EXP, mnC);
#pragma unroll
  for (int r = 0; r < 16; ++r) p1[r] = fmaf(p1[r], C_EXP, mnC);
#pragma unroll
  for (int r = 0; r < 16; ++r) p0[r] = __builtin_amdgcn_exp2f(p0[r]);
}
__device__ __forceinline__ void finishSM(f32x16& p0, f32x16& p1, float alpha, float& l_reg, bf16x8& pa0, bf16x8& pa1, bf16x8& pa2, bf16x8& pa3) {
#pragma unroll
  for (int r = 0; r < 16; ++r) p1[r] = __builtin_amdgcn_exp2f(p1[r]);
  float ps = 0;
#pragma unroll
  for (int r = 0; r < 16; ++r) ps += p0[r];
#pragma unroll
  for (int r = 0; r < 16; ++r) ps += p1[r];
  { auto rr = __builtin_amdgcn_permlane32_swap(__float_as_uint(ps), __float_as_uint(ps), false, false);
    ps = __uint_as_float(rr[0]) + __uint_as_float(rr[1]); }
  l_reg = l_reg * alpha + ps;
#define AP_PK4(P, BASE, OUT) do { unsigned a0 = cvt_pk_bf16(P[BASE + 0], P[BASE + 1]), a1 = cvt_pk_bf16(P[BASE + 2], P[BASE + 3]);   \
    unsigned b0 = cvt_pk_bf16(P[BASE + 4], P[BASE + 5]), b1 = cvt_pk_bf16(P[BASE + 6], P[BASE + 7]);                              \
    auto r0 = __builtin_amdgcn_permlane32_swap(a0, b0, false, false); auto r1 = __builtin_amdgcn_permlane32_swap(a1, b1, false, false); \
    u32x4 w = {r0[0], r1[0], r0[1], r1[1]}; OUT = *reinterpret_cast<bf16x8*>(&w); } while (0)
  AP_PK4(p0, 0, pa0); AP_PK4(p0, 8, pa1); AP_PK4(p1, 0, pa2); AP_PK4(p1, 8, pa3);
#undef AP_PK4
}
__device__ __forceinline__ void qkt(f32x16& p0, f32x16& p1, const char* Ks, const bf16x8* qr, const int (&kb)[4]) {
  p0 = f32x16{}; p1 = f32x16{};
  bf16x8 kf[3][2];
#define QK_LD(set_, d_) do { kf[set_][0] = *reinterpret_cast<const bf16x8*>(Ks + kb[(d_) & 3] + ((d_) >> 2) * 128); kf[set_][1] = *reinterpret_cast<const bf16x8*>(Ks + kb[(d_) & 3] + ((d_) >> 2) * 128 + 32 * 384); } while (0)
  QK_LD(0, 0); QK_LD(1, 1);
#pragma unroll
  for (int d0 = 0; d0 < ND0; ++d0) {
    if (d0 + 2 < ND0) QK_LD((d0 + 2) % 3, d0 + 2);
    __builtin_amdgcn_sched_barrier(0);
    p0 = __builtin_amdgcn_mfma_f32_32x32x16_bf16(kf[d0 % 3][0], qr[d0], p0, 0, 0, 0);
    p1 = __builtin_amdgcn_mfma_f32_32x32x16_bf16(kf[d0 % 3][1], qr[d0], p1, 0, 0, 0);
    __builtin_amdgcn_sched_barrier(0); }
#undef QK_LD
}
__device__ __forceinline__ int v_st(int k, int c) { const int kk = (k & ~0xC) | ((k & 4) << 1) | ((k & 8) >> 1); return ((kk >> 3) * 4 + (c >> 5)) * 512 + ((kk & 7) * 32 + (c & 31)) * 2; }
__device__ __forceinline__ int v_rd_base(int lane) { return ((lane & 3) << 3) | (((lane >> 2) & 3) << 6) | (((lane >> 4) & 1) << 5) | (((lane >> 5) & 1) << 8); }
constexpr int v_rd_off(int d0, int ks, int half) { return d0 * 512 + ks * 4096 + half * 2048; }
template <int OFF> __device__ __forceinline__ s16x4 tr_read(int vb) {
  s16x4 r; asm volatile("ds_read_b64_tr_b16 %0, %1 offset:%2" : "=&v"(r) : "v"(vb), "i"(OFF) : "memory"); return r;
}
template <int D0> __device__ __forceinline__ void pv_one(f32x16& od, int vb, bf16x8 pa0, bf16x8 pa1, bf16x8 pa2, bf16x8 pa3) {
  const s16x4 l0 = tr_read<v_rd_off(D0, 0, 0)>(vb), h0 = tr_read<v_rd_off(D0, 0, 1)>(vb), l1 = tr_read<v_rd_off(D0, 1, 0)>(vb), h1 = tr_read<v_rd_off(D0, 1, 1)>(vb);
  const s16x4 l2 = tr_read<v_rd_off(D0, 2, 0)>(vb), h2 = tr_read<v_rd_off(D0, 2, 1)>(vb), l3 = tr_read<v_rd_off(D0, 3, 0)>(vb), h3 = tr_read<v_rd_off(D0, 3, 1)>(vb);
  asm volatile("s_waitcnt lgkmcnt(0)" ::: "memory"); AP_SBAR();
#define AP_PK(L, H) (bf16x8){L[0], L[1], L[2], L[3], H[0], H[1], H[2], H[3]}
  od = __builtin_amdgcn_mfma_f32_32x32x16_bf16(pa0, AP_PK(l0, h0), od, 0, 0, 0);
  od = __builtin_amdgcn_mfma_f32_32x32x16_bf16(pa1, AP_PK(l1, h1), od, 0, 0, 0);
  od = __builtin_amdgcn_mfma_f32_32x32x16_bf16(pa2, AP_PK(l2, h2), od, 0, 0, 0);
  od = __builtin_amdgcn_mfma_f32_32x32x16_bf16(pa3, AP_PK(l3, h3), od, 0, 0, 0);
#undef AP_PK
}
__device__ __forceinline__ void pv_d0(f32x16* o, int vb, bf16x8 pa0, bf16x8 pa1, bf16x8 pa2, bf16x8 pa3) {
  pv_one<0>(o[0], vb, pa0, pa1, pa2, pa3); pv_one<1>(o[1], vb, pa0, pa1, pa2, pa3); pv_one<2>(o[2], vb, pa0, pa1, pa2, pa3); pv_one<3>(o[3], vb, pa0, pa1, pa2, pa3);
}

__device__ __forceinline__ void unit(const bf16_t* __restrict__ Qb, const bf16_t* __restrict__ Kh, const bf16_t* __restrict__ Vh, bf16_t* __restrict__ Ob, int qt, char* lds, int wid, int lane) {
  const int tid = wid * 64 + lane, r32 = lane & 31, hi = lane >> 5;
  char* V_lds = lds; char* K_lds = lds + 2 * SHM_V;
  float* wsf = (float*)(lds + 2 * SHM_V + 2 * SHM_K) + wid * 64; float* li_l = wsf; float* al_l = wsf + 32;
  float m_reg = -1e30f, l_reg = 0; f32x16 o[4] = {}; bf16x8 qr[ND0];
  const bf16_t* Qw = Qb + (long)(wid * QBLK + r32) * LDQ + hi * 8;
#pragma unroll
  for (int d0 = 0; d0 < ND0; ++d0) qr[d0] = *reinterpret_cast<const bf16x8*>(Qw + d0 * 16);
  const int cq = 4 * qt + (wid >> 1);
  int kb[4];
#pragma unroll
  for (int q = 0; q < 4; ++q) kb[q] = r32 * 384 + ((q * 32 + hi * 16) ^ (((r32 >> 1) & 7) << 4));
  const int NT = 4 * qt + 4;
  const int sr = tid >> 4, sc = (tid & 15) * 8, vst0 = v_st(sr, sc), vst1 = v_st(32 + sr, sc);
  const unsigned vo0 = (unsigned)(sr * LDV + sc) * 2u, vo1 = (unsigned)((32 + sr) * LDV + sc) * 2u;
  unsigned ko[3]; int kst[3];
#pragma unroll
  for (int j = 0; j < 3; ++j) { const int c = tid + 512 * j, kr = c / 24, kc = c % 24; ko[j] = (unsigned)(kr * LDKK + kc * 8) * 2u; kst[j] = AP_KSWZ(kr, kc * 16); }
  const int vb0 = (int)(uintptr_t)V_lds + v_rd_base(lane);
  bf16x8 vs0, vs1, ks0, ks1, ks2;
#define AP_SLOAD(k0) do { const char* vt_ = (const char*)Vh + (size_t)(k0) * (LDV * 2); const char* kt_ = (const char*)Kh + (size_t)(k0) * (LDKK * 2); \
    vs0 = *reinterpret_cast<const bf16x8*>(vt_ + vo0); vs1 = *reinterpret_cast<const bf16x8*>(vt_ + vo1); \
    ks0 = *reinterpret_cast<const bf16x8*>(kt_ + ko[0]); ks1 = *reinterpret_cast<const bf16x8*>(kt_ + ko[1]); ks2 = *reinterpret_cast<const bf16x8*>(kt_ + ko[2]); } while (0)
#define AP_SWRITE(b) do { *(bf16x8*)(V_lds + (b) * SHM_V + vst0) = vs0; *(bf16x8*)(V_lds + (b) * SHM_V + vst1) = vs1; \
    *(bf16x8*)(K_lds + (b) * SHM_K + kst[0]) = ks0; *(bf16x8*)(K_lds + (b) * SHM_K + kst[1]) = ks1; *(bf16x8*)(K_lds + (b) * SHM_K + kst[2]) = ks2; } while (0)
#define AP_RESC(a) do { if (__any((a) < 1.f)) { if (hi == 0) al_l[r32] = (a); asm volatile("s_waitcnt lgkmcnt(0)" ::: "memory"); \
    _Pragma("unroll") for (int d = 0; d < 4; ++d) _Pragma("unroll") for (int r = 0; r < 16; ++r) o[d][r] *= al_l[crow(r, hi)]; } } while (0)
#define AP_MASK(pa, pb, j) do { if ((j) > cq) { _Pragma("unroll") for (int r = 0; r < 16; ++r) { pa[r] = -1e30f; pb[r] = -1e30f; } } } while (0)
  f32x16 p0, p1; float mn, al; bf16x8 pa0, pa1, pa2, pa3;
  AP_SLOAD(0); asm volatile("s_waitcnt vmcnt(0)" ::: "memory"); AP_SWRITE(0); __syncthreads();
#pragma unroll 1
  for (int j = 0; j < NT; ++j) {
    const int bsel = j & 1;
    if (j + 1 < NT) AP_SLOAD((j + 1) * KVBLK);
    AP_SBAR(); qkt(p0, p1, K_lds + bsel * SHM_K, qr, kb); AP_MASK(p0, p1, j);
    partialSM(p0, p1, m_reg, mn, al); AP_RESC(al);
    finishSM(p0, p1, al, l_reg, pa0, pa1, pa2, pa3); AP_SBAR();
    pv_d0(o, vb0 + bsel * (int)SHM_V, pa0, pa1, pa2, pa3);
    if (j + 1 < NT) { asm volatile("s_waitcnt vmcnt(0)" ::: "memory"); AP_SWRITE(bsel ^ 1); }
    __syncthreads();
  }
  if (hi == 0) li_l[r32] = l_reg; asm volatile("s_waitcnt lgkmcnt(0)" ::: "memory");
  float rli[16];
#pragma unroll
  for (int r = 0; r < 16; ++r) rli[r] = __builtin_amdgcn_rcpf(li_l[crow(r, hi)]);
  char* Ow = (char*)(Ob + (size_t)(wid * QBLK) * LDO); const int le = lau_v(lane), r32e = le & 31, hie = le >> 5;
#pragma unroll
  for (int r = 0; r < 16; ++r) { const unsigned oo = (unsigned)(crow(r, hie) * LDO + r32e) * 2u;
#pragma unroll
    for (int d0 = 0; d0 < 4; ++d0) *(bf16_t*)(Ow + oo + d0 * 64) = (bf16_t)(cvt_pk_bf16(o[d0][r] * rli[r], 0.f) & 0xffffu); }
#undef AP_SLOAD
#undef AP_SWRITE
#undef AP_RESC
#undef AP_MASK
}
}

__device__ __forceinline__ void attn_prompt_phase(const Frame& F, KArgs* A_, int first_wg) {
  const int lane = lau_v(lane_id()); unsigned char* ws = lau_s(A_->ws);
  const int w = F.vcu - first_wg; if (w < 0 || w >= 256) return;
  const int bh = w >> 2, p = w & 3, b = bh >> 3, h = bh & 7;
  const bf16_t* Qp = (const bf16_t*)(ws + WS_QP); const bf16_t* Kp = (const bf16_t*)(ws + WS_KP); const bf16_t* Vp = (const bf16_t*)(ws + WS_VP); bf16_t* Y = (bf16_t*)(ws + WS_YCAT);
  const bf16_t* Kh = Kp + ((size_t)b * SEQ * HEADS + h) * QKD; const bf16_t* Vh = Vp + ((size_t)b * SEQ * HEADS + h) * VD;
#pragma unroll 1
  for (int s = 0; s < 2; ++s) { const int qt = s == 0 ? 7 - p : p; const size_t row0 = (size_t)b * SEQ + (size_t)qt * 256;
    attnp::unit(Qp + (row0 * HEADS + h) * QKD, Kh, Vh, Y + row0 * DM + h * VD, qt, (char*)F.lds, F.wave, lane); }
}
namespace attns {
constexpr int QIMG = 0, KIMG = 65536, KPE = KIMG + 65536, SX = KIMG + 73728, SXLD = 272, WSCR = SX + 64 * SXLD, LDS_END = WSCR + 8 * 256;
static_assert(LDS_END <= RING_BYTES, "sample attention LDS");
constexpr float C_EXP = MLA_SCALE * 1.4426950408889634f, THR = 8.f;
__device__ __forceinline__ unsigned off_b(unsigned row, unsigned ch) { return 256u * row + 16u * (ch ^ (((row & 3) << 2) | ((row >> 2) & 3))); }
__device__ __forceinline__ int crow(int r, int hi) { return (r & 3) + 8 * (r >> 2) + 4 * hi; }
template <int OFF> __device__ __forceinline__ s16x4 tr_read(int vb) { s16x4 r; asm volatile("ds_read_b64_tr_b16 %0, %1 offset:%2" : "=&v"(r) : "v"(vb), "i"(OFF) : "memory"); return r; }

__device__ __forceinline__ void unit(const bf16_t* __restrict__ Qs_bh  , const float* __restrict__ Clat  , const float* __restrict__ Ckpe  , const bf16_t* __restrict__ Kn  ,
                                     const bf16_t* __restrict__ Wv  , bf16_t* __restrict__ Yb  , char* lds, int wid, int lane) {
  const int tid = wid * 64 + lane, qh = wid >> 2, cq = wid & 3, l15 = lane & 15, g4 = lane >> 4, r32 = lane & 31, hi = lane >> 5;
  float* wsf = (float*)(lds + WSCR) + wid * 64; float* li_l = wsf; float* al_l = wsf + 32;
#pragma unroll
  for (int j = 0; j < 8; ++j) { const int c = lau_v(tid) + 512 * j, q = c >> 6, ch = c & 63;
    *(bf16x8*)(lds + QIMG + (ch >> 4) * 16384 + off_b(q, ch & 15)) = *reinterpret_cast<const bf16x8*>(Qs_bh + (size_t)q * (HEADS * KVW) + ch * 8); }
  bf16x8 qpe[2][2];
#pragma unroll
  for (int sb = 0; sb < 2; ++sb)
#pragma unroll
    for (int s2 = 0; s2 < 2; ++s2) { const int lq = lau_v(lane); qpe[sb][s2] = *reinterpret_cast<const bf16x8*>(Qs_bh + (unsigned)((32 * qh + 16 * sb + (lq & 15)) * (HEADS * KVW) + KVR + 32 * s2 + 8 * (lq >> 4))); }
  int kb0, qb0, xsh, kpb[2];
  { const int ln2 = lau_v(lane), l15b = ln2 & 15, g4b = ln2 >> 4; const int krow_ = 16 * cq + l15b, qrow_ = 32 * qh + l15b, clo = 16 * (g4b ^ ((l15b >> 2) & 3));
    kb0 = KIMG + 256 * krow_ + clo; qb0 = QIMG + 256 * qrow_ + clo; xsh = (l15b & 3) << 6;
#pragma unroll
    for (int s = 0; s < 2; ++s) kpb[s] = KPE + krow_ * 128 + 16 * ((4 * s + g4b) ^ (krow_ & 7)); }
  int vb[2], q4s;
  { const int blk = (lane >> 4) & 1, q4 = (lane & 15) >> 2, p4 = lane & 3, c0 = 2 * blk + (p4 >> 1);
    q4s = q4 << 6;
#pragma unroll
    for (int t = 0; t < 2; ++t) vb[t] = (int)(uintptr_t)lds + KIMG + cq * 16384 + 256 * (8 * hi + 4 * t + q4) + 16 * (c0 ^ ((2 * hi + t) & 3)) + 8 * (p4 & 1); }
  const int sxw = SX + (32 * qh + l15) * SXLD + (16 * cq + 4 * g4) * 4;
  const int sxr = SX + (32 * qh + r32) * SXLD + (8 * hi) * 4;
  constexpr int NT = (PAST + DECS) / 64;
  constexpr int N1 = 4, N2 = 8 - N1;
  bf16x8 cv[9]; f32x4 r1a[N1], r1b[N1], r2a[N2 + 1], r2b[N2 + 1];
#define AS_CVL(A, B) ({ u32x4 w_; w_.x = cvt_pk_bf16(A[0], A[1]); w_.y = cvt_pk_bf16(A[2], A[3]); w_.z = cvt_pk_bf16(B[0], B[1]); w_.w = cvt_pk_bf16(B[2], B[3]); *reinterpret_cast<bf16x8*>(&w_); })
#define AS_CVP(A, B) ({ u32x4 w_; w_.x = cvt_pk_bf16(A[0], B[0]); w_.y = cvt_pk_bf16(A[1], B[1]); w_.z = cvt_pk_bf16(A[2], B[2]); w_.w = cvt_pk_bf16(A[3], B[3]); *reinterpret_cast<bf16x8*>(&w_); })
#define AS_BC(x) (*reinterpret_cast<const bf16x8*>(&(x)))
#define AS_LD1(j_) do { if ((j_) < PAST / 64) { const unsigned tl_ = (unsigned)lau_v(tid) * 32u; const char* tb_ = (const char*)(Clat + (size_t)(j_) * (64 * KVR)); \
      _Pragma("unroll") for (int i_ = 0; i_ < N1; ++i_) { r1a[i_] = *(const f32x4*)(tb_ + (tl_ + 16384u * i_)); r1b[i_] = *(const f32x4*)(tb_ + (tl_ + 16384u * i_ + 16u)); } } \
    else { const int t2_ = lau_v(tid); _Pragma("unroll") for (int i_ = 0; i_ < N1; ++i_) { const int c_ = t2_ + 512 * i_; r1a[i_] = *reinterpret_cast<const f32x4*>(Kn + (unsigned)((c_ >> 6) * KVW + (c_ & 63) * 8)); } } } while (0)
#define AS_CV1(j_) do { if ((j_) < PAST / 64) { _Pragma("unroll") for (int i_ = 0; i_ < N1; ++i_) cv[i_] = AS_CVL(r1a[i_], r1b[i_]); } \
    else { _Pragma("unroll") for (int i_ = 0; i_ < N1; ++i_) cv[i_] = AS_BC(r1a[i_]); } } while (0)
#define AS_LD2(j_) do { const int t2_ = lau_v(tid); if ((j_) < PAST / 64) { const char* tb_ = (const char*)(Clat + (size_t)(j_) * (64 * KVR)); const float* tp_ = Ckpe + (size_t)(j_) * (64 * ROPE) + (unsigned)((t2_ >> 3) * ROPE + (t2_ & 7) * 4); \
      _Pragma("unroll") for (int i_ = 0; i_ < N2; ++i_) { r2a[i_] = *(const f32x4*)(tb_ + ((unsigned)t2_ * 32u + 16384u * (N1 + i_))); r2b[i_] = *(const f32x4*)(tb_ + ((unsigned)t2_ * 32u + 16384u * (N1 + i_) + 16u)); } \
      r2a[N2] = *(const f32x4*)tp_; r2b[N2] = *(const f32x4*)(tp_ + 32); } \
    else { _Pragma("unroll") for (int i_ = 0; i_ < N2; ++i_) { const int c_ = t2_ + 512 * (N1 + i_); r2a[i_] = *reinterpret_cast<const f32x4*>(Kn + (unsigned)((c_ >> 6) * KVW + (c_ & 63) * 8)); } \
      r2a[N2] = *reinterpret_cast<const f32x4*>(Kn + (unsigned)((t2_ >> 3) * KVW + KVR + (t2_ & 7) * 8)); } } while (0)
#define AS_CV2(j_) do { if ((j_) < PAST / 64) { _Pragma("unroll") for (int i_ = 0; i_ < N2; ++i_) cv[N1 + i_] = AS_CVL(r2a[i_], r2b[i_]); cv[8] = AS_CVP(r2a[N2], r2b[N2]); } \
    else { _Pragma("unroll") for (int i_ = 0; i_ < N2; ++i_) cv[N1 + i_] = AS_BC(r2a[i_]); cv[8] = AS_BC(r2a[N2]); } } while (0)
  float m_reg = -1e30f, l_reg = 0.f; f32x16 o[4] = {};
  AS_LD1(0); AS_LD2(0); AS_CV1(0);
#pragma unroll 1
  for (int j = 0; j < NT; ++j) {
    AS_CV2(j);
    __syncthreads();
    { const int tl = lau_v(tid);
#pragma unroll
      for (int i = 0; i < 8; ++i) { const int c = tl + 512 * i, row = c >> 6, ch = c & 63; *(bf16x8*)(lds + KIMG + (ch >> 4) * 16384 + (int)off_b(row, ch & 15)) = cv[i]; }
      { const int row = tl >> 3, cp = tl & 7; *(bf16x8*)(lds + KPE + row * 128 + 16 * (cp ^ (row & 7))) = cv[8]; } }
    __syncthreads();
    if (j + 1 < NT) AS_LD1(j + 1);
    f32x4 sa[2] = {{0.f, 0.f, 0.f, 0.f}, {0.f, 0.f, 0.f, 0.f}};
    const int xsl = lau_v(xsh);
    bf16x8 fa[2][2], fb0[2][2], fb1[2][2], fp[2];
#define AS_SLD(set, g_) do { _Pragma("unroll") for (int i_ = 0; i_ < 2; ++i_) { const int s_ = 2 * (g_) + i_; const int xs_ = (64 * (s_ & 3)) ^ xsl; \
        fa[set][i_] = *(const bf16x8*)(lds + kb0 + xs_ + (s_ >> 2) * 16384); fb0[set][i_] = *(const bf16x8*)(lds + qb0 + xs_ + (s_ >> 2) * 16384); fb1[set][i_] = *(const bf16x8*)(lds + qb0 + xs_ + (s_ >> 2) * 16384 + 4096); } } while (0)
    AS_SLD(0, 0);
#pragma unroll
    for (int g = 0; g < 8; ++g) {
      if (g < 7) AS_SLD((g + 1) & 1, g + 1); else { fp[0] = *(const bf16x8*)(lds + kpb[0]); fp[1] = *(const bf16x8*)(lds + kpb[1]); }
      __builtin_amdgcn_sched_barrier(0);
#pragma unroll
      for (int i = 0; i < 2; ++i) {
        sa[0] = __builtin_amdgcn_mfma_f32_16x16x32_bf16(fa[g & 1][i], fb0[g & 1][i], sa[0], 0, 0, 0);
        sa[1] = __builtin_amdgcn_mfma_f32_16x16x32_bf16(fa[g & 1][i], fb1[g & 1][i], sa[1], 0, 0, 0); }
      __builtin_amdgcn_sched_barrier(0);
    }
#undef AS_SLD
#pragma unroll
    for (int s = 0; s < 2; ++s) {
      sa[0] = __builtin_amdgcn_mfma_f32_16x16x32_bf16(fp[s], qpe[0][s], sa[0], 0, 0, 0);
      sa[1] = __builtin_amdgcn_mfma_f32_16x16x32_bf16(fp[s], qpe[1][s], sa[1], 0, 0, 0); }
    *(f32x4*)(lds + sxw) = sa[0]; *(f32x4*)(lds + sxw + 16 * SXLD) = sa[1];
    __syncthreads();
    if (j + 1 < NT) { AS_CV1(j + 1); AS_LD2(j + 1); }
    float sv[4][8];
#pragma unroll
    for (int ks = 0; ks < 4; ++ks) { const f32x4 x = *(const f32x4*)(lds + sxr + ks * 64), y = *(const f32x4*)(lds + sxr + ks * 64 + 16);
      sv[ks][0] = x[0]; sv[ks][1] = x[1]; sv[ks][2] = x[2]; sv[ks][3] = x[3]; sv[ks][4] = y[0]; sv[ks][5] = y[1]; sv[ks][6] = y[2]; sv[ks][7] = y[3]; }
    float pmax = sv[0][0];
#pragma unroll
    for (int ks = 0; ks < 4; ++ks)
#pragma unroll
      for (int e = 0; e < 8; ++e) pmax = fmaxf(pmax, sv[ks][e]);
    { auto rr = __builtin_amdgcn_permlane32_swap(__float_as_uint(pmax), __float_as_uint(pmax), false, false); pmax = fmaxf(__uint_as_float(rr[0]), __uint_as_float(rr[1])); }
    float mn, alpha;
    if (__builtin_expect(__all(pmax - m_reg <= THR / MLA_SCALE), 1)) { mn = m_reg; alpha = 1.f; }
    else { mn = fmaxf(m_reg, pmax); alpha = __builtin_amdgcn_exp2f((m_reg - mn) * C_EXP); m_reg = mn; }
    const float mnC = -mn * C_EXP; float ps = 0.f;
#pragma unroll
    for (int ks = 0; ks < 4; ++ks)
#pragma unroll
      for (int e = 0; e < 8; ++e) { sv[ks][e] = __builtin_amdgcn_exp2f(fmaf(sv[ks][e], C_EXP, mnC)); ps += sv[ks][e]; }
    { auto rr = __builtin_amdgcn_permlane32_swap(__float_as_uint(ps), __float_as_uint(ps), false, false); ps = __uint_as_float(rr[0]) + __uint_as_float(rr[1]); }
    l_reg = l_reg * alpha + ps;
    if (__any(alpha < 1.f)) { if (hi == 0) al_l[r32] = alpha; asm volatile("s_waitcnt lgkmcnt(0)" ::: "memory");
#pragma unroll
      for (int d = 0; d < 4; ++d)
#pragma unroll
        for (int r = 0; r < 16; ++r) o[d][r] *= al_l[crow(r, hi)]; }
    bf16x8 pa[4];
#pragma unroll
    for (int ks = 0; ks < 4; ++ks) { u32x4 w; w.x = cvt_pk_bf16(sv[ks][0], sv[ks][1]); w.y = cvt_pk_bf16(sv[ks][2], sv[ks][3]); w.z = cvt_pk_bf16(sv[ks][4], sv[ks][5]); w.w = cvt_pk_bf16(sv[ks][6], sv[ks][7]); pa[ks] = *reinterpret_cast<bf16x8*>(&w); }
    { int va0[4], va1[4]; const int q4l = lau_v(q4s);
#pragma unroll
      for (int d0 = 0; d0 < 4; ++d0) { const int xd = (64 * d0) ^ q4l; va0[d0] = vb[0] + xd; va1[d0] = vb[1] + xd; }
#define AS_PK(L, H) (bf16x8){L[0], L[1], L[2], L[3], H[0], H[1], H[2], H[3]}
#define AS_PVK(ks_) do { const s16x4 l0 = tr_read<4096 * (ks_)>(va0[0]), h0 = tr_read<4096 * (ks_)>(va1[0]), l1 = tr_read<4096 * (ks_)>(va0[1]), h1 = tr_read<4096 * (ks_)>(va1[1]); \
        const s16x4 l2 = tr_read<4096 * (ks_)>(va0[2]), h2 = tr_read<4096 * (ks_)>(va1[2]), l3 = tr_read<4096 * (ks_)>(va0[3]), h3 = tr_read<4096 * (ks_)>(va1[3]); \
        asm volatile("s_waitcnt lgkmcnt(0)" ::: "memory"); __builtin_amdgcn_sched_barrier(0); \
        o[0] = __builtin_amdgcn_mfma_f32_32x32x16_bf16(pa[ks_], AS_PK(l0, h0), o[0], 0, 0, 0); o[1] = __builtin_amdgcn_mfma_f32_32x32x16_bf16(pa[ks_], AS_PK(l1, h1), o[1], 0, 0, 0); \
        o[2] = __builtin_amdgcn_mfma_f32_32x32x16_bf16(pa[ks_], AS_PK(l2, h2), o[2], 0, 0, 0); o[3] = __builtin_amdgcn_mfma_f32_32x32x16_bf16(pa[ks_], AS_PK(l3, h3), o[3], 0, 0, 0); \
        __builtin_amdgcn_sched_barrier(0); } while (0)
      AS_PVK(0); AS_PVK(1); AS_PVK(2); AS_PVK(3);
#undef AS_PVK
#undef AS_PK
    }
  }
  if (hi == 0) li_l[r32] = l_reg; asm volatile("s_waitcnt lgkmcnt(0)" ::: "memory");
  { const int le = lau_v(lane), r32e = le & 31, hie = le >> 5;
#pragma unroll
    for (int r = 0; r < 16; ++r) { const int q = 32 * qh + crow(r, hie); const float rl = __builtin_amdgcn_rcpf(li_l[crow(r, hie)]);
#pragma unroll
      for (int d0 = 0; d0 < 4; ++d0) { const int cc = 32 * d0 + r32e;
        *(bf16_t*)(lds + QIMG + cq * 16384 + off_b(q, cc >> 3) + (cc & 7) * 2) = (bf16_t)(cvt_pk_bf16(o[d0][r] * rl, 0.f) & 0xffffu); } } }
  __syncthreads();
  { f32x4 ya[4] = {{0.f, 0.f, 0.f, 0.f}, {0.f, 0.f, 0.f, 0.f}, {0.f, 0.f, 0.f, 0.f}, {0.f, 0.f, 0.f, 0.f}};
    const bf16_t* wrow = lau_vp(Wv + (size_t)(16 * wid + (lau_v(lane) & 15)) * KVR + 8 * (lau_v(lane) >> 4));
    int ob[4];
#pragma unroll
    for (int s = 0; s < 4; ++s) { const int le2 = lau_v(lane); ob[s] = QIMG + off_b(le2 & 15, 4 * s + (le2 >> 4)); }
#pragma unroll
    for (int s = 0; s < 16; ++s) { const bf16x8 b = *reinterpret_cast<const bf16x8*>(wrow + 32 * s);
#pragma unroll
      for (int qb2 = 0; qb2 < 4; ++qb2) { const bf16x8 a = *(const bf16x8*)(lds + ob[s & 3] + (s >> 2) * 16384 + qb2 * 4096); ya[qb2] = __builtin_amdgcn_mfma_f32_16x16x32_bf16(a, b, ya[qb2], 0, 0, 0); } }
    { const int l2 = lau_v(lane); const unsigned yo = (unsigned)((4 * (l2 >> 4)) * DM + 16 * wid + (l2 & 15)) * 2u;
#pragma unroll
      for (int qb2 = 0; qb2 < 4; ++qb2)
#pragma unroll
        for (int e = 0; e < 4; ++e) *(bf16_t*)((char*)Yb + yo + (unsigned)((16 * qb2 + e) * DM * 2)) = (bf16_t)(cvt_pk_bf16(ya[qb2][e], 0.f) & 0xffffu); } }
  __syncthreads();
#undef AS_LD1
#undef AS_LD2
#undef AS_CV1
#undef AS_CV2
#undef AS_CVL
#undef AS_BC
#undef AS_CVP
}
}

__device__ __forceinline__ void attn_sample_phase(const Frame& F, KArgs* A_, int li) {
  const int lane = lau_v(lane_id()); unsigned char* ws = lau_s(A_->ws);
  for (int it = F.vcu; it < DECB * HEADS; it += F.G) {
    const int b = it >> 3, h = it & 7;
    attns::unit((const bf16_t*)(ws + WS_QS) + ((size_t)b * DECS * HEADS + h) * KVW, as_global(A_->in[I_CLAT]) + ((size_t)li * DECB + b) * PAST * KVR, as_global(A_->in[I_CKPE]) + ((size_t)li * DECB + b) * PAST * ROPE,
                (const bf16_t*)(ws + WS_KVN) + ((size_t)MP + (size_t)b * DECS) * KVW, (const bf16_t*)(ws + WS_WKV) + ((size_t)li * 2048 + 1024 + h * VD) * KVR,
                (bf16_t*)(ws + WS_YCAT) + ((size_t)MP + (size_t)b * DECS) * DM + h * VD, (char*)F.lds, F.wave, lane);
  }
}
namespace gla {
constexpr int QT = 0, KT = 8192, KH = 16384, VT = 24576, EL = 32768, SSX = 33280, GB = 33792;
constexpr int GON = 2 * GB, QPO = GON + 512;
static_assert(QPO + 4096 <= RING_BYTES, "gla LDS");
__device__ __forceinline__ int crow(int r, int hi) { return (r & 3) + 8 * (r >> 2) + 4 * hi; }
template <int OFF> __device__ __forceinline__ s16x4 tr_read(int a) { s16x4 r; asm volatile("ds_read_b64_tr_b16 %0, %1 offset:%2" : "=&v"(r) : "v"(a), "i"(OFF) : "memory"); return r; }
#define GLA_PK(L, H) (bf16x8){L[0], L[1], L[2], L[3], H[0], H[1], H[2], H[3]}
__device__ __forceinline__ bf16x8 cvt8(const f32x16& x, int base) {
    u32x4 w; w.x = cvt_pk_bf16(x[base + 0], x[base + 1]); w.y = cvt_pk_bf16(x[base + 2], x[base + 3]); w.z = cvt_pk_bf16(x[base + 4], x[base + 5]); w.w = cvt_pk_bf16(x[base + 6], x[base + 7]); return *reinterpret_cast<bf16x8*>(&w); }

__device__ __forceinline__ void run(unsigned char* ws, const float* s0  , float* sout, const float* gon, int row0, int h, int nch, char* lds, int wave, int lane) {
    const bool scan = wave < 4; const int vq = wave & 3;
    const int r32 = lane & 31, hi = lane >> 5, th = vq >> 1; const unsigned kd = 64u * (vq & 1) + (unsigned)lane;
    const bf16_t* FGp = (const bf16_t*)(ws + WS_FG) + (size_t)row0 * 2048 + h * 128;
    const bf16_t* QSp = (const bf16_t*)(ws + WS_QSIL) + (size_t)row0 * 2048 + h * 128;
    const bf16_t* VBp = (const bf16_t*)(ws + WS_VB) + (size_t)row0 * 2048 + h * 128;
    const bf16_t* GSp = (const bf16_t*)(ws + WS_GS) + (size_t)row0 * 2048 + h * 128;
    bf16_t* YCp = (bf16_t*)(ws + WS_YCAT) + (size_t)row0 * DM + h * 128;
    char* gb = lds;
    const int trq = (lane & 15) >> 2, trf = (2 * hi + (trq >> 1)) & 3;
    const int trb = (int)(uintptr_t)gb + (4 * hi + trq) * 64 + (((2 * ((lane >> 4) & 1) + ((lane & 3) >> 1)) ^ trf) * 16) + 8 * (lane & 1);
    float* gonL = (float*)(lds + GON);
    const int tq = vq; const unsigned dp2 = 2u * (unsigned)lane;
#define GLA_LOAD(F2, QV, VV, c_) do { const size_t ro_ = (size_t)(32 * (c_) + 8 * tq) * 2048; \
    const bf16_t* f1_ = lau_s(FGp + ro_); const bf16_t* q1_ = lau_s(QSp + ro_); const bf16_t* v1_ = lau_s(VBp + ro_); const unsigned kl_ = (unsigned)lau_v((int)dp2); \
    _Pragma("unroll") for (int i_ = 0; i_ < 8; ++i_) { F2[i_] = *(const unsigned*)(f1_ + kl_ + 2048u * i_); QV[i_] = *(const unsigned*)(q1_ + kl_ + 2048u * i_); VV[i_] = *(const unsigned*)(v1_ + kl_ + 2048u * i_); } } while (0)
#define GLA_PROD(F2, n_) do { float p0_ = 1.f, p1_ = 1.f; \
    _Pragma("unroll") for (int i_ = 0; i_ < 8; ++i_) { p0_ *= fmaxf(1.0f - bf_lo(F2[i_]), 1e-30f); p1_ *= fmaxf(1.0f - bf_hi(F2[i_]), 1e-30f); } \
    *(f32x2*)(lds + QPO + ((((n_) & 1) * 4 + tq) * 128 + (int)dp2) * 4) = (f32x2){p0_, p1_}; } while (0)
#define GLA_PREP(F2, QV, VV, par_) do { char* ib_ = gb + (par_) * GB; \
    const f32x2 g0_ = *(const f32x2*)(lds + QPO + (((par_) * 4 + 0) * 128 + (int)dp2) * 4), g1_ = *(const f32x2*)(lds + QPO + (((par_) * 4 + 1) * 128 + (int)dp2) * 4); \
    const f32x2 g2_ = *(const f32x2*)(lds + QPO + (((par_) * 4 + 2) * 128 + (int)dp2) * 4), g3_ = *(const f32x2*)(lds + QPO + (((par_) * 4 + 3) * 128 + (int)dp2) * 4); \
    _Pragma("unroll") for (int d_ = 0; d_ < 2; ++d_) { \
        const float q0_ = d_ ? g0_.y : g0_.x, q1p_ = d_ ? g1_.y : g1_.x, q2_ = d_ ? g2_.y : g2_.x, q3_ = d_ ? g3_.y : g3_.x; \
        const float pre_ = (tq > 0 ? q0_ : 1.f) * (tq > 1 ? q1p_ : 1.f) * (tq > 2 ? q2_ : 1.f), post_ = (tq < 1 ? q1p_ : 1.f) * (tq < 2 ? q2_ : 1.f) * (tq < 3 ? q3_ : 1.f); \
        float E_ = pre_; float qt_[8], kt_[8], kh_[8], fv_[8], kv_[8]; \
        _Pragma("unroll") for (int i_ = 0; i_ < 8; ++i_) { kv_[i_] = d_ ? bf_hi(F2[i_]) : bf_lo(F2[i_]); fv_[i_] = 1.0f - kv_[i_]; E_ *= fmaxf(fv_[i_], 1e-30f); const float Ec_ = fmaxf(E_, 1e-30f); \
            qt_[i_] = __uint_as_float(d_ ? (QV[i_] & 0xffff0000u) : (QV[i_] << 16)) * Ec_; kt_[i_] = kv_[i_] * __builtin_amdgcn_rcpf(Ec_); } \
        float suf_ = post_; \
        _Pragma("unroll") for (int i_ = 7; i_ >= 0; --i_) { kh_[i_] = kv_[i_] * suf_; suf_ *= fmaxf(fv_[i_], 1e-30f); } \
        if (tq == 0) *(float*)(ib_ + EL + ((int)dp2 + d_) * 4) = E_ * post_; \
        u32x4 a_, b_, c_, dd_; \
        a_.x = cvt_pk_bf16(qt_[0], qt_[1]); a_.y = cvt_pk_bf16(qt_[2], qt_[3]); a_.z = cvt_pk_bf16(qt_[4], qt_[5]); a_.w = cvt_pk_bf16(qt_[6], qt_[7]); \
        b_.x = cvt_pk_bf16(kt_[0], kt_[1]); b_.y = cvt_pk_bf16(kt_[2], kt_[3]); b_.z = cvt_pk_bf16(kt_[4], kt_[5]); b_.w = cvt_pk_bf16(kt_[6], kt_[7]); \
        c_.x = cvt_pk_bf16(kh_[0], kh_[1]); c_.y = cvt_pk_bf16(kh_[2], kh_[3]); c_.z = cvt_pk_bf16(kh_[4], kh_[5]); c_.w = cvt_pk_bf16(kh_[6], kh_[7]); \
        if (d_) { dd_.x = (VV[0] >> 16) | (VV[1] & 0xffff0000u); dd_.y = (VV[2] >> 16) | (VV[3] & 0xffff0000u); dd_.z = (VV[4] >> 16) | (VV[5] & 0xffff0000u); dd_.w = (VV[6] >> 16) | (VV[7] & 0xffff0000u); } \
        else { dd_.x = (VV[0] & 0xffffu) | (VV[1] << 16); dd_.y = (VV[2] & 0xffffu) | (VV[3] << 16); dd_.z = (VV[4] & 0xffffu) | (VV[5] << 16); dd_.w = (VV[6] & 0xffffu) | (VV[7] << 16); } \
        const int o_ = ((int)dp2 + d_) * 64 + ((tq ^ (lane & 3)) * 16);   \
        *(u32x4*)(ib_ + QT + o_) = a_; *(u32x4*)(ib_ + KT + o_) = b_; *(u32x4*)(ib_ + KH + o_) = c_; *(u32x4*)(ib_ + VT + o_) = dd_; } } while (0)
    f32x16 S[4]; f32x16 o = {}; u32x2 gsv[4] = {}; f32x4 gnr[4] = {};
#define GLA_FINAL(c_, par_) do { const float* sx_ = (const float*)(gb + (par_) * GB + SSX); \
    const float tot_ = (sx_[r32] + sx_[32 + r32]) + (sx_[64 + r32] + sx_[96 + r32]); const float rs_ = rsqrtf(tot_ * (1.0f / HI) + EPS); \
    const size_t ro_ = (size_t)(32 * (c_) + r32) * 2048; \
    _Pragma("unroll") for (int g_ = 0; g_ < 4; ++g_) { const int v0_ = 32 * vq + 8 * g_ + 4 * hi; const f32x4 gn_ = gnr[g_]; const u32x2 gw_ = gsv[g_]; \
        u32x2 w_; w_.x = cvt_pk_bf16(o[4 * g_ + 0] * rs_ * gn_[0] * bf_lo(gw_.x), o[4 * g_ + 1] * rs_ * gn_[1] * bf_hi(gw_.x)); w_.y = cvt_pk_bf16(o[4 * g_ + 2] * rs_ * gn_[2] * bf_lo(gw_.y), o[4 * g_ + 3] * rs_ * gn_[3] * bf_hi(gw_.y)); \
        *(u32x2*)(YCp + ro_ + v0_) = w_; } } while (0)
#define GLA_GSLOAD(c_) do { const size_t ro_ = (size_t)(32 * (c_) + r32) * 2048; _Pragma("unroll") for (int g_ = 0; g_ < 4; ++g_) gsv[g_] = *(const u32x2*)(GSp + ro_ + 32 * vq + 8 * g_ + 4 * hi); } while (0)
#define GLA_FR2(kt_) do { const s16x4 ql_ = tr_read<QT + (32 * kt_) * 64>(ia), qh_ = tr_read<QT + (32 * kt_ + 8) * 64>(ia), kl_ = tr_read<KT + (32 * kt_) * 64>(ia), kh2_ = tr_read<KT + (32 * kt_ + 8) * 64>(ia); \
        const s16x4 ql3_ = tr_read<QT + (32 * kt_ + 16) * 64>(ia), qh3_ = tr_read<QT + (32 * kt_ + 24) * 64>(ia), kl3_ = tr_read<KT + (32 * kt_ + 16) * 64>(ia), kh3_ = tr_read<KT + (32 * kt_ + 24) * 64>(ia); \
        asm volatile("s_waitcnt lgkmcnt(0)" ::: "memory"); __builtin_amdgcn_sched_barrier(0); \
        qf[kt_][0] = GLA_PK(ql_, qh_); qf[kt_][1] = GLA_PK(ql3_, qh3_); \
        P = __builtin_amdgcn_mfma_f32_32x32x16_bf16(GLA_PK(kl_, kh2_), qf[kt_][0], P, 0, 0, 0); P1 = __builtin_amdgcn_mfma_f32_32x32x16_bf16(GLA_PK(kl3_, kh3_), qf[kt_][1], P1, 0, 0, 0); } while (0)
#define GLA_SCAN(par_) do { const int ia = trb + (par_) * GB; const char* ib = gb + (par_) * GB; \
        bf16x8 qf[4][2]; f32x16 P = {}, P1 = {}; \
        GLA_FR2(0); GLA_FR2(1); GLA_FR2(2); GLA_FR2(3); \
        P = P + P1; \
        _Pragma("unroll") for (int r = 0; r < 16; ++r) P[r] = (crow(r, hi) <= r32) ? P[r] : 0.f; \
        o = f32x16{}; \
        _Pragma("unroll") for (int kt = 0; kt < 4; ++kt) _Pragma("unroll") for (int s2 = 0; s2 < 2; ++s2) o = __builtin_amdgcn_mfma_f32_32x32x16_bf16(cvt8(S[kt], 8 * s2), qf[kt][s2], o, 0, 0, 0); \
        const char* vrow = ib + VT + (32 * vq + r32) * 64; const int fr_ = (r32 >> 1) & 3; \
        { s16x4 vlo_[2], vhh_[2]; \
          _Pragma("unroll") for (int ks = 0; ks < 2; ++ks) { vlo_[ks] = *(const s16x4*)(vrow + (((2 * ks) ^ fr_) * 16) + 8 * hi); vhh_[ks] = *(const s16x4*)(vrow + (((2 * ks + 1) ^ fr_) * 16) + 8 * hi); } \
          __builtin_amdgcn_sched_barrier(0); \
          _Pragma("unroll") for (int ks = 0; ks < 2; ++ks) o = __builtin_amdgcn_mfma_f32_32x32x16_bf16(GLA_PK(vlo_[ks], vhh_[ks]), cvt8(P, 8 * ks), o, 0, 0, 0); } \
        { float ss = 0.f; \
          _Pragma("unroll") for (int r = 0; r < 16; ++r) ss += o[r] * o[r]; \
          auto rr = __builtin_amdgcn_permlane32_swap(__float_as_uint(ss), __float_as_uint(ss), false, false); ss = __uint_as_float(rr[0]) + __uint_as_float(rr[1]); \
          if (hi == 0) *(float*)(gb + (par_) * GB + SSX + (vq * 32 + r32) * 4) = ss; } \
          \
        { bf16x8 ka_[4][2], vb_[2]; f32x4 el_[4][4]; \
          _Pragma("unroll") for (int ks = 0; ks < 2; ++ks) vb_[ks] = *(const bf16x8*)(vrow + (((2 * ks + hi) ^ fr_) * 16)); \
          _Pragma("unroll") for (int kt = 0; kt < 4; ++kt) { \
            _Pragma("unroll") for (int ks = 0; ks < 2; ++ks) ka_[kt][ks] = *(const bf16x8*)(ib + KH + (32 * kt + r32) * 64 + (((2 * ks + hi) ^ fr_) * 16)); \
            _Pragma("unroll") for (int g = 0; g < 4; ++g) el_[kt][g] = *(const f32x4*)(ib + EL + (32 * kt + 8 * g + 4 * hi) * 4); } \
          __builtin_amdgcn_sched_barrier(0); \
          _Pragma("unroll") for (int kt = 0; kt < 4; ++kt) { \
            _Pragma("unroll") for (int g = 0; g < 4; ++g) { S[kt][4 * g + 0] *= el_[kt][g][0]; S[kt][4 * g + 1] *= el_[kt][g][1]; S[kt][4 * g + 2] *= el_[kt][g][2]; S[kt][4 * g + 3] *= el_[kt][g][3]; } \
            _Pragma("unroll") for (int ks = 0; ks < 2; ++ks) S[kt] = __builtin_amdgcn_mfma_f32_32x32x16_bf16(ka_[kt][ks], vb_[ks], S[kt], 0, 0, 0); } } } while (0)
#define GLA_BAR() do { asm volatile("s_waitcnt lgkmcnt(0)" ::: "memory"); __builtin_amdgcn_s_barrier(); asm volatile("" ::: "memory"); } while (0)
    if (scan) {
        if (s0) { const unsigned sl = (unsigned)((4 * hi) * HI + 32 * vq + r32) * 4u;
#pragma unroll
            for (int kt = 0; kt < 4; ++kt)
#pragma unroll
                for (int r = 0; r < 16; ++r) S[kt][r] = *(const float*)((const char*)s0 + sl + (unsigned)((32 * kt + (r & 3) + 8 * (r >> 2)) * HI * 4));
        } else {
#pragma unroll
            for (int kt = 0; kt < 4; ++kt) S[kt] = f32x16{};
        }
        GLA_BAR();
#pragma unroll
        for (int g = 0; g < 4; ++g) gnr[g] = *(const f32x4*)(gonL + 32 * vq + 8 * g + 4 * hi);
#pragma unroll 1
        for (int c = 0; c < nch; ++c) {
            const int par = c & 1;
            GLA_BAR();
            if (c > 0) GLA_FINAL(c - 1, par ^ 1);
            GLA_GSLOAD(c);
            GLA_SCAN(par);
        }
        GLA_BAR();
        GLA_FINAL(nch - 1, (nch - 1) & 1);
        const int le = lau_v(lane); const unsigned sl = (unsigned)((4 * (le >> 5)) * HI + 32 * vq + (le & 31)) * 4u;
#pragma unroll
        for (int kt = 0; kt < 4; ++kt)
#pragma unroll
            for (int r = 0; r < 16; ++r) *(float*)((char*)sout + sl + (unsigned)((32 * kt + (r & 3) + 8 * (r >> 2)) * HI * 4)) = S[kt][r];
    } else {
        unsigned fA[8], fB[8]; unsigned qvA[8], vvA[8], qvB[8], vvB[8];
        if (tq < 2) gonL[64 * tq + lane] = gon[64 * tq + lane];
        GLA_LOAD(fA, qvA, vvA, 0); if (nch > 1) GLA_LOAD(fB, qvB, vvB, 1);
        GLA_PROD(fA, 0); if (nch > 1) GLA_PROD(fB, 1);
        GLA_BAR();
        GLA_PREP(fA, qvA, vvA, 0); if (nch > 2) GLA_LOAD(fA, qvA, vvA, 2);
#pragma unroll 1
        for (int j = 0; j < nch; j += 2) {
            GLA_BAR();
            if (j + 1 < nch) GLA_PREP(fB, qvB, vvB, 1);
            if (j + 3 < nch) GLA_LOAD(fB, qvB, vvB, j + 3);
            if (j + 2 < nch) GLA_PROD(fA, j + 2);
            if (j + 1 < nch) {
                GLA_BAR();
                if (j + 2 < nch) GLA_PREP(fA, qvA, vvA, 0);
                if (j + 4 < nch) GLA_LOAD(fA, qvA, vvA, j + 4);
                if (j + 3 < nch) GLA_PROD(fB, j + 3);
            }
        }
        GLA_BAR();
    }
    __syncthreads();
#undef GLA_BAR
#undef GLA_LOAD
#undef GLA_PREP
#undef GLA_PROD
#undef GLA_FINAL
#undef GLA_GSLOAD
#undef GLA_SCAN
#undef GLA_FR2
}
#undef GLA_PK
}

__device__ __forceinline__ void gla_phase(const Frame& F, KArgs* A_, int li) {
    const int lane = lau_v(lane_id()); unsigned char* ws = lau_s(A_->ws); float* out = lau_s(A_->out);
    const float* gon = as_global(A_->in[I_GONORM]) + (size_t)li * HI;
    const int bx = (int)blockIdx.x, G = F.G, nit = BATCH * CHD + DECB * CHD;
    for (int k = 0;; ++k) {
        int item;
        if (G == 256) { if (bx < 128) { if (k > 0) break; item = bx; } else { if (k >= 4) break; item = 128 + (bx - 128) + 128 * k; } }
        else { item = bx + k * G; if (item >= nit) break; }
        const bool prompt = item < BATCH * CHD; const int it2 = prompt ? item : item - BATCH * CHD, sq = it2 >> 4, h = it2 & 15;
        if (prompt) gla::run(ws, nullptr, out + O_HGP + ((((size_t)li * BATCH + sq) * CHD + h) * HF) * HI, gon, sq * SEQ, h, SEQ / 32, (char*)F.lds, F.wave, lane);
        else gla::run(ws, as_global(A_->in[I_SHGRN]) + ((((size_t)li * DECB + sq) * CHD + h) * HF) * HI, out + O_HGS + ((((size_t)li * DECB + sq) * CHD + h) * HF) * HI, gon, MP + sq * DECS, h, DECS / 32, (char*)F.lds, F.wave, lane);
    }
}
__global__ void __launch_bounds__(NWAVES * 64, 2) mk_fwd(Args args) {
    extern __shared__ __attribute__((aligned(16))) unsigned char lds[];
    Frame F;
    F.lds = (LAS unsigned char*)lds;
    F.MISC = (volatile LAS unsigned*)(F.lds + MISC_OFF);
    F.wave = __builtin_amdgcn_readfirstlane((int)threadIdx.x >> 6);
    F.G = gridDim.x; { const int bx = blockIdx.x; F.vcu = (F.G % 8 == 0) ? (bx % 8) * (F.G / 8) + bx / 8 : bx; }
    F.ctl = (unsigned*)(args.ws + WS_CTL); F.ctlf = (float*)(args.ws + WS_CTL);
    if (threadIdx.x < 64) ((LAS unsigned*)(F.lds + MISC_OFF))[threadIdx.x] = 0u;
    __syncthreads();
    XcdBarrier bar = xcd_barrier_post(F.ctl + CW_BAR, F.MISC + 8);
#define RUN() (true)
#define SEAM() xcd_barrier(bar)

    if (RUN()) p0_prologue(F, kargs());
    SEAM();

    for (int layer = 0; layer < DEPTH; ++layer) {
        asm volatile("" : "+s"(F.lds), "+s"(F.MISC), "+s"(F.ctl), "+s"(F.ctlf), "+s"(F.wave), "+s"(F.vcu), "+s"(F.G), "+s"(bar.bar), "+s"(bar.x), "+s"(bar.st));
        const int bx = lau_si((int)blockIdx.x);
        const int li = layer >> 1;
        if ((layer & 1) == 0) {
            if (RUN()) {
                unsigned char* ws = lau_s(kargs()->ws);
                pg8::Gemm g{(const bf16_t*)(ws + WS_XB), (const bf16_t*)(ws + WS_WINA) + (size_t)li * INA_PAD * DM, DM, DM, DM};
                pg8::StaticOrder S; S.init(MT / 256, INA_PAD / 256, F.G, bx, DM, DM);
                EpiInA E{ws, as_global(kargs()->out), li, F.lds};
                pg8::gemm_phase<EpiInA, pg8::StaticOrder>(F.lds, g, S, E, F.wave);
                { const unsigned job = layer == 0 ? CJ_INA0 : CJ_INA2;
                    if (F.G == 256) { if (bx >= 136) conv_run(F, kargs(), job, (bx - 136) * NWAVES + F.wave, 120 * NWAVES); }
                    else conv_run(F, kargs(), job, bx * NWAVES + F.wave, F.G * NWAVES); }
            }
            SEAM();
            if (RUN()) {
                post_a_phase(F, kargs(), li); pool_prep_phase(F, kargs(), li);
                __syncthreads();
                unsigned char* ws = lau_s(kargs()->ws);
                pg8::Gemm g{(const bf16_t*)(ws + WS_CQB), (const bf16_t*)(ws + WS_WQB) + (size_t)li * 1536 * QR, QR, QR, QR};
                pg8::StaticOrder S; S.init(MT / 256, 1536 / 256, F.G, bx, QR, QR);
                EpiQ E{ws, li, F.lds};
                pg8::gemm_phase<EpiQ, pg8::StaticOrder>(F.lds, g, S, E, F.wave);
            }
            SEAM();
            if (RUN()) {
                unsigned char* ws = lau_s(kargs()->ws);
                { pg8::Gemm g{(const bf16_t*)(ws + WS_KVN), (const bf16_t*)(ws + WS_WKV) + (size_t)li * 2048 * KVR, KVW, KVR, KVR};
                  pg8::StaticOrder S; S.init(MP / 256, 2048 / 256, F.G, bx, KVW, KVR);
                  EpiStore<0> E{ws}; pg8::gemm_phase<EpiStore<0>, pg8::StaticOrder>(F.lds, g, S, E, F.wave); }
                { pg8::Gemm g{(const bf16_t*)(ws + WS_QNS), (const bf16_t*)(ws + WS_WUKBD) + (size_t)li * 4096 * 128, 1024, 128, 128};
                  pg8::HeadOrder S; S.init(MS / 256, 4096 / 256, F.G, (bx + 128) % F.G, 1024, 128, 128);
                  EpiStore<1> E{ws}; pg8::gemm_phase<EpiStore<1>, pg8::HeadOrder>(F.lds, g, S, E, F.wave); }
                { pg8::Gemm g{(const bf16_t*)(ws + WS_PB), (const bf16_t*)(ws + WS_WPOOL) + (size_t)li * 1024 * 256, POOLW, 256, 256};
                  pg8::GroupOrder S; S.init(MT / 256, 4, F.G, bx, POOLW, 256, 256);
                  EpiStore<2> E{ws}; pg8::gemm_phase<EpiStore<2>, pg8::GroupOrder>(F.lds, g, S, E, F.wave); }
            }
            SEAM();
            if (RUN()) { attn_sample_phase(F, kargs(), li); __syncthreads(); attn_prompt_phase(F, kargs(), 0); }
            SEAM();
        } else {
            if (RUN()) {
                unsigned char* ws = lau_s(kargs()->ws);
                pg8::Gemm g{(const bf16_t*)(ws + WS_XB), (const bf16_t*)(ws + WS_WINC) + (size_t)li * INC * DM, DM, DM, DM};
                pg8::StaticOrder S; S.init(MT / 256, INC / 256, F.G, bx, DM, DM);
                EpiInC E{ws, layer, F.lds}; pg8::gemm_phase<EpiInC, pg8::StaticOrder>(F.lds, g, S, E, F.wave);
            }
            SEAM();
            if (RUN()) { gla_phase(F, kargs(), li);
                { const unsigned job = layer == 1 ? CJ_GLA1 : CJ_GLA3;
                    if (F.G == 256) { if ((int)blockIdx.x >= 128) conv_run(F, kargs(), job, ((int)blockIdx.x - 128) * NWAVES + F.wave, 128 * NWAVES); }
                    else conv_run(F, kargs(), job, (int)blockIdx.x * NWAVES + F.wave, F.G * NWAVES); } }
            SEAM();
        }
        if (RUN()) {
            unsigned char* ws = lau_s(kargs()->ws);
            const bf16_t* W = (layer & 1) ? (const bf16_t*)(ws + WS_WOUTC) + (size_t)li * DM * DM : (const bf16_t*)(ws + WS_WOUTA) + (size_t)li * DM * DM;
            pg8::Gemm g{(const bf16_t*)(ws + WS_YCAT), W, DM, DM, DM};
            pg8::StaticOrder S; S.init(MT / 192, DM / 256, F.G, bx, DM, DM, 192);
            EpiRes<3> E{ws, as_global(kargs()->in[I_XP]), as_global(kargs()->in[I_XS]), layer == 0 ? 1 : 0, 2 * layer + 1}; pg8::gemm_phase<EpiRes<3>, pg8::StaticOrder, true, true, 3>(F.lds, g, S, E, F.wave);
        }
        SEAM();
        if (RUN()) rstd_phase(F, kargs(), 2 * layer + 1);
        SEAM();
        if (RUN()) {
            unsigned char* ws = lau_s(kargs()->ws);
            pg8::Gemm g{(const bf16_t*)(ws + WS_XB), (const bf16_t*)(ws + WS_WUP) + (size_t)layer * DFF2 * DM, DM, DM, DM};
            pg8::StaticOrder S; S.init(MT / 256, DFF2 / 256, F.G, bx, DM, DM);
            EpiUp E{ws, as_global(kargs()->out), as_global(kargs()->in[I_CONVW]) + (size_t)layer * 3 * DFF2, as_global(kargs()->in[I_CONVB]) + (size_t)layer * DFF2, as_global(kargs()->in[I_SCONV]) + (size_t)layer * DECB * 2 * DFF2, F.lds, layer}; pg8::gemm_phase<EpiUp, pg8::StaticOrder>(F.lds, g, S, E, F.wave);
            if (layer < 3) { const unsigned job = layer == 0 ? CJ_UP0 : layer == 1 ? CJ_UP1 : CJ_UP2;
                if (F.G == 256) { if (bx >= 96) conv_run(F, kargs(), job, (bx - 96) * NWAVES + F.wave, 160 * NWAVES); }
                else conv_run(F, kargs(), job, bx * NWAVES + F.wave, F.G * NWAVES); }
        }
        SEAM();
        if (RUN()) act_fix_phase(F, kargs(), layer);
        SEAM();
        if (RUN()) {
            unsigned char* ws = lau_s(kargs()->ws);
            pg8::Gemm g{(const bf16_t*)(ws + WS_ACT), (const bf16_t*)(ws + WS_WDOWN) + (size_t)layer * DM * DFF, DFF, DFF, DFF};
            pg8::StaticOrder S; S.init(MT / 192, DM / 256, F.G, bx, DFF, DFF, 192);
            EpiRes<3> E{ws, as_global(kargs()->in[I_XP]), as_global(kargs()->in[I_XS]), 0, 2 * layer + 2}; pg8::gemm_phase<EpiRes<3>, pg8::StaticOrder, true, true, 3>(F.lds, g, S, E, F.wave);
        }
        SEAM();
        if (RUN()) rstd_phase(F, kargs(), 2 * layer + 2);
        SEAM();
    }
    if (RUN()) final_phase(F, kargs());
#undef RUN
#undef SEAM
}

extern "C" void kernel_launch(void* const* d_in, const int* in_sizes, int n_in, void* d_out, int out_size, void* d_ws, size_t ws_size, hipStream_t stream) {
    static int grid = 0;
    if (grid == 0) {
        if (n_in != N_IN || (size_t)out_size != O_END || ws_size < WS_END) { fprintf(stderr, "kernel_launch: shape mismatch (n_in %d out %d ws %zu, need %d %zu %zu)\n", n_in, out_size, ws_size, (int)N_IN, (size_t)O_END, (size_t)WS_END); grid = -1; return; }
        int dev = 0, cus = 0, per_cu = 0;
        if (hipGetDevice(&dev) != hipSuccess || hipDeviceGetAttribute(&cus, hipDeviceAttributeMultiprocessorCount, dev) != hipSuccess) { grid = -1; return; }
        if (hipFuncSetAttribute((const void*)mk_fwd, hipFuncAttributeMaxDynamicSharedMemorySize, LDS_BYTES) != hipSuccess) { fprintf(stderr, "kernel_launch: hipFuncSetAttribute failed\n"); grid = -1; return; }
        if (hipOccupancyMaxActiveBlocksPerMultiprocessor(&per_cu, (const void*)mk_fwd, NWAVES * 64, LDS_BYTES) != hipSuccess || per_cu < 1) { fprintf(stderr, "kernel_launch: occupancy query reports %d\n", per_cu); }
        (void)hipGetLastError();
        grid = cus;
    }
    if (grid < 0) return;
    (void)hipMemsetAsync((char*)d_ws + WS_CTL, 0, CTL_BYTES, stream);
    Args a{};
    for (int i = 0; i < N_IN; ++i) a.in[i] = (const float*)d_in[i];
    a.out = (float*)d_out; a.ws = (unsigned char*)d_ws; a.ph_lo = 0; a.ph_hi = 1000;
    hipLaunchKernelGGL(mk_fwd, dim3(grid), dim3(NWAVES * 64), LDS_BYTES, stream, a);
    const hipError_t le = hipPeekAtLastError();
    if (le != hipSuccess) fprintf(stderr, "kernel_launch: launch failed: %s\n", hipGetErrorName(le));
}
```

```cpp
#include <hip/hip_runtime.h>
#include <cstdio>
#include <cstdint>

#define GAS __attribute__((address_space(1)))
#define LAS __attribute__((address_space(3)))
typedef unsigned short bf16_t;
typedef short bf16x8 __attribute__((ext_vector_type(8)));
typedef short s16x4 __attribute__((ext_vector_type(4)));
typedef float f32x4 __attribute__((ext_vector_type(4)));
typedef float f32x2 __attribute__((ext_vector_type(2)));
typedef float f32x16 __attribute__((ext_vector_type(16)));
typedef unsigned u32x4 __attribute__((ext_vector_type(4)));
typedef unsigned u32x2 __attribute__((ext_vector_type(2)));

constexpr int DM = 2048, BATCH = 8, SEQ = 2048, DEPTH = 4, DECB = 32, DECS = 64, PAST = 4096;
constexpr int MP = BATCH * SEQ, MS = DECB * DECS, MT = MP + MS;
constexpr int NEVEN = 2, NODD = 2;
constexpr int HEADS = 8, QR = 512, KVR = 512, NOPE = 128, ROPE = 64, VD = 128, QKD = NOPE + ROPE;
constexpr int POOLW = 1024, POOLKEEP = 15;
constexpr int INA = 2112, INA_PAD = 2304;
constexpr int CHD = 16, HF = 128, HI = 128, INC = 8192;
constexpr int DFF = 5632, DFF2 = 11264;
constexpr int KVW = KVR + ROPE;
constexpr float EPS = 1e-6f;
constexpr int NPOS = SEQ + DECS;

constexpr size_t O_YP = 0;
constexpr size_t O_YS = O_YP + (size_t)MP * DM;
constexpr size_t O_LATP = O_YS + (size_t)MS * DM;
constexpr size_t O_KPEP = O_LATP + (size_t)NEVEN * MP * KVR;
constexpr size_t O_POOLP = O_KPEP + (size_t)NEVEN * MP * ROPE;
constexpr size_t O_HGP = O_POOLP + (size_t)NEVEN * BATCH * POOLKEEP * POOLW;
constexpr size_t O_CVP = O_HGP + (size_t)NODD * BATCH * CHD * HF * HI;
constexpr size_t O_LATS = O_CVP + (size_t)DEPTH * BATCH * 2 * DFF2;
constexpr size_t O_KPES = O_LATS + (size_t)NEVEN * MS * KVR;
constexpr size_t O_POOLS = O_KPES + (size_t)NEVEN * MS * ROPE;
constexpr size_t O_HGS = O_POOLS + (size_t)NEVEN * DECB * POOLKEEP * POOLW;
constexpr size_t O_CVS = O_HGS + (size_t)NODD * DECB * CHD * HF * HI;
constexpr size_t O_END = O_CVS + (size_t)DEPTH * DECB * 2 * DFF2;
static_assert(O_END == 84787200, "output size");

enum { I_XP = 0, I_XS, I_CLAT, I_CKPE, I_SPOOL, I_SHGRN, I_SCONV, I_GMIX, I_GFFN, I_GFINAL, I_WINA, I_GQA, I_WQB, I_GKVA, I_WUK, I_WUV,
       I_WPOOL, I_PSCALE, I_WOUTA, I_WINC, I_LB, I_GONORM, I_WOUTC, I_WUP, I_CONVW, I_CONVB, I_WDOWN, N_IN };

constexpr size_t al256(size_t x) { return (x + 255) / 256 * 256; }
constexpr size_t WS_CTL = 0, CTL_BYTES = 1u << 20;
constexpr size_t WS_WINA = WS_CTL + CTL_BYTES;
constexpr size_t WS_WQB = WS_WINA + al256((size_t)NEVEN * INA_PAD * DM * 2);
constexpr size_t WS_WKV = WS_WQB + al256((size_t)NEVEN * 1536 * QR * 2);
constexpr size_t WS_WUKBD = WS_WKV + al256((size_t)NEVEN * 2048 * KVR * 2);
constexpr size_t WS_WUVBD = WS_WUKBD + al256((size_t)NEVEN * 4096 * 1024 * 2);
constexpr size_t WS_WPOOL = WS_WUVBD + al256((size_t)NEVEN * 1024 * 4096 * 2);
constexpr size_t WS_WOUTA = WS_WPOOL + al256((size_t)NEVEN * 1024 * 256 * 2);
constexpr size_t WS_WINC = WS_WOUTA + al256((size_t)NEVEN * DM * DM * 2);
constexpr size_t WS_WOUTC = WS_WINC + al256((size_t)NODD * INC * DM * 2);
constexpr size_t WS_WUP = WS_WOUTC + al256((size_t)NODD * DM * DM * 2);
constexpr size_t WS_WDOWN = WS_WUP + al256((size_t)DEPTH * DFF2 * DM * 2);
constexpr size_t WS_KVC = WS_WDOWN + al256((size_t)DEPTH * DM * DFF * 2);
constexpr size_t WS_ROPE = WS_KVC + al256((size_t)NEVEN * DECB * PAST * KVW * 2);
constexpr size_t WS_LBS = WS_ROPE + al256((size_t)NPOS * 32 * 8);
constexpr size_t WS_SSQP = WS_LBS + al256((size_t)NODD * 2048 * 4);
constexpr size_t WS_RSTD = WS_SSQP + al256((size_t)9 * 32 * MT * 4);
constexpr size_t WS_SSQQ = WS_RSTD + al256((size_t)9 * MT * 4);
constexpr size_t WS_SSQKV = WS_SSQQ + al256((size_t)NEVEN * 8 * MT * 4);
constexpr size_t WS_HALO = WS_SSQKV + al256((size_t)NEVEN * 8 * MT * 4);
constexpr size_t WS_X = WS_HALO + al256((size_t)(MT / 256) * 4 * DFF2 * 4);
constexpr size_t WS_XB = WS_X + al256((size_t)MT * DM * 4);
constexpr size_t WS_YCAT = WS_XB + al256((size_t)MT * DM * 2);
constexpr size_t WS_BIG = WS_YCAT + al256((size_t)MT * DM * 2);
constexpr size_t WS_CQB = WS_BIG;
constexpr size_t WS_ZB = WS_CQB + al256((size_t)MT * QR * 2);
constexpr size_t WS_PB = WS_ZB + al256((size_t)MT * POOLW * 2);
constexpr size_t WS_KVN = WS_PB + al256((size_t)MT * POOLW * 2);
constexpr size_t WS_QP = WS_KVN + al256((size_t)MT * KVW * 2);
constexpr size_t WS_KP = WS_QP + al256((size_t)MP * HEADS * QKD * 2);
constexpr size_t WS_VP = WS_KP + al256((size_t)MP * HEADS * QKD * 2);
constexpr size_t WS_QNS = WS_VP + al256((size_t)MP * HEADS * VD * 2);
constexpr size_t WS_QS = WS_QNS + al256((size_t)MS * 1024 * 2);
constexpr size_t WS_OLAT = WS_QS + al256((size_t)MS * HEADS * KVW * 2);
constexpr size_t WS_EVEN_END = WS_OLAT + al256((size_t)MS * HEADS * KVR * 2);
constexpr size_t WS_FG = WS_BIG;
constexpr size_t WS_QSIL = WS_FG + al256((size_t)MT * 2048 * 4);
constexpr size_t WS_VB = WS_QSIL + al256((size_t)MT * 2048 * 2);
constexpr size_t WS_GS = WS_VB + al256((size_t)MT * 2048 * 2);
constexpr size_t WS_ODD_END = WS_GS + al256((size_t)MT * 2048 * 2);
constexpr size_t WS_HB = WS_BIG;
constexpr size_t WS_ACT = WS_HB + al256((size_t)MT * DFF2 * 2);
constexpr size_t WS_FFN_END = WS_ACT + al256((size_t)MT * DFF * 2);
constexpr size_t WS_END = WS_FFN_END > WS_EVEN_END ? (WS_FFN_END > WS_ODD_END ? WS_FFN_END : WS_ODD_END) : (WS_EVEN_END > WS_ODD_END ? WS_EVEN_END : WS_ODD_END);
static_assert(WS_END <= (size_t)2147483648u, "workspace map must fit 4 x largest input");

constexpr int CW_BAR = 4096;

constexpr int RING_BYTES = 159744;
constexpr int EPI_LDS = 131072;
constexpr int EPI_CW = EPI_LDS + 8192;
constexpr int EPI_RS = EPI_CW + 8192;
static_assert(EPI_RS + 2048 <= RING_BYTES, "epilogue LDS");
constexpr int MISC_OFF = RING_BYTES;
constexpr int LDS_BYTES = RING_BYTES + 256;
constexpr int NWAVES = 8;

#define LDS_WAIT() asm volatile("s_waitcnt lgkmcnt(0)" ::: "memory")
#define VM_WAIT() asm volatile("s_waitcnt vmcnt(0)" ::: "memory")
typedef __bf16 bf16x2_t __attribute__((ext_vector_type(2)));
__device__ __forceinline__ unsigned cvt_pk_bf16(float lo, float hi) { const f32x2 v = {lo, hi}; unsigned r = __builtin_bit_cast(unsigned, __builtin_convertvector(v, bf16x2_t)); asm volatile("" : "+v"(r)); return r; }
__device__ __forceinline__ float bf_lo(unsigned w) { return __uint_as_float(w << 16); }
__device__ __forceinline__ float bf_hi(unsigned w) { return __uint_as_float(w & 0xffff0000u); }
__device__ __forceinline__ float wave_sum(float v) {
#pragma unroll
    for (int o = 1; o < 64; o <<= 1) v += __shfl_xor(v, o);
    return v;
}
__device__ __forceinline__ float row4_sum(float x) {
    { const auto r = __builtin_amdgcn_permlane16_swap(__float_as_uint(x), __float_as_uint(x), false, false); x = __uint_as_float(r[0]) + __uint_as_float(r[1]); }
    { const auto r = __builtin_amdgcn_permlane32_swap(__float_as_uint(x), __float_as_uint(x), false, false); x = __uint_as_float(r[0]) + __uint_as_float(r[1]); }
    return x;
}
__device__ __forceinline__ float silu_f(float x) { return x * __builtin_amdgcn_rcpf(1.0f + __expf(-x)); }
__device__ __forceinline__ float sigmoid_f(float x) { return __builtin_amdgcn_rcpf(1.0f + __expf(-x)); }
template <class T> __device__ __forceinline__ T* as_global(T* p) { return (T*)(T GAS*)(unsigned long long)p; }
template <class T> __device__ __forceinline__ T* lau_s(T* p) { asm volatile("" : "+s"(p)); return as_global(p); }
template <class T> __device__ __forceinline__ T* lau_vp(T* p) { asm volatile("" : "+v"(p)); return as_global(p); }
__device__ __forceinline__ int lau_v(int x) { asm volatile("" : "+v"(x)); return x; }
__device__ __forceinline__ int lau_si(int x) { asm volatile("" : "+s"(x)); return x; }
__device__ __forceinline__ int lane_id() { int l; asm volatile("v_mbcnt_lo_u32_b32 %0, -1, 0\n\tv_mbcnt_hi_u32_b32 %0, -1, %0" : "=v"(l)); return l; }
#define XB_TMO      128
#define XB_XCNT(j)  (256  + 64 * (j))
#define XB_XSUB(j)  (1280 + 64 * (j))
#define XB_XGEN(j)  (2304 + 64 * (j))
#define XB_TOP      3328
#define XB_TOPGEN   3392
#define XCD_BAR_WORDS 3456
#define XB_SPIN_CAP (1u << 18)

__device__ __forceinline__ unsigned xb_ld(unsigned* p)              { return __hip_atomic_load(p, __ATOMIC_RELAXED, __HIP_MEMORY_SCOPE_AGENT); }
__device__ __forceinline__ unsigned xb_add(unsigned* p, unsigned v) { return __hip_atomic_fetch_add(p, v, __ATOMIC_RELAXED, __HIP_MEMORY_SCOPE_AGENT); }
__device__ __forceinline__ unsigned xb_xcc_id() { return (unsigned)__builtin_amdgcn_s_getreg((3 << 11) | 20) & 0xFu; }
#define XB_SPIN(cond, bar) do { unsigned _sp = 0; while (cond) { __builtin_amdgcn_s_sleep(1); \
    if ((++_sp & 255u) == 0u) { if (xb_ld(&(bar)[XB_TMO])) break; if (_sp > XB_SPIN_CAP) { atomicAdd(&(bar)[XB_TMO], 1u); break; } } } } while (0)

struct XcdBarrier {
    unsigned* bar; unsigned x;
    volatile LAS unsigned* st;
};

__device__ __forceinline__ XcdBarrier xcd_barrier_post(unsigned* bar, volatile LAS unsigned* st) {
    XcdBarrier b; b.bar = bar; b.x = xb_xcc_id(); b.st = st;
    if (threadIdx.x == 0) (void)xb_add(&bar[XB_XCNT(b.x)], 1u);
    return b;
}
__device__ __forceinline__ void xcd_barrier_complete(unsigned* bar, unsigned x, unsigned& nloc, unsigned& nx) {
    const unsigned G = gridDim.x * gridDim.y * gridDim.z;
    unsigned sum, cnt, mine, sp = 0u;
    for (;;) {
        sum = 0u; cnt = 0u; mine = 0u;
#pragma unroll
        for (unsigned j = 0; j < 16; ++j) { const unsigned c = xb_ld(&bar[XB_XCNT(j)]); sum += c; cnt += (c > 0u) ? 1u : 0u; mine = (j == x) ? c : mine; }
        if (sum == G) break;
        __builtin_amdgcn_s_sleep(1);
        if ((++sp & 255u) == 0u) { if (xb_ld(&bar[XB_TMO])) break; if (sp > XB_SPIN_CAP) { atomicAdd(&bar[XB_TMO], 1u); break; } }
    }
    nloc = mine > 0u ? mine : 1u; nx = cnt > 0u ? cnt : 1u;
}

__device__ __forceinline__ void xcd_barrier(const XcdBarrier& b) {
    asm volatile("s_waitcnt vmcnt(0)" ::: "memory");
    __syncthreads();
    if (threadIdx.x == 0) {
        unsigned* bar = b.bar;
        __builtin_amdgcn_s_waitcnt(0);
        unsigned nloc = b.st[0], nx = b.st[1];
        if (nloc == 0u) { xcd_barrier_complete(bar, b.x, nloc, nx); b.st[0] = nloc; b.st[1] = nx; }
        const unsigned old = xb_add(&bar[XB_XSUB(b.x)], 1u);
        const unsigned gen = old / nloc;
        if (old + 1u == (gen + 1u) * nloc) {
            __builtin_amdgcn_fence(__ATOMIC_RELEASE, "agent");
            asm volatile("s_waitcnt vmcnt(0)" ::: "memory");
            const unsigned og = xb_add(&bar[XB_TOP], 1u);
            const unsigned tg = og / nx;
            if (og + 1u == (tg + 1u) * nx) xb_add(&bar[XB_TOPGEN], 1u);
            else XB_SPIN(xb_ld(&bar[XB_TOPGEN]) == tg, bar);
            __builtin_amdgcn_fence(__ATOMIC_ACQUIRE, "agent");
            xb_add(&bar[XB_XGEN(b.x)], 1u);
            asm volatile("s_waitcnt vmcnt(0)" ::: "memory");
        } else {
            XB_SPIN(xb_ld(&bar[XB_XGEN(b.x)]) == gen, bar);
            __builtin_amdgcn_fence(__ATOMIC_ACQUIRE, "agent");
            asm volatile("s_waitcnt vmcnt(0)" ::: "memory");
        }
    }
    __syncthreads();
}

namespace pg8 {
constexpr int BM = 256, BK = 64, HALF = 128, HTB = HALF * BK * 2, STAGE_BYTES = 8 * HTB, NXCD = 8, WGM = 8;
__host__ __device__ __forceinline__ int lds_byte(int r, int c) { const int st = (r >> 4) * 2 + (c >> 5), rr = r & 15, cc = c & 31, ob = rr * 64 + cc * 2; return st * 1024 + (ob ^ (((ob >> 9) & 1) << 5)); }
__host__ __device__ __forceinline__ void stage_rc(int b, int& R, int& C) { const int st = b / 1024, sb = b % 1024, swz = sb ^ (((sb >> 9) & 1) << 5); R = (st >> 1) * 16 + swz / 64; C = (st & 1) * 32 + (swz % 64) / 2; }
__host__ __device__ __forceinline__ int perm32(int rho) { const int n = rho >> 4, i = rho & 15; return 8 * (i >> 2) + 4 * n + (i & 3); }

struct Unit { int pm, pn, par; };
struct Gemm { const bf16_t* A; const bf16_t* Bt; int lda, ldb, K; };

struct StaticOrder {
    int nM, nN, nwg, G, c, lda, ldb, bm;
    __device__ void init(int nM_, int nN_, int G_, int c_, int lda_, int ldb_, int bm_ = BM) { nM = nM_; nN = nN_; nwg = nM * nN; G = G_; c = c_; lda = lda_; ldb = ldb_; bm = bm_; }
    __device__ bool next(int i, Unit& u) const {
        const long L = (long)i * G + c; if (L >= nwg) return false;
        int wgid = (int)L; { const int q = nwg / NXCD, r = nwg % NXCD, xcd = wgid % NXCD, off = wgid / NXCD; wgid = (xcd < r ? xcd * (q + 1) : r * (q + 1) + (xcd - r) * q) + off; }
        const int nig = WGM * nN, gid = wgid / nig, fm = gid * WGM, gsz = (nM - fm) < WGM ? (nM - fm) : WGM;
        u.pm = fm + ((wgid % nig) % gsz); u.pn = (wgid % nig) / gsz; return true;
    }
    __device__ __forceinline__ size_t aoff(const Unit& u) const { return (size_t)u.pm * bm * lda * 2; }
    __device__ __forceinline__ size_t boff(const Unit& u) const { return (size_t)u.pn * BM * ldb * 2; }
};
struct GroupOrder {
    int nM, ng, nwg, G, c, lda, ldb, akoff;
    __device__ void init(int nM_, int ng_, int G_, int c_, int lda_, int ldb_, int akoff_) { nM = nM_; ng = ng_; nwg = nM * ng; G = G_; c = c_; lda = lda_; ldb = ldb_; akoff = akoff_; }
    __device__ bool next(int i, Unit& u) const {
        const long L = (long)i * G + c; if (L >= nwg) return false;
        u.pm = (int)(L / ng); u.pn = (int)(L % ng); return true;
    }
    __device__ __forceinline__ size_t aoff(const Unit& u) const { return ((size_t)u.pm * BM * lda + (size_t)u.pn * akoff) * 2; }
    __device__ __forceinline__ size_t boff(const Unit& u) const { return (size_t)u.pn * BM * ldb * 2; }
};

struct HeadOrder {
    int nM, nt, nwg, G, c, lda, ldb, akoff;
    __device__ void init(int nM_, int nt_, int G_, int c_, int lda_, int ldb_, int akoff_) { nM = nM_; nt = nt_; nwg = nM * nt; G = G_; c = c_; lda = lda_; ldb = ldb_; akoff = akoff_; }
    __device__ bool next(int i, Unit& u) const {
        const long L = (long)i * G + c; if (L >= nwg) return false;
        u.pm = (int)(L / nt); u.pn = (int)(L % nt); return true;
    }
    __device__ __forceinline__ size_t aoff(const Unit& u) const { return ((size_t)u.pm * BM * lda + (size_t)(u.pn >> 1) * akoff) * 2; }
    __device__ __forceinline__ size_t boff(const Unit& u) const { return (size_t)u.pn * BM * ldb * 2; }
};

template <class Epi, class Sched, bool ALIGN_EPI = true, bool SP2 = true, int NM = 4>
__device__ __forceinline__ void gemm_phase(LAS unsigned char* lds, const Gemm g, const Sched& S, const Epi& E, int wid) {
    const int lane = lau_v(lane_id()), tid = wid * 64 + lane, wr = wid >> 2, wc = wid & 3, fr = lane & 15, fq = lane >> 4;
    const int K = g.K, nt = K / BK;
    unsigned voffA[2], voffB[2];
#pragma unroll
    for (int i = 0; i < 2; ++i) { int R, C; stage_rc(tid * 16 + i * 8192, R, C); const int Rb = Epi::PERM ? ((R & ~31) + perm32(R & 31)) : R;
        voffA[i] = (unsigned)(R * g.lda + C) * 2u; voffB[i] = (unsigned)(Rb * g.ldb + C) * 2u; }
    const size_t kstep = (size_t)(BK * 2);
    const size_t hstepA = (size_t)(32 * NM) * g.lda * 2, hstepB = (size_t)HALF * g.ldb * 2;
    const unsigned ldsw = (unsigned)wid * 1024u;
    const int aoff = lds_byte(wr * (16 * NM) + fr, fq * 8), boff = lds_byte(wc * 32 + fr, fq * 8);
#define PG8_SA(b, h) (((b) * 2 + (h)) * HTB)
#define PG8_SB(b, h) ((4 + (b) * 2 + (h)) * HTB)
#define PG8_STAGE(bufoff, gbase, voff) do { _Pragma("unroll") for (int _i = 0; _i < 2; ++_i) \
        __builtin_amdgcn_global_load_lds((const unsigned*)((const char*)(gbase) + (voff)[_i]), (LAS unsigned*)(lds + (bufoff) + ldsw + _i * 8192), 16, 0, 0); } while (0)
#define PG8_LDA(dst, b, h) do { _Pragma("unroll") for (int m = 0; m < NM; ++m) _Pragma("unroll") for (int k = 0; k < 2; ++k) dst[m][k] = *(const LAS bf16x8*)(lds + PG8_SA(b, h) + aoff + m * 2048 + k * 1024); } while (0)
#define PG8_LDB(dst, b, h) do { _Pragma("unroll") for (int n = 0; n < 2; ++n) _Pragma("unroll") for (int k = 0; k < 2; ++k) dst[n][k] = *(const LAS bf16x8*)(lds + PG8_SB(b, h) + boff + n * 2048 + k * 1024); } while (0)
#define PG8_MMA(ai, bj, At, Bt) do { __builtin_amdgcn_s_setprio(1); _Pragma("unroll") for (int m = 0; m < NM; ++m) _Pragma("unroll") for (int n = 0; n < 2; ++n) _Pragma("unroll") for (int k = 0; k < 2; ++k) \
        acc[ai][bj][m][n] = __builtin_amdgcn_mfma_f32_16x16x32_bf16(Bt[n][k], At[m][k], acc[ai][bj][m][n], 0, 0, 0); __builtin_amdgcn_s_setprio(0); } while (0)
#define PG8_WAIT_V(n) asm volatile("s_waitcnt vmcnt(" #n ")" ::: "memory")
#define PG8_WAIT_L(n) asm volatile("s_waitcnt lgkmcnt(" #n ")" ::: "memory")
#define PG8_BAR __builtin_amdgcn_s_barrier()
#define PG8_SCHED __builtin_amdgcn_sched_barrier(0)
    Unit cur, nxt; int ui = 0;
    if (!S.next(0, cur)) return;
    cur.par = 0;
    f32x4 acc[2][2][NM][2];
#pragma unroll
    for (int a = 0; a < 2; ++a)
#pragma unroll
        for (int b = 0; b < 2; ++b)
#pragma unroll
            for (int m = 0; m < NM; ++m)
#pragma unroll
                for (int n = 0; n < 2; ++n) acc[a][b][m][n] = (f32x4){0.f, 0.f, 0.f, 0.f};
    bf16x8 At[NM][2], B0[2][2], B1[2][2];
    const char* cA = (const char*)g.A + S.aoff(cur); const char* cB = (const char*)g.Bt + S.boff(cur);
    if constexpr (SP2) {
        PG8_STAGE(PG8_SB(0, 0), cB, voffB); PG8_STAGE(PG8_SB(0, 1), cB + hstepB, voffB); PG8_STAGE(PG8_SA(0, 0), cA, voffA); PG8_STAGE(PG8_SA(0, 1), cA + hstepA, voffA);
        if (wr == 1) PG8_BAR;
        PG8_WAIT_V(2); PG8_BAR;
        PG8_STAGE(PG8_SB(1, 0), cB + kstep, voffB); PG8_STAGE(PG8_SA(1, 0), cA + kstep, voffA); PG8_STAGE(PG8_SB(1, 1), cB + hstepB + kstep, voffB);
        PG8_WAIT_V(6); PG8_BAR;
    } else {
        PG8_STAGE(PG8_SB(0, 0), cB, voffB); PG8_STAGE(PG8_SA(0, 0), cA, voffA); PG8_STAGE(PG8_SB(0, 1), cB + hstepB, voffB); PG8_STAGE(PG8_SA(0, 1), cA + hstepA, voffA);
        if (wr == 1) PG8_BAR;
        PG8_WAIT_V(4); PG8_BAR;
        PG8_STAGE(PG8_SB(1, 0), cB + kstep, voffB); PG8_STAGE(PG8_SA(1, 0), cA + kstep, voffA); PG8_STAGE(PG8_SB(1, 1), cB + hstepB + kstep, voffB);
        PG8_WAIT_V(6); PG8_BAR;
    }
    for (;;) {
        const bool has_next = S.next(ui + 1, nxt);
        const char* nA = has_next ? (const char*)g.A + S.aoff(nxt) : cA; const char* nB = has_next ? (const char*)g.Bt + S.boff(nxt) : cB;
        if constexpr (Epi::PRE) E.pre(lds, cur, wid);
        for (int t = 0; t < nt; t += 2) {
            const bool last = (t == nt - 2);
            const char* a1 = cA + (size_t)(t + 1) * kstep;
            const char* a2 = last ? nA : cA + (size_t)(t + 2) * kstep; const char* b2 = last ? nB : cB + (size_t)(t + 2) * kstep;
            const char* a3 = a2 + kstep; const char* b3 = b2 + kstep;
            if constexpr (SP2) {
            PG8_LDB(B0, 0, 0); PG8_LDB(B1, 0, 1); PG8_SCHED; PG8_LDA(At, 0, 0); PG8_STAGE(PG8_SA(1, 1), a1 + hstepA, voffA);
            PG8_WAIT_V(8); PG8_WAIT_L(0); PG8_BAR; PG8_MMA(0, 0, At, B0); PG8_MMA(0, 1, At, B1); PG8_BAR; PG8_SCHED;
            PG8_LDA(At, 0, 1); PG8_STAGE(PG8_SB(0, 0), b2, voffB); PG8_STAGE(PG8_SB(0, 1), b2 + hstepB, voffB); PG8_STAGE(PG8_SA(0, 0), a2, voffA);
            PG8_WAIT_V(8); PG8_WAIT_L(0); PG8_BAR; PG8_MMA(1, 0, At, B0); PG8_MMA(1, 1, At, B1); PG8_BAR; PG8_SCHED;
            PG8_LDB(B0, 1, 0); PG8_LDB(B1, 1, 1); PG8_SCHED; PG8_LDA(At, 1, 0); PG8_STAGE(PG8_SA(0, 1), a2 + hstepA, voffA);
            PG8_WAIT_V(8); PG8_WAIT_L(0); PG8_BAR; PG8_MMA(0, 0, At, B0); PG8_MMA(0, 1, At, B1); PG8_BAR; PG8_SCHED;
            PG8_LDA(At, 1, 1); PG8_STAGE(PG8_SB(1, 0), b3, voffB); PG8_STAGE(PG8_SB(1, 1), b3 + hstepB, voffB); PG8_STAGE(PG8_SA(1, 0), a3, voffA);
            PG8_WAIT_V(8); PG8_WAIT_L(0); PG8_BAR; PG8_MMA(1, 0, At, B0); PG8_MMA(1, 1, At, B1); PG8_BAR; PG8_SCHED;
            } else {
            PG8_LDB(B0, 0, 0); PG8_SCHED; PG8_LDA(At, 0, 0); PG8_STAGE(PG8_SA(1, 1), a1 + hstepA, voffA);
            PG8_WAIT_L(8); PG8_BAR; PG8_WAIT_L(0); PG8_MMA(0, 0, At, B0); PG8_BAR; PG8_SCHED;
            PG8_LDB(B1, 0, 1); PG8_STAGE(PG8_SB(0, 0), b2, voffB);
            PG8_BAR; PG8_WAIT_L(0); PG8_MMA(0, 1, At, B1); PG8_BAR;
            PG8_LDA(At, 0, 1); PG8_STAGE(PG8_SA(0, 0), a2, voffA);
            PG8_BAR; PG8_WAIT_L(0); PG8_MMA(1, 0, At, B0); PG8_BAR; PG8_SCHED;
            PG8_STAGE(PG8_SB(0, 1), b2 + hstepB, voffB);
            PG8_WAIT_V(6); PG8_BAR; PG8_MMA(1, 1, At, B1); PG8_BAR;
            PG8_LDB(B0, 1, 0); PG8_SCHED; PG8_LDA(At, 1, 0); PG8_STAGE(PG8_SA(0, 1), a2 + hstepA, voffA);
            PG8_WAIT_L(8); PG8_BAR; PG8_WAIT_L(0); PG8_MMA(0, 0, At, B0); PG8_BAR; PG8_SCHED;
            PG8_LDB(B1, 1, 1); PG8_STAGE(PG8_SB(1, 0), b3, voffB);
            PG8_BAR; PG8_WAIT_L(0); PG8_MMA(0, 1, At, B1); PG8_BAR;
            PG8_LDA(At, 1, 1); PG8_STAGE(PG8_SA(1, 0), a3, voffA);
            PG8_BAR; PG8_WAIT_L(0); PG8_MMA(1, 0, At, B0); PG8_BAR; PG8_SCHED;
            PG8_STAGE(PG8_SB(1, 1), b3 + hstepB, voffB);
            PG8_WAIT_V(6); PG8_BAR; PG8_MMA(1, 1, At, B1); PG8_BAR;
            }
        }
        if constexpr (ALIGN_EPI) { if (wr == 0) PG8_BAR; }
        E(acc, cur, wr, wc, fr, fq);
        if (!has_next) break;
#pragma unroll
        for (int a = 0; a < 2; ++a)
#pragma unroll
            for (int b = 0; b < 2; ++b)
#pragma unroll
                for (int m = 0; m < NM; ++m)
#pragma unroll
                    for (int n = 0; n < 2; ++n) acc[a][b][m][n] = (f32x4){0.f, 0.f, 0.f, 0.f};
        cur = nxt; cA = nA; cB = nB; ++ui; cur.par = ui & 1;
        if constexpr (ALIGN_EPI) { if (wr == 1) PG8_BAR; }
    }
    PG8_WAIT_V(0);
    if constexpr (!ALIGN_EPI) { if (wr == 0) PG8_BAR; }
    PG8_BAR;
#undef PG8_SA
#undef PG8_SB
#undef PG8_STAGE
#undef PG8_LDA
#undef PG8_LDB
#undef PG8_MMA
#undef PG8_WAIT_V
#undef PG8_WAIT_L
#undef PG8_BAR
#undef PG8_SCHED
}
}
struct Frame {
    LAS unsigned char* lds;
    volatile LAS unsigned* MISC;
    unsigned* ctl;
    float* ctlf;
    int wave;
    int vcu, G;
};
struct Args { const float* in[N_IN]; float* out; unsigned char* ws; int ph_lo, ph_hi; };
typedef const Args __attribute__((address_space(4))) KArgs;
__device__ __forceinline__ KArgs* kargs() { KArgs* p = (KArgs*)__builtin_amdgcn_kernarg_segment_ptr(); asm volatile("" : "+s"(p)); return p; }
__device__ __forceinline__ int rope_row(int r) { return r < MP ? (r & (SEQ - 1)) : SEQ + ((r - MP) & (DECS - 1)); }

__device__ __forceinline__ void tr_item(const float* W, int ldn, int k0, int n0, const float* ks, const float* ns, bf16_t* WT, size_t dld, int rbase, int rstride, int dcol0, LAS float* scr, int lane) {
    f32x4 v[8];
#pragma unroll
    for (int i = 0; i < 8; ++i) v[i] = *(const f32x4*)(W + (size_t)(k0 + 8 * i + (lane >> 3)) * ldn + n0 + 4 * (lane & 7));
#pragma unroll
    for (int i = 0; i < 8; ++i) { const int kk = 8 * i + (lane >> 3); const float s = ks ? ks[k0 + kk] : 1.0f; LAS float* d = scr + kk * 33 + 4 * (lane & 7);
        d[0] = v[i][0] * s; d[1] = v[i][1] * s; d[2] = v[i][2] * s; d[3] = v[i][3] * s; }
    LDS_WAIT(); asm volatile("" ::: "memory");
    const int c = lane & 7;
#pragma unroll
    for (int j = 0; j < 4; ++j) { const int n = (lane >> 3) + 8 * j; const LAS float* s = scr + (8 * c) * 33 + n; const float sc = ns ? ns[n] : 1.0f;
        u32x4 o; o.x = cvt_pk_bf16(s[0 * 33] * sc, s[1 * 33] * sc); o.y = cvt_pk_bf16(s[2 * 33] * sc, s[3 * 33] * sc); o.z = cvt_pk_bf16(s[4 * 33] * sc, s[5 * 33] * sc); o.w = cvt_pk_bf16(s[6 * 33] * sc, s[7 * 33] * sc);
        *(u32x4*)(WT + (size_t)(rbase + rstride * n) * dld + dcol0 + k0 + 8 * c) = o; }
    LDS_WAIT(); asm volatile("" ::: "memory");
}
struct TrMat { const float* W; int K, N; const float* ks; bf16_t* WT; size_t dld; int mode; const float* ns; };
__device__ __forceinline__ void tr_mat_item(const TrMat& t, int it, LAS float* scr, int lane) {
    const int nblk = t.N / 32, kb = it / nblk, nb = it % nblk, k0 = 64 * kb, n0 = 32 * nb;
    int rbase = n0, rstride = 1, dcol0 = 0;
    if (t.mode == 1) { rbase = n0 < 1024 ? n0 : (n0 < 1088 ? 2048 + (n0 - 1024) : 1024 + (n0 - 1088)); }
    else if (t.mode == 2) { const int h = n0 / 192, c = n0 % 192; if (c >= 128) { const int j0 = c - 128; rbase = h * 192 + 128 + (j0 >= 32 ? 1 : 0); rstride = 2; } }
    else if (t.mode == 3) { dcol0 = (n0 / 128) * 512; }
    else if (t.mode == 5) { const int isb = n0 >= DFF ? 1 : 0, j0 = n0 - isb * DFF; rbase = (j0 / 128) * 256 + isb * 128 + (j0 % 128); }
    tr_item(t.W, t.N, k0, n0, t.ks, t.ns ? t.ns + n0 : nullptr, t.WT, t.dld, rbase, rstride, dcol0, scr, lane);
}
__device__ __forceinline__ void sincos_red(float ang, float& sn, float& cs) {
    const double a = (double)ang, k = rint(a * 0.63661977236758134308), r = a - k * 1.57079632679489661923;
    const float x = (float)r, x2 = x * x;
    const float s = x + x * x2 * (-1.6666667e-1f + x2 * (8.3333333e-3f + x2 * (-1.9841270e-4f + x2 * 2.7557319e-6f)));
    const float c = 1.0f + x2 * (-0.5f + x2 * (4.1666667e-2f + x2 * (-1.3888889e-3f + x2 * (2.4801587e-5f + x2 * -2.7557319e-7f))));
    const int q = ((int)k) & 3;
    sn = (q == 0) ? s : (q == 1) ? c : (q == 2) ? -s : -c;
    cs = (q == 0) ? c : (q == 1) ? -s : (q == 2) ? -c : s;
}
enum { CM_WINA = 0, CM_WQB = 2, CM_WUK = 4, CM_WUV = 6, CM_WPOOL = 8, CM_WOUTA = 16, CM_WINC = 18, CM_WOUTC = 20, CM_WUP = 22, CM_WDOWN = 26, CM_FILL = 30 };
constexpr unsigned cm_attn(int i) { return (1u << (CM_WINA + i)) | (1u << (CM_WQB + i)) | (1u << (CM_WUK + i)) | (1u << (CM_WUV + i)) | (0xFu << (CM_WPOOL + 4 * i)) | (1u << (CM_WOUTA + i)) | (1u << (CM_FILL + i)); }
__device__ __forceinline__ TrMat conv_mat(KArgs* A_k, unsigned char* ws, int id) {
    TrMat t{};
    if (id < CM_WQB) { const int i = id - CM_WINA; t = TrMat{as_global(A_k->in[I_WINA]) + (size_t)i * DM * INA, DM, INA, as_global(A_k->in[I_GMIX]) + (size_t)(2 * i) * DM, (bf16_t*)(ws + WS_WINA) + (size_t)i * INA_PAD * DM, (size_t)DM, 1, nullptr}; }
    else if (id < CM_WUK) { const int i = id - CM_WQB; t = TrMat{as_global(A_k->in[I_WQB]) + (size_t)i * QR * 1536, QR, 1536, as_global(A_k->in[I_GQA]) + (size_t)i * QR, (bf16_t*)(ws + WS_WQB) + (size_t)i * 1536 * QR, (size_t)QR, 2, nullptr}; }
    else if (id < CM_WUV) { const int i = id - CM_WUK; t = TrMat{as_global(A_k->in[I_WUK]) + (size_t)i * KVR * 1024, KVR, 1024, nullptr, (bf16_t*)(ws + WS_WKV) + (size_t)i * 2048 * KVR, (size_t)KVR, 0, nullptr}; }
    else if (id < CM_WPOOL) { const int i = id - CM_WUV; t = TrMat{as_global(A_k->in[I_WUV]) + (size_t)i * KVR * 1024, KVR, 1024, nullptr, (bf16_t*)(ws + WS_WKV) + (size_t)i * 2048 * KVR + (size_t)1024 * KVR, (size_t)KVR, 0, nullptr}; }
    else if (id < CM_WOUTA) { const int ig = id - CM_WPOOL; t = TrMat{as_global(A_k->in[I_WPOOL]) + (size_t)ig * 256 * 256, 256, 256, nullptr, (bf16_t*)(ws + WS_WPOOL) + (size_t)ig * 256 * 256, (size_t)256, 0, as_global(A_k->in[I_PSCALE]) + (size_t)ig * 256}; }
    else if (id < CM_WINC) { const int i = id - CM_WOUTA; t = TrMat{as_global(A_k->in[I_WOUTA]) + (size_t)i * DM * DM, DM, DM, nullptr, (bf16_t*)(ws + WS_WOUTA) + (size_t)i * DM * DM, (size_t)DM, 0, nullptr}; }
    else if (id < CM_WOUTC) { const int i = id - CM_WINC; t = TrMat{as_global(A_k->in[I_WINC]) + (size_t)i * DM * INC, DM, INC, as_global(A_k->in[I_GMIX]) + (size_t)(2 * i + 1) * DM, (bf16_t*)(ws + WS_WINC) + (size_t)i * INC * DM, (size_t)DM, 0, nullptr}; }
    else if (id < CM_WUP) { const int i = id - CM_WOUTC; t = TrMat{as_global(A_k->in[I_WOUTC]) + (size_t)i * DM * DM, DM, DM, nullptr, (bf16_t*)(ws + WS_WOUTC) + (size_t)i * DM * DM, (size_t)DM, 0, nullptr}; }
    else if (id < CM_WDOWN) { const int l = id - CM_WUP; t = TrMat{as_global(A_k->in[I_WUP]) + (size_t)l * DM * DFF2, DM, DFF2, as_global(A_k->in[I_GFFN]) + (size_t)l * DM, (bf16_t*)(ws + WS_WUP) + (size_t)l * DFF2 * DM, (size_t)DM, 5, nullptr}; }
    else { const int l = id - CM_WDOWN; t = TrMat{as_global(A_k->in[I_WDOWN]) + (size_t)l * DFF * DM, DFF, DM, nullptr, (bf16_t*)(ws + WS_WDOWN) + (size_t)l * DM * DFF, (size_t)DFF, 0, nullptr}; }
    return t;
}
__device__ __forceinline__ void conv_run(const Frame& F, KArgs* A_k, unsigned mask, int widx, int nw) {
    LAS float* scr = (LAS float*)(F.lds + F.wave * 16384);
    const int lane = lau_v(lane_id()); unsigned char* ws = lau_s(A_k->ws);
    int first = widx;
#pragma unroll 1
    for (int id = 0; id < CM_FILL; ++id) {
        if (!((mask >> id) & 1u)) continue;
        const TrMat t = conv_mat(A_k, ws, id); const int n = (t.K / 64) * (t.N / 32);
        int it = first;
#pragma unroll 1
        for (; it < n; it += nw) tr_mat_item(t, it, scr, lane);
        first = it - n;
    }
#pragma unroll 1
    for (int i = 0; i < NEVEN; ++i) {
        if (!((mask >> (CM_FILL + i)) & 1u)) continue;
        const unsigned tix = (unsigned)(widx * 64 + lau_v(lane)), nthr = (unsigned)nw * 64u; const unsigned z_ = (unsigned)lau_v(0); const u32x4 z4 = {z_, z_, z_, z_};
        for (unsigned c = tix; c < (unsigned)((INA_PAD - INA) * DM / 8); c += nthr) *(u32x4*)((bf16_t*)(ws + WS_WINA) + ((size_t)i * INA_PAD + INA) * DM + (size_t)c * 8) = z4;
        for (unsigned c = tix; c < 4096u * 16u; c += nthr) {
            const int row = (int)(c / 16), d0 = (int)(c % 16) * 8, h = row / 512, r = row % 512;
            const float* s = as_global(A_k->in[I_WUK]) + (((size_t)i * KVR + r) * HEADS + h) * NOPE + d0; const f32x4 a = *(const f32x4*)s, b = *(const f32x4*)(s + 4);
            u32x4 o; o.x = cvt_pk_bf16(a[0], a[1]); o.y = cvt_pk_bf16(a[2], a[3]); o.z = cvt_pk_bf16(b[0], b[1]); o.w = cvt_pk_bf16(b[2], b[3]);
            *(u32x4*)((bf16_t*)(ws + WS_WUKBD) + (size_t)i * 4096 * 128 + (size_t)row * 128 + d0) = o; }
    }
}
constexpr unsigned CJ_PROLOGUE = cm_attn(0) | (1u << (CM_WUP + 0)) | (1u << (CM_WINC + 0)) | (1u << (CM_WINC + 1)) | (1u << (CM_WUP + 2));
constexpr unsigned CJ_INA0 = (1u << (CM_WOUTC + 0)), CJ_INA2 = (1u << (CM_WOUTC + 1));
constexpr unsigned CJ_UP0 = (1u << (CM_WDOWN + 0)), CJ_UP1 = (1u << (CM_WDOWN + 1)), CJ_UP2 = (1u << (CM_WDOWN + 2));
constexpr unsigned CJ_GLA1 = (1u << (CM_WUP + 1)) | cm_attn(1), CJ_GLA3 = (1u << (CM_WUP + 3)) | (1u << (CM_WDOWN + 3));
static_assert((CJ_PROLOGUE | CJ_INA0 | CJ_INA2 | CJ_UP0 | CJ_UP1 | CJ_UP2 | CJ_GLA1 | CJ_GLA3) == 0xFFFFFFFFu, "every matrix is converted exactly once");
static_assert((CJ_PROLOGUE ^ CJ_INA0 ^ CJ_INA2 ^ CJ_UP0 ^ CJ_UP1 ^ CJ_UP2 ^ CJ_GLA1 ^ CJ_GLA3) == 0xFFFFFFFFu, "every matrix is converted exactly once");
__device__ __forceinline__ void p0_prologue(const Frame& F, KArgs* A_k) {
    LAS float* scr = (LAS float*)(F.lds + F.wave * 16384);
    const int lane = lau_v(lane_id());
    const int gw = lau_si(F.vcu * NWAVES + F.wave), NGW = F.G * NWAVES;
    const size_t gt = (size_t)gw * 64 + lane, NGT = (size_t)NGW * 64;
    unsigned char* ws = lau_s(A_k->ws);
    conv_run(F, A_k, CJ_PROLOGUE, gw, NGW);
    for (size_t c = gt; c < (size_t)NPOS * 32; c += NGT) {
        const int pr = (int)(c / 32), j = (int)(c % 32); const float pos = (float)(pr < SEQ ? pr : PAST + (pr - SEQ));
        const float inv = exp2f(-((float)(2 * j) / 64.0f) * 13.287712379549449f); const float ang = pos * inv; float sn, cs; sincos_red(ang, sn, cs);
        ((f32x2*)(ws + WS_ROPE))[c] = (f32x2){cs, sn}; }
    for (size_t c = gt; c < (size_t)2048; c += NGT) {
        const float p0 = as_global(A_k->in[I_LB])[c], p1 = as_global(A_k->in[I_LB])[2048 + c], mx = fmaxf(p0, p1), e0 = expf(p0 - mx), e1 = expf(p1 - mx), s0 = e0 / (e0 + e1), s1 = e1 / (e0 + e1);
        float* lb = (float*)(ws + WS_LBS); lb[c] = fminf(fmaxf(s0 - s0, 0.f), 1.f); lb[2048 + c] = fminf(fmaxf((s0 + s1) - s0, 0.f), 1.f); }
    for (int r0 = gw; r0 < MT; r0 += 3 * NGW) {
        f32x4 v[3][8];
#pragma unroll
        for (int k = 0; k < 3; ++k) { const int r = r0 + k * NGW; if (r < MT) {
            const float* xr = r < MP ? as_global(A_k->in[I_XP]) + (size_t)r * DM : as_global(A_k->in[I_XS]) + (size_t)(r - MP) * DM;
#pragma unroll
            for (int j = 0; j < 8; ++j) v[k][j] = *(const f32x4*)(xr + (64 * j + lane) * 4); } }
        asm volatile("" ::: "memory");
#pragma unroll
        for (int k = 0; k < 3; ++k) { const int r = r0 + k * NGW; if (r < MT) {
            bf16_t* xb = (bf16_t*)(ws + WS_XB) + (size_t)r * DM; float s = 0.f;
#pragma unroll
            for (int j = 0; j < 8; ++j) { const f32x4 w = v[k][j]; s += (w[0] * w[0] + w[1] * w[1]) + (w[2] * w[2] + w[3] * w[3]);
                u32x2 o; o.x = cvt_pk_bf16(w[0], w[1]); o.y = cvt_pk_bf16(w[2], w[3]); *(u32x2*)(xb + (64 * j + lane) * 4) = o; }
            s = wave_sum(s); if (lane == 0) ((float*)(ws + WS_RSTD))[r] = rsqrtf(s * (1.0f / DM) + EPS); } }
    }
}
#define EPI_ROWS(u) { const int _l = lane_id(); fr = _l & 15; fq = _l >> 4; } const int row0 = (u).pm * 256 + wr * 64 + fr
#define EPI_ROW(ai, m) (row0 + (ai) * 128 + (m) * 16)

struct EpiInA {
    static constexpr bool PERM = false, PRE = true;
    unsigned char* ws; float* out; int li; LAS unsigned char* lds;
    __device__ __forceinline__ void pre(LAS unsigned char* l, const pg8::Unit& u, int wid) const {
        if (wid == 4) { const float* src = (const float*)(ws + WS_RSTD) + (size_t)(4 * li) * MT + u.pm * 256 + lane_id() * 4;
            __builtin_amdgcn_global_load_lds((const unsigned*)src, (LAS unsigned*)(l + EPI_RS + u.par * 1024), 16, 0, 0); }
    }
    __device__ __forceinline__ void operator()(const f32x4 (&acc)[2][2][4][2], const pg8::Unit& u, int wr, int wc, int fr, int fq) const {
        EPI_ROWS(u); const int pn = u.pn, cb = wc * 32 + 4 * fq;
        const LAS float* rsl = (const LAS float*)(lds + EPI_RS + u.par * 1024) + wr * 64 + fr; float* ssqq = (float*)(ws + WS_SSQQ) + (size_t)(li * 8 + (pn & 1) * 4 + wc) * MT; float* ssqkv = (float*)(ws + WS_SSQKV) + (size_t)(li * 8 + (pn & 1) * 4 + wc) * MT;
        bf16_t* cqb = (bf16_t*)(ws + WS_CQB); bf16_t* zb = (bf16_t*)(ws + WS_ZB);
#pragma unroll
        for (int ai = 0; ai < 2; ++ai)
#pragma unroll
            for (int m = 0; m < 4; ++m) {
                const int r = EPI_ROW(ai, m); const float rs = rsl[ai * 128 + m * 16];
                f32x4 v[2][2]; float sq = 0.f;
#pragma unroll
                for (int bj = 0; bj < 2; ++bj)
#pragma unroll
                    for (int n = 0; n < 2; ++n) { v[bj][n] = acc[ai][bj][m][n] * rs; sq += (v[bj][n][0] * v[bj][n][0] + v[bj][n][1] * v[bj][n][1]) + (v[bj][n][2] * v[bj][n][2] + v[bj][n][3] * v[bj][n][3]); }
                if (pn < 2) {
                    bf16_t* o = cqb + (size_t)r * QR + pn * 256 + cb;
#pragma unroll
                    for (int bj = 0; bj < 2; ++bj)
#pragma unroll
                        for (int n = 0; n < 2; ++n) { u32x2 w; w.x = cvt_pk_bf16(v[bj][n][0], v[bj][n][1]); w.y = cvt_pk_bf16(v[bj][n][2], v[bj][n][3]); *(u32x2*)(o + bj * 128 + n * 16) = w; }
                    sq = row4_sum(sq); if (fq == 0) ssqq[r] = sq;
                } else if (pn < 4) {
                    float* o = (r < MP ? out + O_LATP + ((size_t)li * MP + r) * KVR : out + O_LATS + ((size_t)li * MS + (r - MP)) * KVR) + (pn - 2) * 256 + cb;
#pragma unroll
                    for (int bj = 0; bj < 2; ++bj)
#pragma unroll
                        for (int n = 0; n < 2; ++n) *(f32x4*)(o + bj * 128 + n * 16) = v[bj][n];
                    sq = row4_sum(sq); if (fq == 0) ssqkv[r] = sq;
                } else if (pn < 8) {
                    bf16_t* o = zb + (size_t)r * POOLW + (pn - 4) * 256 + cb;
#pragma unroll
                    for (int bj = 0; bj < 2; ++bj)
#pragma unroll
                        for (int n = 0; n < 2; ++n) { u32x2 w; w.x = cvt_pk_bf16(v[bj][n][0], v[bj][n][1]); w.y = cvt_pk_bf16(v[bj][n][2], v[bj][n][3]); *(u32x2*)(o + bj * 128 + n * 16) = w; }
                    float* po = nullptr;
                    if (r < MP) { const int t = r & (SEQ - 1); if (t >= SEQ - POOLKEEP) po = out + O_POOLP + (((size_t)li * BATCH + (r >> 11)) * POOLKEEP + (t - (SEQ - POOLKEEP))) * POOLW; }
                    else { const int rr = r - MP, t = rr & (DECS - 1); if (t >= DECS - POOLKEEP) po = out + O_POOLS + (((size_t)li * DECB + (rr >> 6)) * POOLKEEP + (t - (DECS - POOLKEEP))) * POOLW; }
                    if (po) { po += (pn - 4) * 256 + cb;
#pragma unroll
                        for (int bj = 0; bj < 2; ++bj)
#pragma unroll
                            for (int n = 0; n < 2; ++n) *(f32x4*)(po + bj * 128 + n * 16) = v[bj][n]; }
                } else {
                    float* o = (r < MP ? out + O_KPEP + ((size_t)li * MP + r) * ROPE : out + O_KPES + ((size_t)li * MS + (r - MP)) * ROPE) + cb;
                    if (cb < 64) {
#pragma unroll
                        for (int n = 0; n < 2; ++n) *(f32x4*)(o + n * 16) = v[0][n]; }
                }
            }
    }
};

__device__ __forceinline__ void post_a_phase(const Frame& F, KArgs* A_, int li) {
    const int lane = lau_v(lane_id()); struct { unsigned char* ws; float* out; } A{lau_s(A_->ws), lau_s(A_->out)};
    const int gw = lau_si(F.vcu * NWAVES + F.wave), NGW = F.G * NWAVES;
    const float* ssqkv = (const float*)(A.ws + WS_SSQKV) + (size_t)li * 8 * MT; const float* gk = as_global(A_->in[I_GKVA]) + (size_t)li * KVR;
    bf16_t* kvn = (bf16_t*)(A.ws + WS_KVN); bf16_t* kp = (bf16_t*)(A.ws + WS_KP); const f32x2* rope = (const f32x2*)(A.ws + WS_ROPE);
    const f32x4 g0 = *(const f32x4*)(gk + lane * 8), g1 = *(const f32x4*)(gk + lane * 8 + 4);
    for (int r0 = gw; r0 < MT; r0 += 3 * NGW) {
        float pq[3][8]; f32x4 av[3], bv[3]; float x1[3] = {}, x2[3] = {}; f32x2 cs[3] = {};
#pragma unroll
        for (int k = 0; k < 3; ++k) { const int r = r0 + k * NGW; if (r < MT) {
#pragma unroll
            for (int s = 0; s < 8; ++s) pq[k][s] = ssqkv[(size_t)s * MT + r];
            const float* lp = (r < MP ? A.out + O_LATP + ((size_t)li * MP + r) * KVR : A.out + O_LATS + ((size_t)li * MS + (r - MP)) * KVR) + lane * 8;
            av[k] = *(const f32x4*)lp; bv[k] = *(const f32x4*)(lp + 4);
            const float* kq = (r < MP ? A.out + O_KPEP + ((size_t)li * MP + r) * ROPE : A.out + O_KPES + ((size_t)li * MS + (r - MP)) * ROPE);
            if (lane < 32) { x1[k] = kq[lane]; x2[k] = kq[32 + lane]; cs[k] = rope[(size_t)rope_row(r) * 32 + lane]; } } }
        asm volatile("" ::: "memory");
#pragma unroll
        for (int k = 0; k < 3; ++k) { const int r = r0 + k * NGW; if (r < MT) {
            float sk = 0.f;
#pragma unroll
            for (int s = 0; s < 8; ++s) sk += pq[k][s];
            const float rs = rsqrtf(sk * (1.0f / KVR) + EPS);
            float* lp = (r < MP ? A.out + O_LATP + ((size_t)li * MP + r) * KVR : A.out + O_LATS + ((size_t)li * MS + (r - MP)) * KVR) + lane * 8;
            const f32x4 a = av[k] * rs * g0, b = bv[k] * rs * g1;
            *(f32x4*)lp = a; *(f32x4*)(lp + 4) = b;
            u32x4 o; o.x = cvt_pk_bf16(a[0], a[1]); o.y = cvt_pk_bf16(a[2], a[3]); o.z = cvt_pk_bf16(b[0], b[1]); o.w = cvt_pk_bf16(b[2], b[3]);
            *(u32x4*)(kvn + (size_t)r * KVW + lane * 8) = o;
            float* kq = (r < MP ? A.out + O_KPEP + ((size_t)li * MP + r) * ROPE : A.out + O_KPES + ((size_t)li * MS + (r - MP)) * ROPE);
            if (lane < 32) {
                const float o1 = x1[k] * cs[k].x - x2[k] * cs[k].y, o2 = x1[k] * cs[k].y + x2[k] * cs[k].x;
                kq[lane] = o1; kq[32 + lane] = o2;
                const unsigned pk = cvt_pk_bf16(o1, o2);
                *(unsigned*)(kvn + (size_t)r * KVW + KVR + 2 * lane) = pk;
                if (r < MP) {
#pragma unroll
                    for (int h = 0; h < HEADS; ++h) *(unsigned*)(kp + ((size_t)r * HEADS + h) * QKD + NOPE + 2 * lane) = pk; }
            } } }
    }
}

__device__ __forceinline__ void pool_prep_phase(const Frame& F, KArgs* A_, int li) {
    const int lane = lau_v(lane_id()); struct { unsigned char* ws; } A{lau_s(A_->ws)};
    const int gw = lau_si(F.vcu * NWAVES + F.wave), NGW = F.G * NWAVES;
    const size_t gt = (size_t)gw * 64 + lane, NGT = (size_t)NGW * 64;
    const bf16_t* zb = (const bf16_t*)(A.ws + WS_ZB); bf16_t* pb = (bf16_t*)(A.ws + WS_PB);
    const float* sp = as_global(A_->in[I_SPOOL]) + (size_t)li * DECB * POOLKEEP * POOLW;
    for (size_t it = gt; it < (size_t)(MT / 16) * 128; it += NGT) {
        const int rb = (int)(it / 128), cg = (int)(it % 128), col = cg * 8, w = 2 << (cg >> 5);
        const int r0 = rb * 16; const bool prompt = r0 < MP;
        const int t0 = prompt ? (r0 & (SEQ - 1)) : ((r0 - MP) & (DECS - 1)); const int seqrow0 = r0 - t0;
        const int bs = prompt ? 0 : (r0 - MP) >> 6;
        float sum[8];
#pragma unroll
        for (int e = 0; e < 8; ++e) sum[e] = 0.f;
        auto loadz = [&](int t, float (&z)[8]) {
            if (t >= 0) { const u32x4 q = *(const u32x4*)(zb + (size_t)(seqrow0 + t) * POOLW + col);
                z[0] = bf_lo(q.x); z[1] = bf_hi(q.x); z[2] = bf_lo(q.y); z[3] = bf_hi(q.y); z[4] = bf_lo(q.z); z[5] = bf_hi(q.z); z[6] = bf_lo(q.w); z[7] = bf_hi(q.w); }
            else if (prompt) {
#pragma unroll
                for (int e = 0; e < 8; ++e) z[e] = 0.f; }
            else { const float* s = sp + ((size_t)bs * POOLKEEP + (POOLKEEP + t)) * POOLW + col; const f32x4 a = *(const f32x4*)s, b = *(const f32x4*)(s + 4);
                z[0] = a[0]; z[1] = a[1]; z[2] = a[2]; z[3] = a[3]; z[4] = b[0]; z[5] = b[1]; z[6] = b[2]; z[7] = b[3]; }
        };
        for (int j = 1; j < w; ++j) { float z[8]; loadz(t0 - j, z);
#pragma unroll
            for (int e = 0; e < 8; ++e) sum[e] += z[e]; }
        for (int tt = 0; tt < 16; ++tt) {
            const int t = t0 + tt; float z[8], zo[8]; loadz(t, z); loadz(t - w + 1, zo);
            const float cnt = prompt ? (float)((t + 1) < w ? (t + 1) : w) : (float)w; const float ic = 1.0f / cnt;
            float p[8];
#pragma unroll
            for (int e = 0; e < 8; ++e) { sum[e] += z[e]; p[e] = sum[e] * ic - z[e]; sum[e] -= zo[e]; }
            u32x4 o; o.x = cvt_pk_bf16(p[0], p[1]); o.y = cvt_pk_bf16(p[2], p[3]); o.z = cvt_pk_bf16(p[4], p[5]); o.w = cvt_pk_bf16(p[6], p[7]);
            *(u32x4*)(pb + (size_t)(r0 + tt) * POOLW + col) = o;
        }
    }
}
__device__ __forceinline__ u32x4 pack8(const f32x4 a, const f32x4 b) { u32x4 w; w.x = cvt_pk_bf16(a[0], a[1]); w.y = cvt_pk_bf16(a[2], a[3]); w.z = cvt_pk_bf16(b[0], b[1]); w.w = cvt_pk_bf16(b[2], b[3]); return w; }

template <int MODE> struct EpiStore {
    static constexpr bool PERM = true, PRE = false;
    unsigned char* ws;
    __device__ __forceinline__ void operator()(const f32x4 (&acc)[2][2][4][2], const pg8::Unit& u, int wr, int wc, int fr, int fq) const {
        EPI_ROWS(u); const int cl = wc * 32 + 8 * fq;
#pragma unroll
        for (int bj = 0; bj < 2; ++bj) {
            bf16_t* base; size_t ldc;
            if (MODE == 0) { if (u.pn < 4) { base = (bf16_t*)(ws + WS_KP) + (2 * u.pn + bj) * QKD; ldc = HEADS * QKD; } else { base = (bf16_t*)(ws + WS_VP) + (u.pn - 4) * 256 + bj * 128; ldc = HEADS * VD; } }
            else if (MODE == 1) { base = (bf16_t*)(ws + WS_QS) + (u.pn >> 1) * KVW + (u.pn & 1) * 256 + bj * 128; ldc = HEADS * KVW; }
            else if (MODE == 2) { base = (bf16_t*)(ws + WS_YCAT) + 1024 + u.pn * 256 + bj * 128; ldc = DM; }
            else { base = (bf16_t*)(ws + WS_YCAT) + (size_t)MP * DM + u.pn * 256 + bj * 128; ldc = DM; }
#pragma unroll
            for (int ai = 0; ai < 2; ++ai)
#pragma unroll
                for (int m = 0; m < 4; ++m) *(u32x4*)(base + (size_t)EPI_ROW(ai, m) * ldc + cl) = pack8(acc[ai][bj][m][0], acc[ai][bj][m][1]);
        }
    }
};

struct EpiQ {
    static constexpr bool PERM = true, PRE = true;
    unsigned char* ws; int li; LAS unsigned char* lds;
    __device__ __forceinline__ void pre(LAS unsigned char* l, const pg8::Unit& u, int wid) const {
        const float* src = (const float*)(ws + WS_SSQQ) + ((size_t)li * 8 + wid) * MT + u.pm * 256 + lane_id() * 4;
        __builtin_amdgcn_global_load_lds((const unsigned*)src, (LAS unsigned*)(l + EPI_LDS + u.par * 8192 + wid * 1024), 16, 0, 0);
    }
    __device__ __forceinline__ void operator()(const f32x4 (&acc)[2][2][4][2], const pg8::Unit& u, int wr, int wc, int fr, int fq) const {
        EPI_ROWS(u); const LAS float* sql = (const LAS float*)(lds + EPI_LDS + u.par * 8192) + wr * 64 + fr; const f32x4* rope = (const f32x4*)(ws + WS_ROPE);
        bf16_t* qp = (bf16_t*)(ws + WS_QP); bf16_t* qns = (bf16_t*)(ws + WS_QNS); bf16_t* qs = (bf16_t*)(ws + WS_QS);
        int hh[2], cc[2];
#pragma unroll
        for (int bj = 0; bj < 2; ++bj) { const int c = u.pn * 256 + bj * 128 + wc * 32 + 8 * fq; hh[bj] = c / QKD; cc[bj] = c - hh[bj] * QKD; }
        f32x4 T[2][2] = {}, Tn[2][2] = {};
#define EPIQ_ROPE(dst, ai_, m_) do { const int rr_ = rope_row(EPI_ROW(ai_, m_)); _Pragma("unroll") for (int bj = 0; bj < 2; ++bj) if (cc[bj] >= NOPE) { \
            const size_t ix_ = ((size_t)rr_ * 32 + ((cc[bj] - NOPE) >> 1)) >> 1; dst[bj][0] = rope[ix_]; dst[bj][1] = rope[ix_ + 1]; } } while (0)
        EPIQ_ROPE(T, 0, 0);
#pragma unroll
        for (int k = 0; k < 8; ++k) {
            const int ai = k >> 2, m = k & 3;
            if (k < 7) EPIQ_ROPE(Tn, (k + 1) >> 2, (k + 1) & 3);
            asm volatile("" ::: "memory");
            const int r = EPI_ROW(ai, m); float sk = 0.f;
#pragma unroll
            for (int s = 0; s < 8; ++s) sk += sql[s * 256 + ai * 128 + m * 16];
            const float rs = rsqrtf(sk * (1.0f / QR) + EPS);
#pragma unroll
            for (int bj = 0; bj < 2; ++bj) {
                const int h = hh[bj], c2 = cc[bj];
                f32x4 a = acc[ai][bj][m][0] * rs, b = acc[ai][bj][m][1] * rs;
                if (c2 >= NOPE) {
                    const f32x4 t0 = T[bj][0], t1 = T[bj][1];
                    f32x4 ra, rb;
                    ra[0] = a[0] * t0[0] - a[1] * t0[1]; ra[1] = a[0] * t0[1] + a[1] * t0[0]; ra[2] = a[2] * t0[2] - a[3] * t0[3]; ra[3] = a[2] * t0[3] + a[3] * t0[2];
                    rb[0] = b[0] * t1[0] - b[1] * t1[1]; rb[1] = b[0] * t1[1] + b[1] * t1[0]; rb[2] = b[2] * t1[2] - b[3] * t1[3]; rb[3] = b[2] * t1[3] + b[3] * t1[2];
                    a = ra; b = rb;
                }
                const u32x4 w = pack8(a, b);
                if (r < MP) *(u32x4*)(qp + ((size_t)r * HEADS + h) * QKD + c2) = w;
                else if (c2 < NOPE) *(u32x4*)(qns + (size_t)(r - MP) * 1024 + h * NOPE + c2) = w;
                else *(u32x4*)(qs + ((size_t)(r - MP) * HEADS + h) * KVW + KVR + (c2 - NOPE)) = w;
            }
#pragma unroll
            for (int bj = 0; bj < 2; ++bj) { T[bj][0] = Tn[bj][0]; T[bj][1] = Tn[bj][1]; }
        }
#undef EPIQ_ROPE
    }
};

template <int NM> struct EpiRes {
    static constexpr bool PERM = true, PRE = false;
    unsigned char* ws; const float* xp; const float* xs; int first; int nidx;
    __device__ __forceinline__ void operator()(const f32x4 (&acc)[2][2][NM][2], const pg8::Unit& u, int wr, int wc, int fr, int fq) const {
        { const int _l = lane_id(); fr = _l & 15; fq = _l >> 4; } const int row0 = u.pm * (64 * NM) + wr * (16 * NM) + fr;
        const int c0 = u.pn * 256 + wc * 32 + 8 * fq; bf16_t* XB = (bf16_t*)(ws + WS_XB); float* ssq = (float*)(ws + WS_SSQP) + (size_t)(nidx * 32 + u.pn * 4 + wc) * MT;
        u32x4 q[2][NM][2];
        if (!first) {
#pragma unroll
            for (int ai = 0; ai < 2; ++ai)
#pragma unroll
                for (int m = 0; m < NM; ++m)
#pragma unroll
                    for (int bj = 0; bj < 2; ++bj) q[ai][m][bj] = *(const u32x4*)(XB + (size_t)(row0 + ai * (32 * NM) + m * 16) * DM + c0 + bj * 128);
            asm volatile("" ::: "memory");
        }
        float sqv[2][NM];
#pragma unroll
        for (int ai = 0; ai < 2; ++ai)
#pragma unroll
            for (int m = 0; m < NM; ++m) {
                const int r = row0 + ai * (32 * NM) + m * 16; float sq = 0.f;
#pragma unroll
                for (int bj = 0; bj < 2; ++bj) { const int c = c0 + bj * 128; f32x4 a, b;
                    if (first) { const float* xo = (r < MP ? xp + (size_t)r * DM : xs + (size_t)(r - MP) * DM) + c; a = *(const f32x4*)xo; b = *(const f32x4*)(xo + 4); }
                    else { const u32x4 w = q[ai][m][bj]; a = (f32x4){bf_lo(w.x), bf_hi(w.x), bf_lo(w.y), bf_hi(w.y)}; b = (f32x4){bf_lo(w.z), bf_hi(w.z), bf_lo(w.w), bf_hi(w.w)}; }
                    a = a + acc[ai][bj][m][0]; b = b + acc[ai][bj][m][1];
                    *(u32x4*)(XB + (size_t)r * DM + c) = pack8(a, b);
                    sq += ((a[0] * a[0] + a[1] * a[1]) + (a[2] * a[2] + a[3] * a[3])) + ((b[0] * b[0] + b[1] * b[1]) + (b[2] * b[2] + b[3] * b[3])); }
                sqv[ai][m] = sq;
            }
#pragma unroll
        for (int ai = 0; ai < 2; ++ai)
#pragma unroll
            for (int m = 0; m < NM; ++m) { const float sq = row4_sum(sqv[ai][m]); if (fq == 0) ssq[row0 + ai * (32 * NM) + m * 16] = sq; }
    }
};

__device__ __forceinline__ float dpp_ror1(float x) { return __builtin_bit_cast(float, __builtin_amdgcn_update_dpp(0, __builtin_bit_cast(int, x), 0x121, 0xf, 0xf, true)); }
__device__ __forceinline__ float dpp_ror2(float x) { return __builtin_bit_cast(float, __builtin_amdgcn_update_dpp(0, __builtin_bit_cast(int, x), 0x122, 0xf, 0xf, true)); }
struct EpiUp {
    static constexpr bool PERM = true, PRE = true;
    unsigned char* ws; float* out; const float* cw; const float* cb; const float* past; LAS unsigned char* lds; int layer;
    __device__ __forceinline__ void pre(LAS unsigned char* l, const pg8::Unit& u, int wid) const {
        const int lane = lane_id();
        if (wid < 4) { const int seg = 2 * wid + (lane >> 5), bj = seg & 1; const float* src = (seg < 6 ? cw + (size_t)(seg >> 1) * DFF2 : cb) + bj * DFF + u.pn * 128 + (lane & 31) * 4;
            __builtin_amdgcn_global_load_lds((const unsigned*)src, (LAS unsigned*)(l + EPI_CW + u.par * 4096 + wid * 1024), 16, 0, 0); }
        else if (wid == 4) { const float* src = (const float*)(ws + WS_RSTD) + (size_t)(2 * layer + 1) * MT + u.pm * 256 + lane * 4;
            __builtin_amdgcn_global_load_lds((const unsigned*)src, (LAS unsigned*)(l + EPI_RS + u.par * 1024), 16, 0, 0); }
    }
    __device__ __forceinline__ void operator()(const f32x4 (&acc_)[2][2][4][2], const pg8::Unit& u, int wr, int wc, int fr, int fq) const {
        f32x4 (&acc)[2][2][4][2] = const_cast<f32x4 (&)[2][2][4][2]>(acc_);
        EPI_ROWS(u); const LAS float* rsl = (const LAS float*)(lds + EPI_RS + u.par * 1024) + wr * 64 + fr; const LAS float* cwl = (const LAS float*)(lds + EPI_CW + u.par * 4096) + wc * 32 + 8 * fq; bf16_t* act = (bf16_t*)(ws + WS_ACT); float* halo = (float*)(ws + WS_HALO) + (size_t)u.pm * 4 * DFF2;
        const int ch = u.pn * 128 + wc * 32 + 8 * fq;
        const bool prompt = u.pm < MP / 256;
        LAS float* hl = (LAS float*)(lds + EPI_LDS);
#pragma unroll
        for (int ai = 0; ai < 2; ++ai)
#pragma unroll
            for (int m = 0; m < 4; ++m) {
                const int r = EPI_ROW(ai, m); const float rs = rsl[ai * 128 + m * 16];
#pragma unroll
                for (int bj = 0; bj < 2; ++bj) { acc[ai][bj][m][0] = acc[ai][bj][m][0] * rs; acc[ai][bj][m][1] = acc[ai][bj][m][1] * rs; }
                float* so = nullptr;
                if (prompt) { const int t = r & (SEQ - 1); if (t >= SEQ - 2) so = out + O_CVP + (((size_t)layer * BATCH + (r >> 11)) * 2 + (t - (SEQ - 2))) * DFF2; }
                else { const int rr = r - MP, t = rr & (DECS - 1); if (t >= DECS - 2) so = out + O_CVS + (((size_t)layer * DECB + (rr >> 6)) * 2 + (t - (DECS - 2))) * DFF2; }
                if (so) {
#pragma unroll
                    for (int bj = 0; bj < 2; ++bj) { *(f32x4*)(so + bj * DFF + ch) = acc[ai][bj][m][0]; *(f32x4*)(so + bj * DFF + ch + 4) = acc[ai][bj][m][1]; } }
                if (m == 3 && fr >= 14) {
#pragma unroll
                    for (int bj = 0; bj < 2; ++bj) { LAS float* d = hl + ((((ai * 2 + wr) * 4 + wc) * 2 + (fr - 14)) * 4 + fq) * 16 + bj * 8; *(LAS f32x4*)d = acc[ai][bj][m][0]; *(LAS f32x4*)(d + 4) = acc[ai][bj][m][1]; } }
                if (prompt) { int sel = -1; if (ai == 0 && wr == 0 && m == 0 && fr < 2) sel = fr; if (ai == 1 && wr == 1 && m == 3 && fr >= 14) sel = fr - 12;
                    if (sel >= 0) {
#pragma unroll
                        for (int bj = 0; bj < 2; ++bj) { float* d = halo + (size_t)sel * DFF2 + bj * DFF + ch; *(f32x4*)d = acc[ai][bj][m][0]; *(f32x4*)(d + 4) = acc[ai][bj][m][1]; } } }
            }
        asm volatile("s_waitcnt lgkmcnt(0)" ::: "memory"); __builtin_amdgcn_s_barrier(); asm volatile("" ::: "memory");
#pragma unroll
        for (int ai = 0; ai < 2; ++ai) {
            const int blk0 = u.pm * 256 + ai * 128 + wr * 64;
#pragma unroll
            for (int eh = 0; eh < 2; ++eh) {
                f32x4 w[2][3], bia[2], hm1[2], hm2[2];
#pragma unroll
                for (int bj = 0; bj < 2; ++bj) {
                    const int cc = bj * DFF + ch + 4 * eh;
#pragma unroll
                    for (int j = 0; j < 3; ++j) w[bj][j] = *(const LAS f32x4*)(cwl + (2 * j + bj) * 128 + 4 * eh);
                    bia[bj] = *(const LAS f32x4*)(cwl + (6 + bj) * 128 + 4 * eh);
                    if (!prompt) { const float* ps = past + (size_t)((blk0 - MP) >> 6) * 2 * DFF2 + cc; hm2[bj] = *(const f32x4*)ps; hm1[bj] = *(const f32x4*)(ps + DFF2); }
                    else if (ai == 0 && wr == 0) { hm1[bj] = (f32x4){0.f, 0.f, 0.f, 0.f}; hm2[bj] = hm1[bj]; }
                    else { const int pb = ai * 2 + wr - 1; const LAS float* s = hl + (((pb * 4 + wc) * 2 + 0) * 4 + fq) * 16 + bj * 8 + 4 * eh; hm2[bj] = *(const LAS f32x4*)s; hm1[bj] = *(const LAS f32x4*)(s + 64); }
                }
                u32x2 pk[4]; f32x4 pr1[2], pr2[2];
#pragma unroll
                for (int bj = 0; bj < 2; ++bj)
#pragma unroll
                    for (int e = 0; e < 4; ++e) { pr1[bj][e] = hm1[bj][e]; pr2[bj][e] = (fr == 0) ? hm2[bj][e] : hm1[bj][e]; }
#pragma unroll
                for (int m = 0; m < 4; ++m) {
                    f32x4 c[2];
#pragma unroll
                    for (int bj = 0; bj < 2; ++bj) {
                        const f32x4 h0 = acc[ai][bj][m][eh]; f32x4 p1, p2;
#pragma unroll
                        for (int e = 0; e < 4; ++e) {
                            const float r1 = dpp_ror1(h0[e]), r2 = dpp_ror2(h0[e]);
                            p1[e] = (fr >= 1) ? r1 : pr1[bj][e]; p2[e] = (fr >= 2) ? r2 : pr2[bj][e];
                            pr1[bj][e] = r1; pr2[bj][e] = r2;
                        }
                        c[bj] = bia[bj] + w[bj][0] * p2 + w[bj][1] * p1 + w[bj][2] * h0;
                    }
                    f32x4 o;
#pragma unroll
                    for (int e = 0; e < 4; ++e) o[e] = silu_f(c[0][e]) * c[1][e];
                    pk[m].x = cvt_pk_bf16(o[0], o[1]); pk[m].y = cvt_pk_bf16(o[2], o[3]);
                }
#pragma unroll
                for (int m = 0; m < 4; ++m) *(u32x2*)(act + (size_t)(blk0 + 16 * m + fr) * DFF + ch + 4 * eh) = pk[m];
            }
        }
    }
};

struct EpiInC {
    static constexpr bool PERM = true, PRE = true;
    unsigned char* ws; int layer; LAS unsigned char* lds;
    __device__ __forceinline__ void pre(LAS unsigned char* l, const pg8::Unit& u, int wid) const {
        if (wid == 4) { const float* src = (const float*)(ws + WS_RSTD) + (size_t)(2 * layer) * MT + u.pm * 256 + lane_id() * 4;
            __builtin_amdgcn_global_load_lds((const unsigned*)src, (LAS unsigned*)(l + EPI_RS + u.par * 1024), 16, 0, 0); }
    }
    __device__ __forceinline__ void operator()(const f32x4 (&acc)[2][2][4][2], const pg8::Unit& u, int wr, int wc, int fr, int fq) const {
        EPI_ROWS(u); const LAS float* rsl = (const LAS float*)(lds + EPI_RS + u.par * 1024) + wr * 64 + fr; const int sec = u.pn >> 3, c0 = (u.pn & 7) * 256 + wc * 32 + 8 * fq;
        const float* lbs = (const float*)(ws + WS_LBS) + (layer >> 1) * 2048;
        f32x4 lb[2][2] = {};
        if (sec == 1) {
#pragma unroll
            for (int bj = 0; bj < 2; ++bj) { lb[bj][0] = *(const f32x4*)(lbs + c0 + bj * 128); lb[bj][1] = *(const f32x4*)(lbs + c0 + bj * 128 + 4); }
            asm volatile("" ::: "memory"); }
#pragma unroll
        for (int ai = 0; ai < 2; ++ai)
#pragma unroll
            for (int m = 0; m < 4; ++m) {
                const int r = EPI_ROW(ai, m); const float rs = rsl[ai * 128 + m * 16];
#pragma unroll
                for (int bj = 0; bj < 2; ++bj) { f32x4 a = acc[ai][bj][m][0] * rs, b = acc[ai][bj][m][1] * rs; const int c = c0 + bj * 128;
                    if (sec == 1) { const f32x4 l0 = lb[bj][0], l1 = lb[bj][1];
#pragma unroll
                        for (int e = 0; e < 4; ++e) { a[e] = (1.0f - l0[e]) * sigmoid_f(-a[e]); b[e] = (1.0f - l1[e]) * sigmoid_f(-b[e]); }
                        bf16_t* o = (bf16_t*)(ws + WS_FG) + (size_t)r * 2048 + c; *(u32x4*)o = pack8(a, b); }
                    else { if (sec != 2) {
#pragma unroll
                            for (int e = 0; e < 4; ++e) { a[e] = silu_f(a[e]); b[e] = silu_f(b[e]); } }
                        bf16_t* o = (bf16_t*)(ws + (sec == 0 ? WS_QSIL : sec == 2 ? WS_VB : WS_GS)) + (size_t)r * 2048 + c; *(u32x4*)o = pack8(a, b); }
                }
            }
    }
};

__device__ __forceinline__ void act_fix_phase(const Frame& F, KArgs* A_, int layer) {
    const int lane = lau_v(lane_id()); unsigned char* ws = lau_s(A_->ws);
    const int gw = lau_si(F.vcu * NWAVES + F.wave), NGW = F.G * NWAVES;
    const size_t gt = (size_t)gw * 64 + lane, NGT = (size_t)NGW * 64;
    const float* halo = (const float*)(ws + WS_HALO); bf16_t* act = (bf16_t*)(ws + WS_ACT);
    const float* cw = as_global(A_->in[I_CONVW]) + (size_t)layer * 3 * DFF2; const float* cbias = as_global(A_->in[I_CONVB]) + (size_t)layer * DFF2;
    constexpr int NT = MP / 256, CG = DFF / 4;
    for (size_t it = gt; it < (size_t)NT * 2 * CG; it += NGT) {
        const int pm = (int)(it / (2 * CG)), rem = (int)(it % (2 * CG)), i = rem / CG, col = (rem % CG) * 4;
        if ((pm & 7) == 0) continue;
        const float* H = halo + (size_t)pm * 4 * DFF2; const float* Hp = H - (size_t)4 * DFF2;
        const float* h0p = H + (size_t)i * DFF2; const float* h1p = i == 0 ? Hp + (size_t)3 * DFF2 : H; const float* h2p = i == 0 ? Hp + (size_t)2 * DFF2 : Hp + (size_t)3 * DFF2;
        f32x4 c[2];
#pragma unroll
        for (int s = 0; s < 2; ++s) { const int cc = s * DFF + col;
            c[s] = *(const f32x4*)(cbias + cc) + *(const f32x4*)(cw + cc) * *(const f32x4*)(h2p + cc) + *(const f32x4*)(cw + DFF2 + cc) * *(const f32x4*)(h1p + cc) + *(const f32x4*)(cw + 2 * DFF2 + cc) * *(const f32x4*)(h0p + cc); }
        u32x2 pk; pk.x = cvt_pk_bf16(silu_f(c[0][0]) * c[1][0], silu_f(c[0][1]) * c[1][1]); pk.y = cvt_pk_bf16(silu_f(c[0][2]) * c[1][2], silu_f(c[0][3]) * c[1][3]);
        *(u32x2*)(act + (size_t)(pm * 256 + i) * DFF + col) = pk;
    }
}

__device__ __forceinline__ void final_phase(const Frame& F, KArgs* A_) {
    const int lane = lau_v(lane_id()); unsigned char* ws = lau_s(A_->ws); float* out = lau_s(A_->out);
    const int gw = lau_si(F.vcu * NWAVES + F.wave), NGW = F.G * NWAVES;
    const float* rstd = (const float*)(ws + WS_RSTD) + 8 * MT; const bf16_t* XB = (const bf16_t*)(ws + WS_XB); const float* g = as_global(A_->in[I_GFINAL]);
    f32x4 gg[4][2];
#pragma unroll
    for (int j = 0; j < 4; ++j) { const int c = (64 * j + lane) * 8; gg[j][0] = *(const f32x4*)(g + c); gg[j][1] = *(const f32x4*)(g + c + 4); }
    for (int r0 = gw; r0 < MT; r0 += 3 * NGW) {
        u32x4 q[3][4]; float rs[3] = {};
#pragma unroll
        for (int k = 0; k < 3; ++k) { const int r = r0 + k * NGW; if (r < MT) { rs[k] = rstd[r];
#pragma unroll
            for (int j = 0; j < 4; ++j) q[k][j] = *(const u32x4*)(XB + (size_t)r * DM + (64 * j + lane) * 8); } }
        asm volatile("" ::: "memory");
#pragma unroll
        for (int k = 0; k < 3; ++k) { const int r = r0 + k * NGW; if (r < MT) {
#pragma unroll
            for (int j = 0; j < 4; ++j) { const int c = (64 * j + lane) * 8; const u32x4 w = q[k][j];
                const f32x4 a = (f32x4){bf_lo(w.x), bf_hi(w.x), bf_lo(w.y), bf_hi(w.y)} * rs[k] * gg[j][0], b = (f32x4){bf_lo(w.z), bf_hi(w.z), bf_lo(w.w), bf_hi(w.w)} * rs[k] * gg[j][1];
                *(f32x4*)(out + (size_t)r * DM + c) = a; *(f32x4*)(out + (size_t)r * DM + c + 4) = b; } } }
    }
}

__device__ __forceinline__ void rstd_phase(const Frame& F, KArgs* A_, int nidx) {
    const int lane = lau_v(lane_id()); unsigned char* ws = lau_s(A_->ws);
    const int gw = lau_si(F.vcu * NWAVES + F.wave), NGW = F.G * NWAVES;
    const float* part = (const float*)(ws + WS_SSQP) + (size_t)nidx * 32 * MT; float* rstd = (float*)(ws + WS_RSTD) + (size_t)nidx * MT;
    for (int r = gw * 64 + lane; r < MT; r += NGW * 64) { float s = 0.f;
#pragma unroll 8
        for (int k = 0; k < 32; ++k) s += part[(size_t)k * MT + r];
        rstd[r] = rsqrtf(s * (1.0f / DM) + EPS); }
}
constexpr float MLA_SCALE = 0.07216878364870322f;

template <bool SAMPLE>
__device__ __forceinline__ void naive_attn_phase(const Frame& F, KArgs* A_, int li) {
    constexpr int DQ = SAMPLE ? KVW : QKD, DV = SAMPLE ? KVR : VD, NKMAX = SAMPLE ? PAST + DECS : SEQ, EV = DV / 64;
    const int lane = lau_v(lane_id()); unsigned char* ws = lau_s(A_->ws);
    const int gw = lau_si(F.vcu * NWAVES + F.wave), NGW = F.G * NWAVES;
    LAS float* qf = (LAS float*)(F.lds + F.wave * ((DQ + NKMAX) * 4)); LAS float* sc = qf + DQ;
    const int nitems = (SAMPLE ? MS : MP) * HEADS;
    for (int it = gw; it < nitems; it += NGW) {
        const int r = it >> 3, h = it & 7;
        const bf16_t* qrow; int nk, b;
        if (SAMPLE) { qrow = (const bf16_t*)(ws + WS_QS) + ((size_t)r * HEADS + h) * KVW; nk = PAST + DECS; b = r >> 6; }
        else { qrow = (const bf16_t*)(ws + WS_QP) + ((size_t)r * HEADS + h) * QKD; const int t = r & (SEQ - 1); nk = ((t >> 6) + 1) * 64; b = r >> 11; }
        for (int d = lane; d < DQ; d += 64) qf[d] = __uint_as_float(((unsigned)qrow[d]) << 16);
        LDS_WAIT(); asm volatile("" ::: "memory");
        auto krow = [&](int k) -> const bf16_t* {
            if (SAMPLE) return k < PAST ? (const bf16_t*)(ws + WS_KVC) + (((size_t)li * DECB + b) * PAST + k) * KVW : (const bf16_t*)(ws + WS_KVN) + ((size_t)MP + (size_t)b * DECS + (k - PAST)) * KVW;
            return (const bf16_t*)(ws + WS_KP) + (((size_t)b * SEQ + k) * HEADS + h) * QKD; };
        float mx = -3.0e38f;
        for (int k = lane; k < nk; k += 64) {
            const bf16_t* kr = krow(k); float dot = 0.f;
#pragma unroll 4
            for (int c = 0; c < DQ / 8; ++c) { const u32x4 w = *(const u32x4*)(kr + c * 8); const f32x4 q0 = *(const LAS f32x4*)(qf + c * 8), q1 = *(const LAS f32x4*)(qf + c * 8 + 4);
                dot += bf_lo(w.x) * q0[0] + bf_hi(w.x) * q0[1] + bf_lo(w.y) * q0[2] + bf_hi(w.y) * q0[3] + bf_lo(w.z) * q1[0] + bf_hi(w.z) * q1[1] + bf_lo(w.w) * q1[2] + bf_hi(w.w) * q1[3]; }
            dot *= MLA_SCALE; sc[k] = dot; mx = fmaxf(mx, dot);
        }
#pragma unroll
        for (int o = 1; o < 64; o <<= 1) mx = fmaxf(mx, __shfl_xor(mx, o));
        float sum = 0.f;
        for (int k = lane; k < nk; k += 64) { const float p = __expf(sc[k] - mx); sc[k] = p; sum += p; }
        sum = wave_sum(sum);
        LDS_WAIT(); asm volatile("" ::: "memory");
        float o[EV];
#pragma unroll
        for (int e = 0; e < EV; ++e) o[e] = 0.f;
        for (int k = 0; k < nk; ++k) {
            const float p = sc[k];
            const bf16_t* vr = SAMPLE ? krow(k) : (const bf16_t*)(ws + WS_VP) + (((size_t)b * SEQ + k) * HEADS + h) * VD;
            if constexpr (!SAMPLE) { const unsigned w = *(const unsigned*)(vr + lane * 2); o[0] += p * bf_lo(w); o[1] += p * bf_hi(w); }
            else { const u32x4 w = *(const u32x4*)(vr + lane * 8); o[0] += p * bf_lo(w.x); o[1] += p * bf_hi(w.x); o[2] += p * bf_lo(w.y); o[3] += p * bf_hi(w.y);
                o[4] += p * bf_lo(w.z); o[5] += p * bf_hi(w.z); o[6] += p * bf_lo(w.w); o[7] += p * bf_hi(w.w); }
        }
        const float inv = 1.0f / sum;
        if constexpr (!SAMPLE) *(unsigned*)((bf16_t*)(ws + WS_YCAT) + (size_t)r * DM + h * VD + lane * 2) = cvt_pk_bf16(o[0] * inv, o[1] * inv);
        else { u32x4 w; w.x = cvt_pk_bf16(o[0] * inv, o[1] * inv); w.y = cvt_pk_bf16(o[2] * inv, o[3] * inv); w.z = cvt_pk_bf16(o[4] * inv, o[5] * inv); w.w = cvt_pk_bf16(o[6] * inv, o[7] * inv);
            *(u32x4*)((bf16_t*)(ws + WS_OLAT) + ((size_t)r * HEADS + h) * KVR + lane * 8) = w; }
        LDS_WAIT(); asm volatile("" ::: "memory");
    }
}

__device__ __forceinline__ void naive_gla_phase(const Frame& F, KArgs* A_, int li) {
    const int lane = lau_v(lane_id()), wave = F.wave, tid = wave * 64 + lane; unsigned char* ws = lau_s(A_->ws); float* out = lau_s(A_->out);
    LAS float* fL = (LAS float*)F.lds;
    LAS float* qL = fL + 16 * 128;
    LAS float* vL = qL + 16 * 128;
    LAS float* oL = vL + 16 * 128;
    const float* FG = (const float*)(ws + WS_FG); const bf16_t* QS = (const bf16_t*)(ws + WS_QSIL); const bf16_t* VB = (const bf16_t*)(ws + WS_VB); const bf16_t* GS = (const bf16_t*)(ws + WS_GS);
    bf16_t* yc = (bf16_t*)(ws + WS_YCAT); const float* gon = as_global(A_->in[I_GONORM]) + (size_t)li * HI;
    const int col = tid & 127, kg = tid >> 7;
    const int nitems = (BATCH + DECB) * CHD;
    for (int it = F.vcu; it < nitems; it += F.G) {
        const bool prompt = it < BATCH * CHD; const int sq = prompt ? it / CHD : (it - BATCH * CHD) / CHD, h = it % CHD;
        const int row0 = prompt ? sq * SEQ : MP + sq * DECS, L = prompt ? SEQ : DECS;
        float S[32];
        float* so = prompt ? out + O_HGP + ((((size_t)li * BATCH + sq) * CHD + h) * HF) * HI : out + O_HGS + ((((size_t)li * DECB + sq) * CHD + h) * HF) * HI;
        if (prompt) {
#pragma unroll
            for (int i = 0; i < 32; ++i) S[i] = 0.f; }
        else { const float* s0 = as_global(A_->in[I_SHGRN]) + ((((size_t)li * DECB + sq) * CHD + h) * HF) * HI;
#pragma unroll
            for (int i = 0; i < 32; ++i) S[i] = s0[(size_t)(kg * 32 + i) * HI + col]; }
        for (int c0 = 0; c0 < L; c0 += 16) {
            __syncthreads();
            for (int e = tid; e < 16 * 128; e += 512) { const int tt = e >> 7, k = e & 127; const size_t g = (size_t)(row0 + c0 + tt) * 2048 + h * 128 + k;
                fL[e] = FG[g]; qL[e] = __uint_as_float(((unsigned)QS[g]) << 16); vL[e] = __uint_as_float(((unsigned)VB[g]) << 16); }
            __syncthreads();
            for (int tt = 0; tt < 16; ++tt) {
                const float v = vL[tt * 128 + col]; float acc = 0.f;
#pragma unroll
                for (int i4 = 0; i4 < 8; ++i4) { const f32x4 f4 = *(const LAS f32x4*)(fL + tt * 128 + kg * 32 + i4 * 4), q4 = *(const LAS f32x4*)(qL + tt * 128 + kg * 32 + i4 * 4);
#pragma unroll
                    for (int e = 0; e < 4; ++e) { const float f = f4[e]; S[i4 * 4 + e] = fmaxf(f, 1e-30f) * S[i4 * 4 + e] + (1.0f - f) * v; acc += q4[e] * S[i4 * 4 + e]; } }
                oL[(tt * 4 + kg) * 128 + col] = acc;
            }
            __syncthreads();
            for (int tt = wave; tt < 16; tt += 8) {
                const int r = row0 + c0 + tt; float o0 = 0.f, o1 = 0.f;
#pragma unroll
                for (int g = 0; g < 4; ++g) { const f32x2 p = *(const LAS f32x2*)(oL + (tt * 4 + g) * 128 + lane * 2); o0 += p.x; o1 += p.y; }
                const float ms = wave_sum(o0 * o0 + o1 * o1) * (1.0f / HI), rs = rsqrtf(ms + EPS);
                const unsigned gw2 = *(const unsigned*)(GS + (size_t)r * 2048 + h * 128 + lane * 2); const f32x2 gn = *(const f32x2*)(gon + lane * 2);
                *(unsigned*)(yc + (size_t)r * DM + h * 128 + lane * 2) = cvt_pk_bf16(o0 * rs * gn.x * bf_lo(gw2), o1 * rs * gn.y * bf_hi(gw2));
            }
        }
#pragma unroll
        for (int i = 0; i < 32; ++i) so[(size_t)(kg * 32 + i) * HI + col] = S[i];
    }
}
namespace attnp {
constexpr int NW = 8, QBLK = 32, KVBLK = 64, DQK = QKD, DVV = VD, ND0 = DQK / 16;
constexpr int LDQ = HEADS * QKD, LDKK = HEADS * QKD, LDV = HEADS * VD, LDO = DM;
constexpr size_t SHM_V = KVBLK * DVV * 2, SHM_K = KVBLK * DQK * 2;
constexpr size_t SHM_ATTN = 2 * SHM_V + 2 * SHM_K + NW * 64 * 4;
constexpr float C_EXP = MLA_SCALE * 1.4426950408889634f;
constexpr float THR = 8.f;
#define AP_KSWZ(row, colB) ((row) * 384 + ((colB) ^ ((((row) >> 1) & 7) << 4)))
#define AP_SBAR() __builtin_amdgcn_sched_barrier(0)
__device__ __forceinline__ int crow(int r, int hi) { return (r & 3) + 8 * (r >> 2) + 4 * hi; }

__device__ __forceinline__ void partialSM(f32x16& p0, f32x16& p1, float& m_reg, float& mn, float& alpha) {
  float pmax = p0[0];
#pragma unroll
  for (int r = 1; r < 16; ++r) pmax = fmaxf(pmax, p0[r]);
#pragma unroll
  for (int r = 0; r < 16; ++r) pmax = fmaxf(pmax, p1[r]);
  { auto rr = __builtin_amdgcn_permlane32_swap(__float_as_uint(pmax), __float_as_uint(pmax), false, false);
    pmax = fmaxf(__uint_as_float(rr[0]), __uint_as_float(rr[1])); }
  if (__builtin_expect(__all(pmax - m_reg <= THR / MLA_SCALE), 1)) { mn = m_reg; alpha = 1.f; }
  else { mn = fmaxf(m_reg, pmax); alpha = __builtin_amdgcn_exp2f((m_reg - mn) * C_EXP); m_reg = mn; }
  const float mnC = -mn * C_EXP;
#pragma unroll
  for (int r = 0; r < 16; ++r) p0[r] = fmaf(p0[r], C_EXP, mnC);
#pragma unroll
  for (int r = 0; r < 16; ++r) p1[r] = fmaf(p1[r], C_EXP, mnC);
#pragma unroll
  for (int r = 0; r < 16; ++r) p0[r] = __builtin_amdgcn_exp2f(p0[r]);
}
__device__ __forceinline__ void finishSM(f32x16& p0, f32x16& p1, float alpha, float& l_reg, bf16x8& pa0, bf16x8& pa1, bf16x8& pa2, bf16x8& pa3) {
#pragma unroll
  for (int r = 0; r < 16; ++r) p1[r] = __builtin_amdgcn_exp2f(p1[r]);
  float ps = 0;
#pragma unroll
  for (int r = 0; r < 16; ++r) ps += p0[r];
#pragma unroll
  for (int r = 0; r < 16; ++r) ps += p1[r];
  { auto rr = __builtin_amdgcn_permlane32_swap(__float_as_uint(ps), __float_as_uint(ps), false, false);
    ps = __uint_as_float(rr[0]) + __uint_as_float(rr[1]); }
  l_reg = l_reg * alpha + ps;
#define AP_PK4(P, BASE, OUT) do { unsigned a0 = cvt_pk_bf16(P[BASE + 0], P[BASE + 1]), a1 = cvt_pk_bf16(P[BASE + 2], P[BASE + 3]);   \
    unsigned b0 = cvt_pk_bf16(P[BASE + 4], P[BASE + 5]), b1 = cvt_pk_bf16(P[BASE + 6], P[BASE + 7]);                              \
    auto r0 = __builtin_amdgcn_permlane32_swap(a0, b0, false, false); auto r1 = __builtin_amdgcn_permlane32_swap(a1, b1, false, false); \
    u32x4 w = {r0[0], r1[0], r0[1], r1[1]}; OUT = *reinterpret_cast<bf16x8*>(&w); } while (0)
  AP_PK4(p0, 0, pa0); AP_PK4(p0, 8, pa1); AP_PK4(p1, 0, pa2); AP_PK4(p1, 8, pa3);
#undef AP_PK4
}
__device__ __forceinline__ void qkt(f32x16& p0, f32x16& p1, const char* Ks, const bf16x8* qr, const int (&kb)[4]) {
  p0 = f32x16{}; p1 = f32x16{};
  bf16x8 kf[3][2];
#define QK_LD(set_, d_) do { kf[set_][0] = *reinterpret_cast<const bf16x8*>(Ks + kb[(d_) & 3] + ((d_) >> 2) * 128); kf[set_][1] = *reinterpret_cast<const bf16x8*>(Ks + kb[(d_) & 3] + ((d_) >> 2) * 128 + 32 * 384); } while (0)
  QK_LD(0, 0); QK_LD(1, 1);
#pragma unroll
  for (int d0 = 0; d0 < ND0; ++d0) {
    if (d0 + 2 < ND0) QK_LD((d0 + 2) % 3, d0 + 2);
    __builtin_amdgcn_sched_barrier(0);
    p0 = __builtin_amdgcn_mfma_f32_32x32x16_bf16(kf[d0 % 3][0], qr[d0], p0, 0, 0, 0);
    p1 = __builtin_amdgcn_mfma_f32_32x32x16_bf16(kf[d0 % 3][1], qr[d0], p1, 0, 0, 0);
    __builtin_amdgcn_sched_barrier(0); }
#undef QK_LD
}
__device__ __forceinline__ int v_st(int k, int c) { const int kk = (k & ~0xC) | ((k & 4) << 1) | ((k & 8) >> 1); return ((kk >> 3) * 4 + (c >> 5)) * 512 + ((kk & 7) * 32 + (c & 31)) * 2; }
__device__ __forceinline__ int v_rd_base(int lane) { return ((lane & 3) << 3) | (((lane >> 2) & 3) << 6) | (((lane >> 4) & 1) << 5) | (((lane >> 5) & 1) << 8); }
constexpr int v_rd_off(int d0, int ks, int half) { return d0 * 512 + ks * 4096 + half * 2048; }
template <int OFF> __device__ __forceinline__ s16x4 tr_read(int vb) {
  s16x4 r; asm volatile("ds_read_b64_tr_b16 %0, %1 offset:%2" : "=&v"(r) : "v"(vb), "i"(OFF) : "memory"); return r;
}
template <int D0> __device__ __forceinline__ void pv_one(f32x16& od, int vb, bf16x8 pa0, bf16x8 pa1, bf16x8 pa2, bf16x8 pa3) {
  const s16x4 l0 = tr_read<v_rd_off(D0, 0, 0)>(vb), h0 = tr_read<v_rd_off(D0, 0, 1)>(vb), l1 = tr_read<v_rd_off(D0, 1, 0)>(vb), h1 = tr_read<v_rd_off(D0, 1, 1)>(vb);
  const s16x4 l2 = tr_read<v_rd_off(D0, 2, 0)>(vb), h2 = tr_read<v_rd_off(D0, 2, 1)>(vb), l3 = tr_read<v_rd_off(D0, 3, 0)>(vb), h3 = tr_read<v_rd_off(D0, 3, 1)>(vb);
  asm volatile("s_waitcnt lgkmcnt(0)" ::: "memory"); AP_SBAR();
#define AP_PK(L, H) (bf16x8){L[0], L[1], L[2], L[3], H[0], H[1], H[2], H[3]}
  od = __builtin_amdgcn_mfma_f32_32x32x16_bf16(pa0, AP_PK(l0, h0), od, 0, 0, 0);
  od = __builtin_amdgcn_mfma_f32_32x32x16_bf16(pa1, AP_PK(l1, h1), od, 0, 0, 0);
  od = __builtin_amdgcn_mfma_f32_32x32x16_bf16(pa2, AP_PK(l2, h2), od, 0, 0, 0);
  od = __builtin_amdgcn_mfma_f32_32x32x16_bf16(pa3, AP_PK(l3, h3), od, 0, 0, 0);
#undef AP_PK
}
__device__ __forceinline__ void pv_d0(f32x16* o, int vb, bf16x8 pa0, bf16x8 pa1, bf16x8 pa2, bf16x8 pa3) {
  pv_one<0>(o[0], vb, pa0, pa1, pa2, pa3); pv_one<1>(o[1], vb, pa0, pa1, pa2, pa3); pv_one<2>(o[2], vb, pa0, pa1, pa2, pa3); pv_one<3>(o[3], vb, pa0, pa1, pa2, pa3);
}

__device__ __forceinline__ void unit(const bf16_t* __restrict__ Qb, const bf16_t* __restrict__ Kh, const bf16_t* __restrict__ Vh, bf16_t* __restrict__ Ob, int qt, char* lds, int wid, int lane) {
  const int tid = wid * 64 + lane, r32 = lane & 31, hi = lane >> 5;
  char* V_lds = lds; char* K_lds = lds + 2 * SHM_V;
  float* wsf = (float*)(lds + 2 * SHM_V + 2 * SHM_K) + wid * 64; float* li_l = wsf; float* al_l = wsf + 32;
  float m_reg = -1e30f, l_reg = 0; f32x16 o[4] = {}; bf16x8 qr[ND0];
  const bf16_t* Qw = Qb + (long)(wid * QBLK + r32) * LDQ + hi * 8;
#pragma unroll
  for (int d0 = 0; d0 < ND0; ++d0) qr[d0] = *reinterpret_cast<const bf16x8*>(Qw + d0 * 16);
  const int cq = 4 * qt + (wid >> 1);
  int kb[4];
#pragma unroll
  for (int q = 0; q < 4; ++q) kb[q] = r32 * 384 + ((q * 32 + hi * 16) ^ (((r32 >> 1) & 7) << 4));
  const int NT = 4 * qt + 4;
  const int sr = tid >> 4, sc = (tid & 15) * 8, vst0 = v_st(sr, sc), vst1 = v_st(32 + sr, sc);
  const unsigned vo0 = (unsigned)(sr * LDV + sc) * 2u, vo1 = (unsigned)((32 + sr) * LDV + sc) * 2u;
  unsigned ko[3]; int kst[3];
#pragma unroll
  for (int j = 0; j < 3; ++j) { const int c = tid + 512 * j, kr = c / 24, kc = c % 24; ko[j] = (unsigned)(kr * LDKK + kc * 8) * 2u; kst[j] = AP_KSWZ(kr, kc * 16); }
  const int vb0 = (int)(uintptr_t)V_lds + v_rd_base(lane);
  bf16x8 vs0, vs1, ks0, ks1, ks2;
#define AP_SLOAD(k0) do { const char* vt_ = (const char*)Vh + (size_t)(k0) * (LDV * 2); const char* kt_ = (const char*)Kh + (size_t)(k0) * (LDKK * 2); \
    vs0 = *reinterpret_cast<const bf16x8*>(vt_ + vo0); vs1 = *reinterpret_cast<const bf16x8*>(vt_ + vo1); \
    ks0 = *reinterpret_cast<const bf16x8*>(kt_ + ko[0]); ks1 = *reinterpret_cast<const bf16x8*>(kt_ + ko[1]); ks2 = *reinterpret_cast<const bf16x8*>(kt_ + ko[2]); } while (0)
#define AP_SWRITE(b) do { *(bf16x8*)(V_lds + (b) * SHM_V + vst0) = vs0; *(bf16x8*)(V_lds + (b) * SHM_V + vst1) = vs1; \
    *(bf16x8*)(K_lds + (b) * SHM_K + kst[0]) = ks0; *(bf16x8*)(K_lds + (b) * SHM_K + kst[1]) = ks1; *(bf16x8*)(K_lds + (b) * SHM_K + kst[2]) = ks2; } while (0)
#define AP_RESC(a) do { if (__any((a) < 1.f)) { if (hi == 0) al_l[r32] = (a); asm volatile("s_waitcnt lgkmcnt(0)" ::: "memory"); \
    _Pragma("unroll") for (int d = 0; d < 4; ++d) _Pragma("unroll") for (int r = 0; r < 16; ++r) o[d][r] *= al_l[crow(r, hi)]; } } while (0)
#define AP_MASK(pa, pb, j) do { if ((j) > cq) { _Pragma("unroll") for (int r = 0; r < 16; ++r) { pa[r] = -1e30f; pb[r] = -1e30f; } } } while (0)
  f32x16 p0, p1; float mn, al; bf16x8 pa0, pa1, pa2, pa3;
  AP_SLOAD(0); asm volatile("s_waitcnt vmcnt(0)" ::: "memory"); AP_SWRITE(0); __syncthreads();
#pragma unroll 1
  for (int j = 0; j < NT; ++j) {
    const int bsel = j & 1;
    if (j + 1 < NT) AP_SLOAD((j + 1) * KVBLK);
    AP_SBAR(); qkt(p0, p1, K_lds + bsel * SHM_K, qr, kb); AP_MASK(p0, p1, j);
    partialSM(p0, p1, m_reg, mn, al); AP_RESC(al);
    finishSM(p0, p1, al, l_reg, pa0, pa1, pa2, pa3); AP_SBAR();
    pv_d0(o, vb0 + bsel * (int)SHM_V, pa0, pa1, pa2, pa3);
    if (j + 1 < NT) { asm volatile("s_waitcnt vmcnt(0)" ::: "memory"); AP_SWRITE(bsel ^ 1); }
    __syncthreads();
  }
  if (hi == 0) li_l[r32] = l_reg; asm volatile("s_waitcnt lgkmcnt(0)" ::: "memory");
  float rli[16];
#pragma unroll
  for (int r = 0; r < 16; ++r) rli[r] = __builtin_amdgcn_rcpf(li_l[crow(r, hi)]);
  char* Ow = (char*)(Ob + (size_t)(wid * QBLK) * LDO); const int le = lau_v(lane), r32e = le & 31, hie = le >> 5;
#pragma unroll
  for (int r = 0; r < 16; ++r) { const unsigned oo = (unsigned)(crow(r, hie) * LDO + r32e) * 2u;
#pragma unroll
    for (int d0 = 0; d0 < 4; ++d0) *(bf16_t*)(Ow + oo + d0 * 64) = (bf16_t)(cvt_pk_bf16(o[d0][r] * rli[r], 0.f) & 0xffffu); }
#undef AP_SLOAD
#undef AP_SWRITE
#undef AP_RESC
#undef AP_MASK
}
}

__device__ __forceinline__ void attn_prompt_phase(const Frame& F, KArgs* A_, int first_wg) {
  const int lane = lau_v(lane_id()); unsigned char* ws = lau_s(A_->ws);
  const int w = F.vcu - first_wg; if (w < 0 || w >= 256) return;
  const int bh = w >> 2, p = w & 3, b = bh >> 3, h = bh & 7;
  const bf16_t* Qp = (const bf16_t*)(ws + WS_QP); const bf16_t* Kp = (const bf16_t*)(ws + WS_KP); const bf16_t* Vp = (const bf16_t*)(ws + WS_VP); bf16_t* Y = (bf16_t*)(ws + WS_YCAT);
  const bf16_t* Kh = Kp + ((size_t)b * SEQ * HEADS + h) * QKD; const bf16_t* Vh = Vp + ((size_t)b * SEQ * HEADS + h) * VD;
#pragma unroll 1
  for (int s = 0; s < 2; ++s) { const int qt = s == 0 ? 7 - p : p; const size_t row0 = (size_t)b * SEQ + (size_t)qt * 256;
    attnp::unit(Qp + (row0 * HEADS + h) * QKD, Kh, Vh, Y + row0 * DM + h * VD, qt, (char*)F.lds, F.wave, lane); }
}
namespace attns {
constexpr int QIMG = 0, KIMG = 65536, KPE = KIMG + 65536, SX = KIMG + 73728, SXLD = 272, WSCR = SX + 64 * SXLD, LDS_END = WSCR + 8 * 256;
static_assert(LDS_END <= RING_BYTES, "sample attention LDS");
constexpr float C_EXP = MLA_SCALE * 1.4426950408889634f, THR = 8.f;
__device__ __forceinline__ unsigned off_b(unsigned row, unsigned ch) { return 256u * row + 16u * (ch ^ (((row & 3) << 2) | ((row >> 2) & 3))); }
__device__ __forceinline__ int crow(int r, int hi) { return (r & 3) + 8 * (r >> 2) + 4 * hi; }
template <int OFF> __device__ __forceinline__ s16x4 tr_read(int vb) { s16x4 r; asm volatile("ds_read_b64_tr_b16 %0, %1 offset:%2" : "=&v"(r) : "v"(vb), "i"(OFF) : "memory"); return r; }

__device__ __forceinline__ void unit(const bf16_t* __restrict__ Qs_bh  , const float* __restrict__ Clat  , const float* __restrict__ Ckpe  , const bf16_t* __restrict__ Kn  ,
                                     const bf16_t* __restrict__ Wv  , bf16_t* __restrict__ Yb  , char* lds, int wid, int lane) {
  const int tid = wid * 64 + lane, qh = wid >> 2, cq = wid & 3, l15 = lane & 15, g4 = lane >> 4, r32 = lane & 31, hi = lane >> 5;
  float* wsf = (float*)(lds + WSCR) + wid * 64; float* li_l = wsf; float* al_l = wsf + 32;
#pragma unroll
  for (int j = 0; j < 8; ++j) { const int c = lau_v(tid) + 512 * j, q = c >> 6, ch = c & 63;
    *(bf16x8*)(lds + QIMG + (ch >> 4) * 16384 + off_b(q, ch & 15)) = *reinterpret_cast<const bf16x8*>(Qs_bh + (size_t)q * (HEADS * KVW) + ch * 8); }
  bf16x8 qpe[2][2];
#pragma unroll
  for (int sb = 0; sb < 2; ++sb)
#pragma unroll
    for (int s2 = 0; s2 < 2; ++s2) { const int lq = lau_v(lane); qpe[sb][s2] = *reinterpret_cast<const bf16x8*>(Qs_bh + (unsigned)((32 * qh + 16 * sb + (lq & 15)) * (HEADS * KVW) + KVR + 32 * s2 + 8 * (lq >> 4))); }
  int kb0, qb0, xsh, kpb[2];
  { const int ln2 = lau_v(lane), l15b = ln2 & 15, g4b = ln2 >> 4; const int krow_ = 16 * cq + l15b, qrow_ = 32 * qh + l15b, clo = 16 * (g4b ^ ((l15b >> 2) & 3));
    kb0 = KIMG + 256 * krow_ + clo; qb0 = QIMG + 256 * qrow_ + clo; xsh = (l15b & 3) << 6;
#pragma unroll
    for (int s = 0; s < 2; ++s) kpb[s] = KPE + krow_ * 128 + 16 * ((4 * s + g4b) ^ (krow_ & 7)); }
  int vb[2], q4s;
  { const int blk = (lane >> 4) & 1, q4 = (lane & 15) >> 2, p4 = lane & 3, c0 = 2 * blk + (p4 >> 1);
    q4s = q4 << 6;
#pragma unroll
    for (int t = 0; t < 2; ++t) vb[t] = (int)(uintptr_t)lds + KIMG + cq * 16384 + 256 * (8 * hi + 4 * t + q4) + 16 * (c0 ^ ((2 * hi + t) & 3)) + 8 * (p4 & 1); }
  const int sxw = SX + (32 * qh + l15) * SXLD + (16 * cq + 4 * g4) * 4;
  const int sxr = SX + (32 * qh + r32) * SXLD + (8 * hi) * 4;
  constexpr int NT = (PAST + DECS) / 64;
  constexpr int N1 = 4, N2 = 8 - N1;
  bf16x8 cv[9]; f32x4 r1a[N1], r1b[N1], r2a[N2 + 1], r2b[N2 + 1];
#define AS_CVL(A, B) ({ u32x4 w_; w_.x = cvt_pk_bf16(A[0], A[1]); w_.y = cvt_pk_bf16(A[2], A[3]); w_.z = cvt_pk_bf16(B[0], B[1]); w_.w = cvt_pk_bf16(B[2], B[3]); *reinterpret_cast<bf16x8*>(&w_); })
#define AS_CVP(A, B) ({ u32x4 w_; w_.x = cvt_pk_bf16(A[0], B[0]); w_.y = cvt_pk_bf16(A[1], B[1]); w_.z = cvt_pk_bf16(A[2], B[2]); w_.w = cvt_pk_bf16(A[3], B[3]); *reinterpret_cast<bf16x8*>(&w_); })
#define AS_BC(x) (*reinterpret_cast<const bf16x8*>(&(x)))
#define AS_LD1(j_) do { if ((j_) < PAST / 64) { const unsigned tl_ = (unsigned)lau_v(tid) * 32u; const char* tb_ = (const char*)(Clat + (size_t)(j_) * (64 * KVR)); \
      _Pragma("unroll") for (int i_ = 0; i_ < N1; ++i_) { r1a[i_] = *(const f32x4*)(tb_ + (tl_ + 16384u * i_)); r1b[i_] = *(const f32x4*)(tb_ + (tl_ + 16384u * i_ + 16u)); } } \
    else { const int t2_ = lau_v(tid); _Pragma("unroll") for (int i_ = 0; i_ < N1; ++i_) { const int c_ = t2_ + 512 * i_; r1a[i_] = *reinterpret_cast<const f32x4*>(Kn + (unsigned)((c_ >> 6) * KVW + (c_ & 63) * 8)); } } } while (0)
#define AS_CV1(j_) do { if ((j_) < PAST / 64) { _Pragma("unroll") for (int i_ = 0; i_ < N1; ++i_) cv[i_] = AS_CVL(r1a[i_], r1b[i_]); } \
    else { _Pragma("unroll") for (int i_ = 0; i_ < N1; ++i_) cv[i_] = AS_BC(r1a[i_]); } } while (0)
#define AS_LD2(j_) do { const int t2_ = lau_v(tid); if ((j_) < PAST / 64) { const char* tb_ = (const char*)(Clat + (size_t)(j_) * (64 * KVR)); const float* tp_ = Ckpe + (size_t)(j_) * (64 * ROPE) + (unsigned)((t2_ >> 3) * ROPE + (t2_ & 7) * 4); \
      _Pragma("unroll") for (int i_ = 0; i_ < N2; ++i_) { r2a[i_] = *(const f32x4*)(tb_ + ((unsigned)t2_ * 32u + 16384u * (N1 + i_))); r2b[i_] = *(const f32x4*)(tb_ + ((unsigned)t2_ * 32u + 16384u * (N1 + i_) + 16u)); } \
      r2a[N2] = *(const f32x4*)tp_; r2b[N2] = *(const f32x4*)(tp_ + 32); } \
    else { _Pragma("unroll") for (int i_ = 0; i_ < N2; ++i_) { const int c_ = t2_ + 512 * (N1 + i_); r2a[i_] = *reinterpret_cast<const f32x4*>(Kn + (unsigned)((c_ >> 6) * KVW + (c_ & 63) * 8)); } \
      r2a[N2] = *reinterpret_cast<const f32x4*>(Kn + (unsigned)((t2_ >> 3) * KVW + KVR + (t2_ & 7) * 8)); } } while (0)
#define AS_CV2(j_) do { if ((j_) < PAST / 64) { _Pragma("unroll") for (int i_ = 0; i_ < N2; ++i_) cv[N1 + i_] = AS_CVL(r2a[i_], r2b[i_]); cv[8] = AS_CVP(r2a[N2], r2b[N2]); } \
    else { _Pragma("unroll") for (int i_ = 0; i_ < N2; ++i_) cv[N1 + i_] = AS_BC(r2a[i_]); cv[8] = AS_BC(r2a[N2]); } } while (0)
  float m_reg = -1e30f, l_reg = 0.f; f32x16 o[4] = {};
  AS_LD1(0); AS_LD2(0); AS_CV1(0);
#pragma unroll 1
  for (int j = 0; j < NT; ++j) {
    AS_CV2(j);
    __syncthreads();
    { const int tl = lau_v(tid);
#pragma unroll
      for (int i = 0; i < 8; ++i) { const int c = tl + 512 * i, row = c >> 6, ch = c & 63; *(bf16x8*)(lds + KIMG + (ch >> 4) * 16384 + (int)off_b(row, ch & 15)) = cv[i]; }
      { const int row = tl >> 3, cp = tl & 7; *(bf16x8*)(lds + KPE + row * 128 + 16 * (cp ^ (row & 7))) = cv[8]; } }
    __syncthreads();
    if (j + 1 < NT) AS_LD1(j + 1);
    f32x4 sa[2] = {{0.f, 0.f, 0.f, 0.f}, {0.f, 0.f, 0.f, 0.f}};
    const int xsl = lau_v(xsh);
    bf16x8 fa[2][2], fb0[2][2], fb1[2][2], fp[2];
#define AS_SLD(set, g_) do { _Pragma("unroll") for (int i_ = 0; i_ < 2; ++i_) { const int s_ = 2 * (g_) + i_; const int xs_ = (64 * (s_ & 3)) ^ xsl; \
        fa[set][i_] = *(const bf16x8*)(lds + kb0 + xs_ + (s_ >> 2) * 16384); fb0[set][i_] = *(const bf16x8*)(lds + qb0 + xs_ + (s_ >> 2) * 16384); fb1[set][i_] = *(const bf16x8*)(lds + qb0 + xs_ + (s_ >> 2) * 16384 + 4096); } } while (0)
    AS_SLD(0, 0);
#pragma unroll
    for (int g = 0; g < 8; ++g) {
      if (g < 7) AS_SLD((g + 1) & 1, g + 1); else { fp[0] = *(const bf16x8*)(lds + kpb[0]); fp[1] = *(const bf16x8*)(lds + kpb[1]); }
      __builtin_amdgcn_sched_barrier(0);
#pragma unroll
      for (int i = 0; i < 2; ++i) {
        sa[0] = __builtin_amdgcn_mfma_f32_16x16x32_bf16(fa[g & 1][i], fb0[g & 1][i], sa[0], 0, 0, 0);
        sa[1] = __builtin_amdgcn_mfma_f32_16x16x32_bf16(fa[g & 1][i], fb1[g & 1][i], sa[1], 0, 0, 0); }
      __builtin_amdgcn_sched_barrier(0);
    }
#undef AS_SLD
#pragma unroll
    for (int s = 0; s < 2; ++s) {
      sa[0] = __builtin_amdgcn_mfma_f32_16x16x32_bf16(fp[s], qpe[0][s], sa[0], 0, 0, 0);
      sa[1] = __builtin_amdgcn_mfma_f32_16x16x32_bf16(fp[s], qpe[1][s], sa[1], 0, 0, 0); }
    *(f32x4*)(lds + sxw) = sa[0]; *(f32x4*)(lds + sxw + 16 * SXLD) = sa[1];
    __syncthreads();
    if (j + 1 < NT) { AS_CV1(j + 1); AS_LD2(j + 1); }
    float sv[4][8];
#pragma unroll
    for (int ks = 0; ks < 4; ++ks) { const f32x4 x = *(const f32x4*)(lds + sxr + ks * 64), y = *(const f32x4*)(lds + sxr + ks * 64 + 16);
      sv[ks][0] = x[0]; sv[ks][1] = x[1]; sv[ks][2] = x[2]; sv[ks][3] = x[3]; sv[ks][4] = y[0]; sv[ks][5] = y[1]; sv[ks][6] = y[2]; sv[ks][7] = y[3]; }
    float pmax = sv[0][0];
#pragma unroll
    for (int ks = 0; ks < 4; ++ks)
#pragma unroll
      for (int e = 0; e < 8; ++e) pmax = fmaxf(pmax, sv[ks][e]);
    { auto rr = __builtin_amdgcn_permlane32_swap(__float_as_uint(pmax), __float_as_uint(pmax), false, false); pmax = fmaxf(__uint_as_float(rr[0]), __uint_as_float(rr[1])); }
    float mn, alpha;
    if (__builtin_expect(__all(pmax - m_reg <= THR / MLA_SCALE), 1)) { mn = m_reg; alpha = 1.f; }
    else { mn = fmaxf(m_reg, pmax); alpha = __builtin_amdgcn_exp2f((m_reg - mn) * C_EXP); m_reg = mn; }
    const float mnC = -mn * C_EXP; float ps = 0.f;
#pragma unroll
    for (int ks = 0; ks < 4; ++ks)
#pragma unroll
      for (int e = 0; e < 8; ++e) { sv[ks][e] = __builtin_amdgcn_exp2f(fmaf(sv[ks][e], C_EXP, mnC)); ps += sv[ks][e]; }
    { auto rr = __builtin_amdgcn_permlane32_swap(__float_as_uint(ps), __float_as_uint(ps), false, false); ps = __uint_as_float(rr[0]) + __uint_as_float(rr[1]); }
    l_reg = l_reg * alpha + ps;
    if (__any(alpha < 1.f)) { if (hi == 0) al_l[r32] = alpha; asm volatile("s_waitcnt lgkmcnt(0)" ::: "memory");
#pragma unroll
      for (int d = 0; d < 4; ++d)
#pragma unroll
        for (int r = 0; r < 16; ++r) o[d][r] *= al_l[crow(r, hi)]; }
    bf16x8 pa[4];
#pragma unroll
    for (int ks = 0; ks < 4; ++ks) { u32x4 w; w.x = cvt_pk_bf16(sv[ks][0], sv[ks][1]); w.y = cvt_pk_bf16(sv[ks][2], sv[ks][3]); w.z = cvt_pk_bf16(sv[ks][4], sv[ks][5]); w.w = cvt_pk_bf16(sv[ks][6], sv[ks][7]); pa[ks] = *reinterpret_cast<bf16x8*>(&w); }
#pragma unroll
    for (int d0 = 0; d0 < 4; ++d0) {
      const int xd = (64 * d0) ^ lau_v(q4s), va0 = vb[0] + xd, va1 = vb[1] + xd;
      const s16x4 l0 = tr_read<0>(va0), h0 = tr_read<0>(va1), l1 = tr_read<4096>(va0), h1 = tr_read<4096>(va1);
      const s16x4 l2 = tr_read<8192>(va0), h2 = tr_read<8192>(va1), l3 = tr_read<12288>(va0), h3 = tr_read<12288>(va1);
      asm volatile("s_waitcnt lgkmcnt(0)" ::: "memory"); __builtin_amdgcn_sched_barrier(0);
#define AS_PK(L, H) (bf16x8){L[0], L[1], L[2], L[3], H[0], H[1], H[2], H[3]}
      o[d0] = __builtin_amdgcn_mfma_f32_32x32x16_bf16(pa[0], AS_PK(l0, h0), o[d0], 0, 0, 0);
      o[d0] = __builtin_amdgcn_mfma_f32_32x32x16_bf16(pa[1], AS_PK(l1, h1), o[d0], 0, 0, 0);
      o[d0] = __builtin_amdgcn_mfma_f32_32x32x16_bf16(pa[2], AS_PK(l2, h2), o[d0], 0, 0, 0);
      o[d0] = __builtin_amdgcn_mfma_f32_32x32x16_bf16(pa[3], AS_PK(l3, h3), o[d0], 0, 0, 0);
#undef AS_PK
    }
  }
  if (hi == 0) li_l[r32] = l_reg; asm volatile("s_waitcnt lgkmcnt(0)" ::: "memory");
  { const int le = lau_v(lane), r32e = le & 31, hie = le >> 5;
#pragma unroll
    for (int r = 0; r < 16; ++r) { const int q = 32 * qh + crow(r, hie); const float rl = __builtin_amdgcn_rcpf(li_l[crow(r, hie)]);
#pragma unroll
      for (int d0 = 0; d0 < 4; ++d0) { const int cc = 32 * d0 + r32e;
        *(bf16_t*)(lds + QIMG + cq * 16384 + off_b(q, cc >> 3) + (cc & 7) * 2) = (bf16_t)(cvt_pk_bf16(o[d0][r] * rl, 0.f) & 0xffffu); } } }
  __syncthreads();
  { f32x4 ya[4] = {{0.f, 0.f, 0.f, 0.f}, {0.f, 0.f, 0.f, 0.f}, {0.f, 0.f, 0.f, 0.f}, {0.f, 0.f, 0.f, 0.f}};
    const bf16_t* wrow = lau_vp(Wv + (size_t)(16 * wid + (lau_v(lane) & 15)) * KVR + 8 * (lau_v(lane) >> 4));
    int ob[4];
#pragma unroll
    for (int s = 0; s < 4; ++s) { const int le2 = lau_v(lane); ob[s] = QIMG + off_b(le2 & 15, 4 * s + (le2 >> 4)); }
#pragma unroll
    for (int s = 0; s < 16; ++s) { const bf16x8 b = *reinterpret_cast<const bf16x8*>(wrow + 32 * s);
#pragma unroll
      for (int qb2 = 0; qb2 < 4; ++qb2) { const bf16x8 a = *(const bf16x8*)(lds + ob[s & 3] + (s >> 2) * 16384 + qb2 * 4096); ya[qb2] = __builtin_amdgcn_mfma_f32_16x16x32_bf16(a, b, ya[qb2], 0, 0, 0); } }
    { const int l2 = lau_v(lane); const unsigned yo = (unsigned)((4 * (l2 >> 4)) * DM + 16 * wid + (l2 & 15)) * 2u;
#pragma unroll
      for (int qb2 = 0; qb2 < 4; ++qb2)
#pragma unroll
        for (int e = 0; e < 4; ++e) *(bf16_t*)((char*)Yb + yo + (unsigned)((16 * qb2 + e) * DM * 2)) = (bf16_t)(cvt_pk_bf16(ya[qb2][e], 0.f) & 0xffffu); } }
  __syncthreads();
#undef AS_LD1
#undef AS_LD2
#undef AS_CV1
#undef AS_CV2
#undef AS_CVL
#undef AS_BC
#undef AS_CVP
}
}

__device__ __forceinline__ void attn_sample_phase(const Frame& F, KArgs* A_, int li) {
  const int lane = lau_v(lane_id()); unsigned char* ws = lau_s(A_->ws);
  for (int it = F.vcu; it < DECB * HEADS; it += F.G) {
    const int b = it >> 3, h = it & 7;
    attns::unit((const bf16_t*)(ws + WS_QS) + ((size_t)b * DECS * HEADS + h) * KVW, as_global(A_->in[I_CLAT]) + ((size_t)li * DECB + b) * PAST * KVR, as_global(A_->in[I_CKPE]) + ((size_t)li * DECB + b) * PAST * ROPE,
                (const bf16_t*)(ws + WS_KVN) + ((size_t)MP + (size_t)b * DECS) * KVW, (const bf16_t*)(ws + WS_WKV) + ((size_t)li * 2048 + 1024 + h * VD) * KVR,
                (bf16_t*)(ws + WS_YCAT) + ((size_t)MP + (size_t)b * DECS) * DM + h * VD, (char*)F.lds, F.wave, lane);
  }
}
namespace gla {
constexpr int QT = 0, KT = 8192, KH = 16384, VT = 24576, EL = 32768, SSX = 33280, GB = 33792;
constexpr int GON = 2 * GB, QPO = GON + 512;
static_assert(QPO + 4096 <= RING_BYTES, "gla LDS");
__device__ __forceinline__ int crow(int r, int hi) { return (r & 3) + 8 * (r >> 2) + 4 * hi; }
template <int OFF> __device__ __forceinline__ s16x4 tr_read(int a) { s16x4 r; asm volatile("ds_read_b64_tr_b16 %0, %1 offset:%2" : "=&v"(r) : "v"(a), "i"(OFF) : "memory"); return r; }
#define GLA_PK(L, H) (bf16x8){L[0], L[1], L[2], L[3], H[0], H[1], H[2], H[3]}
__device__ __forceinline__ bf16x8 cvt8(const f32x16& x, int base) {
    u32x4 w; w.x = cvt_pk_bf16(x[base + 0], x[base + 1]); w.y = cvt_pk_bf16(x[base + 2], x[base + 3]); w.z = cvt_pk_bf16(x[base + 4], x[base + 5]); w.w = cvt_pk_bf16(x[base + 6], x[base + 7]); return *reinterpret_cast<bf16x8*>(&w); }

__device__ __forceinline__ void run(unsigned char* ws, const float* s0  , float* sout, const float* gon, int row0, int h, int nch, char* lds, int wave, int lane) {
    const bool scan = wave < 4; const int vq = wave & 3;
    const int r32 = lane & 31, hi = lane >> 5, th = vq >> 1; const unsigned kd = 64u * (vq & 1) + (unsigned)lane;
    const bf16_t* FGp = (const bf16_t*)(ws + WS_FG) + (size_t)row0 * 2048 + h * 128;
    const bf16_t* QSp = (const bf16_t*)(ws + WS_QSIL) + (size_t)row0 * 2048 + h * 128;
    const bf16_t* VBp = (const bf16_t*)(ws + WS_VB) + (size_t)row0 * 2048 + h * 128;
    const bf16_t* GSp = (const bf16_t*)(ws + WS_GS) + (size_t)row0 * 2048 + h * 128;
    bf16_t* YCp = (bf16_t*)(ws + WS_YCAT) + (size_t)row0 * DM + h * 128;
    char* gb = lds;
    const int trq = (lane & 15) >> 2, trf = (2 * hi + (trq >> 1)) & 3;
    const int trb = (int)(uintptr_t)gb + (4 * hi + trq) * 64 + (((2 * ((lane >> 4) & 1) + ((lane & 3) >> 1)) ^ trf) * 16) + 8 * (lane & 1);
    float* gonL = (float*)(lds + GON);
    const int tq = vq; const unsigned dp2 = 2u * (unsigned)lane;
#define GLA_LOAD(F2, QV, VV, c_) do { const size_t ro_ = (size_t)(32 * (c_) + 8 * tq) * 2048; \
    const bf16_t* f1_ = lau_s(FGp + ro_); const bf16_t* q1_ = lau_s(QSp + ro_); const bf16_t* v1_ = lau_s(VBp + ro_); const unsigned kl_ = (unsigned)lau_v((int)dp2); \
    _Pragma("unroll") for (int i_ = 0; i_ < 8; ++i_) { F2[i_] = *(const unsigned*)(f1_ + kl_ + 2048u * i_); QV[i_] = *(const unsigned*)(q1_ + kl_ + 2048u * i_); VV[i_] = *(const unsigned*)(v1_ + kl_ + 2048u * i_); } } while (0)
#define GLA_PROD(F2, n_) do { float p0_ = 1.f, p1_ = 1.f; \
    _Pragma("unroll") for (int i_ = 0; i_ < 8; ++i_) { p0_ *= fmaxf(1.0f - bf_lo(F2[i_]), 1e-30f); p1_ *= fmaxf(1.0f - bf_hi(F2[i_]), 1e-30f); } \
    *(f32x2*)(lds + QPO + ((((n_) & 1) * 4 + tq) * 128 + (int)dp2) * 4) = (f32x2){p0_, p1_}; } while (0)
#define GLA_PREP(F2, QV, VV, par_) do { char* ib_ = gb + (par_) * GB; \
    const f32x2 g0_ = *(const f32x2*)(lds + QPO + (((par_) * 4 + 0) * 128 + (int)dp2) * 4), g1_ = *(const f32x2*)(lds + QPO + (((par_) * 4 + 1) * 128 + (int)dp2) * 4); \
    const f32x2 g2_ = *(const f32x2*)(lds + QPO + (((par_) * 4 + 2) * 128 + (int)dp2) * 4), g3_ = *(const f32x2*)(lds + QPO + (((par_) * 4 + 3) * 128 + (int)dp2) * 4); \
    _Pragma("unroll") for (int d_ = 0; d_ < 2; ++d_) { \
        const float q0_ = d_ ? g0_.y : g0_.x, q1p_ = d_ ? g1_.y : g1_.x, q2_ = d_ ? g2_.y : g2_.x, q3_ = d_ ? g3_.y : g3_.x; \
        const float pre_ = (tq > 0 ? q0_ : 1.f) * (tq > 1 ? q1p_ : 1.f) * (tq > 2 ? q2_ : 1.f), post_ = (tq < 1 ? q1p_ : 1.f) * (tq < 2 ? q2_ : 1.f) * (tq < 3 ? q3_ : 1.f); \
        float E_ = pre_; float qt_[8], kt_[8], kh_[8], fv_[8], kv_[8]; \
        _Pragma("unroll") for (int i_ = 0; i_ < 8; ++i_) { kv_[i_] = d_ ? bf_hi(F2[i_]) : bf_lo(F2[i_]); fv_[i_] = 1.0f - kv_[i_]; E_ *= fmaxf(fv_[i_], 1e-30f); const float Ec_ = fmaxf(E_, 1e-30f); \
            qt_[i_] = __uint_as_float(d_ ? (QV[i_] & 0xffff0000u) : (QV[i_] << 16)) * Ec_; kt_[i_] = kv_[i_] * __builtin_amdgcn_rcpf(Ec_); } \
        float suf_ = post_; \
        _Pragma("unroll") for (int i_ = 7; i_ >= 0; --i_) { kh_[i_] = kv_[i_] * suf_; suf_ *= fmaxf(fv_[i_], 1e-30f); } \
        if (tq == 0) *(float*)(ib_ + EL + ((int)dp2 + d_) * 4) = E_ * post_; \
        u32x4 a_, b_, c_, dd_; \
        a_.x = cvt_pk_bf16(qt_[0], qt_[1]); a_.y = cvt_pk_bf16(qt_[2], qt_[3]); a_.z = cvt_pk_bf16(qt_[4], qt_[5]); a_.w = cvt_pk_bf16(qt_[6], qt_[7]); \
        b_.x = cvt_pk_bf16(kt_[0], kt_[1]); b_.y = cvt_pk_bf16(kt_[2], kt_[3]); b_.z = cvt_pk_bf16(kt_[4], kt_[5]); b_.w = cvt_pk_bf16(kt_[6], kt_[7]); \
        c_.x = cvt_pk_bf16(kh_[0], kh_[1]); c_.y = cvt_pk_bf16(kh_[2], kh_[3]); c_.z = cvt_pk_bf16(kh_[4], kh_[5]); c_.w = cvt_pk_bf16(kh_[6], kh_[7]); \
        if (d_) { dd_.x = (VV[0] >> 16) | (VV[1] & 0xffff0000u); dd_.y = (VV[2] >> 16) | (VV[3] & 0xffff0000u); dd_.z = (VV[4] >> 16) | (VV[5] & 0xffff0000u); dd_.w = (VV[6] >> 16) | (VV[7] & 0xffff0000u); } \
        else { dd_.x = (VV[0] & 0xffffu) | (VV[1] << 16); dd_.y = (VV[2] & 0xffffu) | (VV[3] << 16); dd_.z = (VV[4] & 0xffffu) | (VV[5] << 16); dd_.w = (VV[6] & 0xffffu) | (VV[7] << 16); } \
        const int o_ = ((int)dp2 + d_) * 64 + ((tq ^ (lane & 3)) * 16);   \
        *(u32x4*)(ib_ + QT + o_) = a_; *(u32x4*)(ib_ + KT + o_) = b_; *(u32x4*)(ib_ + KH + o_) = c_; *(u32x4*)(ib_ + VT + o_) = dd_; } } while (0)
    f32x16 S[4]; f32x16 o = {}; u32x2 gsv[4] = {}; f32x4 gnr[4] = {};
#define GLA_FINAL(c_, par_) do { const float* sx_ = (const float*)(gb + (par_) * GB + SSX); \
    const float tot_ = (sx_[r32] + sx_[32 + r32]) + (sx_[64 + r32] + sx_[96 + r32]); const float rs_ = rsqrtf(tot_ * (1.0f / HI) + EPS); \
    const size_t ro_ = (size_t)(32 * (c_) + r32) * 2048; \
    _Pragma("unroll") for (int g_ = 0; g_ < 4; ++g_) { const int v0_ = 32 * vq + 8 * g_ + 4 * hi; const f32x4 gn_ = gnr[g_]; const u32x2 gw_ = gsv[g_]; \
        u32x2 w_; w_.x = cvt_pk_bf16(o[4 * g_ + 0] * rs_ * gn_[0] * bf_lo(gw_.x), o[4 * g_ + 1] * rs_ * gn_[1] * bf_hi(gw_.x)); w_.y = cvt_pk_bf16(o[4 * g_ + 2] * rs_ * gn_[2] * bf_lo(gw_.y), o[4 * g_ + 3] * rs_ * gn_[3] * bf_hi(gw_.y)); \
        *(u32x2*)(YCp + ro_ + v0_) = w_; } } while (0)
#define GLA_GSLOAD(c_) do { const size_t ro_ = (size_t)(32 * (c_) + r32) * 2048; _Pragma("unroll") for (int g_ = 0; g_ < 4; ++g_) gsv[g_] = *(const u32x2*)(GSp + ro_ + 32 * vq + 8 * g_ + 4 * hi); } while (0)
#define GLA_FR2(kt_) do { const s16x4 ql_ = tr_read<QT + (32 * kt_) * 64>(ia), qh_ = tr_read<QT + (32 * kt_ + 8) * 64>(ia), kl_ = tr_read<KT + (32 * kt_) * 64>(ia), kh2_ = tr_read<KT + (32 * kt_ + 8) * 64>(ia); \
        const s16x4 ql3_ = tr_read<QT + (32 * kt_ + 16) * 64>(ia), qh3_ = tr_read<QT + (32 * kt_ + 24) * 64>(ia), kl3_ = tr_read<KT + (32 * kt_ + 16) * 64>(ia), kh3_ = tr_read<KT + (32 * kt_ + 24) * 64>(ia); \
        asm volatile("s_waitcnt lgkmcnt(0)" ::: "memory"); __builtin_amdgcn_sched_barrier(0); \
        qf[kt_][0] = GLA_PK(ql_, qh_); qf[kt_][1] = GLA_PK(ql3_, qh3_); \
        P = __builtin_amdgcn_mfma_f32_32x32x16_bf16(GLA_PK(kl_, kh2_), qf[kt_][0], P, 0, 0, 0); P1 = __builtin_amdgcn_mfma_f32_32x32x16_bf16(GLA_PK(kl3_, kh3_), qf[kt_][1], P1, 0, 0, 0); } while (0)
#define GLA_SCAN(par_) do { const int ia = trb + (par_) * GB; const char* ib = gb + (par_) * GB; \
        bf16x8 qf[4][2]; f32x16 P = {}, P1 = {}; \
        GLA_FR2(0); GLA_FR2(1); GLA_FR2(2); GLA_FR2(3); \
        P = P + P1; \
        _Pragma("unroll") for (int r = 0; r < 16; ++r) P[r] = (crow(r, hi) <= r32) ? P[r] : 0.f; \
        o = f32x16{}; \
        _Pragma("unroll") for (int kt = 0; kt < 4; ++kt) _Pragma("unroll") for (int s2 = 0; s2 < 2; ++s2) o = __builtin_amdgcn_mfma_f32_32x32x16_bf16(cvt8(S[kt], 8 * s2), qf[kt][s2], o, 0, 0, 0); \
        const char* vrow = ib + VT + (32 * vq + r32) * 64; const int fr_ = (r32 >> 1) & 3; \
        { s16x4 vlo_[2], vhh_[2]; \
          _Pragma("unroll") for (int ks = 0; ks < 2; ++ks) { vlo_[ks] = *(const s16x4*)(vrow + (((2 * ks) ^ fr_) * 16) + 8 * hi); vhh_[ks] = *(const s16x4*)(vrow + (((2 * ks + 1) ^ fr_) * 16) + 8 * hi); } \
          __builtin_amdgcn_sched_barrier(0); \
          _Pragma("unroll") for (int ks = 0; ks < 2; ++ks) o = __builtin_amdgcn_mfma_f32_32x32x16_bf16(GLA_PK(vlo_[ks], vhh_[ks]), cvt8(P, 8 * ks), o, 0, 0, 0); } \
        { float ss = 0.f; \
          _Pragma("unroll") for (int r = 0; r < 16; ++r) ss += o[r] * o[r]; \
          auto rr = __builtin_amdgcn_permlane32_swap(__float_as_uint(ss), __float_as_uint(ss), false, false); ss = __uint_as_float(rr[0]) + __uint_as_float(rr[1]); \
          if (hi == 0) *(float*)(gb + (par_) * GB + SSX + (vq * 32 + r32) * 4) = ss; } \
          \
        { bf16x8 ka_[4][2], vb_[2]; f32x4 el_[4][4]; \
          _Pragma("unroll") for (int ks = 0; ks < 2; ++ks) vb_[ks] = *(const bf16x8*)(vrow + (((2 * ks + hi) ^ fr_) * 16)); \
          _Pragma("unroll") for (int kt = 0; kt < 4; ++kt) { \
            _Pragma("unroll") for (int ks = 0; ks < 2; ++ks) ka_[kt][ks] = *(const bf16x8*)(ib + KH + (32 * kt + r32) * 64 + (((2 * ks + hi) ^ fr_) * 16)); \
            _Pragma("unroll") for (int g = 0; g < 4; ++g) el_[kt][g] = *(const f32x4*)(ib + EL + (32 * kt + 8 * g + 4 * hi) * 4); } \
          __builtin_amdgcn_sched_barrier(0); \
          _Pragma("unroll") for (int kt = 0; kt < 4; ++kt) { \
            _Pragma("unroll") for (int g = 0; g < 4; ++g) { S[kt][4 * g + 0] *= el_[kt][g][0]; S[kt][4 * g + 1] *= el_[kt][g][1]; S[kt][4 * g + 2] *= el_[kt][g][2]; S[kt][4 * g + 3] *= el_[kt][g][3]; } \
            _Pragma("unroll") for (int ks = 0; ks < 2; ++ks) S[kt] = __builtin_amdgcn_mfma_f32_32x32x16_bf16(ka_[kt][ks], vb_[ks], S[kt], 0, 0, 0); } } } while (0)
#define GLA_BAR() do { asm volatile("s_waitcnt lgkmcnt(0)" ::: "memory"); __builtin_amdgcn_s_barrier(); asm volatile("" ::: "memory"); } while (0)
    if (scan) {
        if (s0) { const unsigned sl = (unsigned)((4 * hi) * HI + 32 * vq + r32) * 4u;
#pragma unroll
            for (int kt = 0; kt < 4; ++kt)
#pragma unroll
                for (int r = 0; r < 16; ++r) S[kt][r] = *(const float*)((const char*)s0 + sl + (unsigned)((32 * kt + (r & 3) + 8 * (r >> 2)) * HI * 4));
        } else {
#pragma unroll
            for (int kt = 0; kt < 4; ++kt) S[kt] = f32x16{};
        }
        GLA_BAR();
#pragma unroll
        for (int g = 0; g < 4; ++g) gnr[g] = *(const f32x4*)(gonL + 32 * vq + 8 * g + 4 * hi);
#pragma unroll 1
        for (int c = 0; c < nch; ++c) {
            const int par = c & 1;
            GLA_BAR();
            if (c > 0) GLA_FINAL(c - 1, par ^ 1);
            GLA_GSLOAD(c);
            GLA_SCAN(par);
        }
        GLA_BAR();
        GLA_FINAL(nch - 1, (nch - 1) & 1);
        const int le = lau_v(lane); const unsigned sl = (unsigned)((4 * (le >> 5)) * HI + 32 * vq + (le & 31)) * 4u;
#pragma unroll
        for (int kt = 0; kt < 4; ++kt)
#pragma unroll
            for (int r = 0; r < 16; ++r) *(float*)((char*)sout + sl + (unsigned)((32 * kt + (r & 3) + 8 * (r >> 2)) * HI * 4)) = S[kt][r];
    } else {
        unsigned fA[8], fB[8]; unsigned qvA[8], vvA[8], qvB[8], vvB[8];
        if (tq < 2) { const int lg = lau_v(lane); gonL[64 * tq + lg] = lau_s(gon)[64 * tq + lg]; }
        GLA_LOAD(fA, qvA, vvA, 0); if (nch > 1) GLA_LOAD(fB, qvB, vvB, 1);
        GLA_PROD(fA, 0); if (nch > 1) GLA_PROD(fB, 1);
        GLA_BAR();
        GLA_PREP(fA, qvA, vvA, 0); if (nch > 2) GLA_LOAD(fA, qvA, vvA, 2);
#pragma unroll 1
        for (int j = 0; j < nch; j += 2) {
            GLA_BAR();
            if (j + 1 < nch) GLA_PREP(fB, qvB, vvB, 1);
            if (j + 3 < nch) GLA_LOAD(fB, qvB, vvB, j + 3);
            if (j + 2 < nch) GLA_PROD(fA, j + 2);
            if (j + 1 < nch) {
                GLA_BAR();
                if (j + 2 < nch) GLA_PREP(fA, qvA, vvA, 0);
                if (j + 4 < nch) GLA_LOAD(fA, qvA, vvA, j + 4);
                if (j + 3 < nch) GLA_PROD(fB, j + 3);
            }
        }
        GLA_BAR();
    }
    __syncthreads();
#undef GLA_BAR
#undef GLA_LOAD
#undef GLA_PREP
#undef GLA_PROD
#undef GLA_FINAL
#undef GLA_GSLOAD
#undef GLA_SCAN
#undef GLA_FR2
}
#undef GLA_PK
}

__device__ __forceinline__ void gla_phase(const Frame& F, KArgs* A_, int li) {
    const int lane = lau_v(lane_id()); unsigned char* ws = lau_s(A_->ws); float* out = lau_s(A_->out);
    const float* gon = as_global(A_->in[I_GONORM]) + (size_t)li * HI;
    const int bx = (int)blockIdx.x, G = F.G, nit = BATCH * CHD + DECB * CHD;
    for (int k = 0;; ++k) {
        int item;
        if (G == 256) { if (bx < 128) { if (k > 0) break; item = bx; } else { if (k >= 4) break; item = 128 + (bx - 128) + 128 * k; } }
        else { item = bx + k * G; if (item >= nit) break; }
        const bool prompt = item < BATCH * CHD; const int it2 = prompt ? item : item - BATCH * CHD, sq = it2 >> 4, h = it2 & 15;
        if (prompt) gla::run(ws, nullptr, out + O_HGP + ((((size_t)li * BATCH + sq) * CHD + h) * HF) * HI, gon, sq * SEQ, h, SEQ / 32, (char*)F.lds, F.wave, lane);
        else gla::run(ws, as_global(A_->in[I_SHGRN]) + ((((size_t)li * DECB + sq) * CHD + h) * HF) * HI, out + O_HGS + ((((size_t)li * DECB + sq) * CHD + h) * HF) * HI, gon, MP + sq * DECS, h, DECS / 32, (char*)F.lds, F.wave, lane);
    }
}
__global__ void __launch_bounds__(NWAVES * 64, 2) mk_fwd(Args args) {
    extern __shared__ __attribute__((aligned(16))) unsigned char lds[];
    Frame F;
    F.lds = (LAS unsigned char*)lds;
    F.MISC = (volatile LAS unsigned*)(F.lds + MISC_OFF);
    F.wave = __builtin_amdgcn_readfirstlane((int)threadIdx.x >> 6);
    F.G = gridDim.x; { const int bx = blockIdx.x; F.vcu = (F.G % 8 == 0) ? (bx % 8) * (F.G / 8) + bx / 8 : bx; }
    F.ctl = (unsigned*)(args.ws + WS_CTL); F.ctlf = (float*)(args.ws + WS_CTL);
    if (threadIdx.x < 64) ((LAS unsigned*)(F.lds + MISC_OFF))[threadIdx.x] = 0u;
    __syncthreads();
    XcdBarrier bar = xcd_barrier_post(F.ctl + CW_BAR, F.MISC + 8);
#define RUN() (true)
#define SEAM() xcd_barrier(bar)

    if (RUN()) p0_prologue(F, kargs());
    SEAM();

    for (int layer = 0; layer < DEPTH; ++layer) {
        asm volatile("" : "+s"(F.lds), "+s"(F.MISC), "+s"(F.ctl), "+s"(F.ctlf), "+s"(F.wave), "+s"(F.vcu), "+s"(F.G), "+s"(bar.bar), "+s"(bar.x), "+s"(bar.st));
        const int bx = lau_si((int)blockIdx.x);
        const int li = layer >> 1;
        if ((layer & 1) == 0) {
            if (RUN()) {
                unsigned char* ws = lau_s(kargs()->ws);
                pg8::Gemm g{(const bf16_t*)(ws + WS_XB), (const bf16_t*)(ws + WS_WINA) + (size_t)li * INA_PAD * DM, DM, DM, DM};
                pg8::StaticOrder S; S.init(MT / 256, INA_PAD / 256, F.G, bx, DM, DM);
                EpiInA E{ws, as_global(kargs()->out), li, F.lds};
                pg8::gemm_phase<EpiInA, pg8::StaticOrder>(F.lds, g, S, E, F.wave);
                { const unsigned job = layer == 0 ? CJ_INA0 : CJ_INA2;
                    if (F.G == 256) { if (bx >= 136) conv_run(F, kargs(), job, (bx - 136) * NWAVES + F.wave, 120 * NWAVES); }
                    else conv_run(F, kargs(), job, bx * NWAVES + F.wave, F.G * NWAVES); }
            }
            SEAM();
            if (RUN()) {
                post_a_phase(F, kargs(), li); pool_prep_phase(F, kargs(), li);
                __syncthreads();
                unsigned char* ws = lau_s(kargs()->ws);
                pg8::Gemm g{(const bf16_t*)(ws + WS_CQB), (const bf16_t*)(ws + WS_WQB) + (size_t)li * 1536 * QR, QR, QR, QR};
                pg8::StaticOrder S; S.init(MT / 256, 1536 / 256, F.G, bx, QR, QR);
                EpiQ E{ws, li, F.lds};
                pg8::gemm_phase<EpiQ, pg8::StaticOrder>(F.lds, g, S, E, F.wave);
            }
            SEAM();
            if (RUN()) {
                unsigned char* ws = lau_s(kargs()->ws);
                { pg8::Gemm g{(const bf16_t*)(ws + WS_KVN), (const bf16_t*)(ws + WS_WKV) + (size_t)li * 2048 * KVR, KVW, KVR, KVR};
                  pg8::StaticOrder S; S.init(MP / 256, 2048 / 256, F.G, bx, KVW, KVR);
                  EpiStore<0> E{ws}; pg8::gemm_phase<EpiStore<0>, pg8::StaticOrder>(F.lds, g, S, E, F.wave); }
                { pg8::Gemm g{(const bf16_t*)(ws + WS_QNS), (const bf16_t*)(ws + WS_WUKBD) + (size_t)li * 4096 * 128, 1024, 128, 128};
                  pg8::HeadOrder S; S.init(MS / 256, 4096 / 256, F.G, (bx + 128) % F.G, 1024, 128, 128);
                  EpiStore<1> E{ws}; pg8::gemm_phase<EpiStore<1>, pg8::HeadOrder>(F.lds, g, S, E, F.wave); }
                { pg8::Gemm g{(const bf16_t*)(ws + WS_PB), (const bf16_t*)(ws + WS_WPOOL) + (size_t)li * 1024 * 256, POOLW, 256, 256};
                  pg8::GroupOrder S; S.init(MT / 256, 4, F.G, bx, POOLW, 256, 256);
                  EpiStore<2> E{ws}; pg8::gemm_phase<EpiStore<2>, pg8::GroupOrder>(F.lds, g, S, E, F.wave); }
            }
            SEAM();
            if (RUN()) { attn_sample_phase(F, kargs(), li); __syncthreads(); attn_prompt_phase(F, kargs(), 0); }
            SEAM();
        } else {
            if (RUN()) {
                unsigned char* ws = lau_s(kargs()->ws);
                pg8::Gemm g{(const bf16_t*)(ws + WS_XB), (const bf16_t*)(ws + WS_WINC) + (size_t)li * INC * DM, DM, DM, DM};
                pg8::StaticOrder S; S.init(MT / 256, INC / 256, F.G, bx, DM, DM);
                EpiInC E{ws, layer, F.lds}; pg8::gemm_phase<EpiInC, pg8::StaticOrder>(F.lds, g, S, E, F.wave);
            }
            SEAM();
            if (RUN()) { gla_phase(F, kargs(), li);
                { const unsigned job = layer == 1 ? CJ_GLA1 : CJ_GLA3;
                    if (F.G == 256) { if ((int)blockIdx.x >= 128) conv_run(F, kargs(), job, ((int)blockIdx.x - 128) * NWAVES + F.wave, 128 * NWAVES); }
                    else conv_run(F, kargs(), job, (int)blockIdx.x * NWAVES + F.wave, F.G * NWAVES); } }
            SEAM();
        }
        if (RUN()) {
            unsigned char* ws = lau_s(kargs()->ws);
            const bf16_t* W = (layer & 1) ? (const bf16_t*)(ws + WS_WOUTC) + (size_t)li * DM * DM : (const bf16_t*)(ws + WS_WOUTA) + (size_t)li * DM * DM;
            pg8::Gemm g{(const bf16_t*)(ws + WS_YCAT), W, DM, DM, DM};
            pg8::StaticOrder S; S.init(MT / 192, DM / 256, F.G, bx, DM, DM, 192);
            EpiRes<3> E{ws, as_global(kargs()->in[I_XP]), as_global(kargs()->in[I_XS]), layer == 0 ? 1 : 0, 2 * layer + 1}; pg8::gemm_phase<EpiRes<3>, pg8::StaticOrder, true, true, 3>(F.lds, g, S, E, F.wave);
        }
        SEAM();
        if (RUN()) rstd_phase(F, kargs(), 2 * layer + 1);
        SEAM();
        if (RUN()) {
            unsigned char* ws = lau_s(kargs()->ws);
            pg8::Gemm g{(const bf16_t*)(ws + WS_XB), (const bf16_t*)(ws + WS_WUP) + (size_t)layer * DFF2 * DM, DM, DM, DM};
            pg8::StaticOrder S; S.init(MT / 256, DFF2 / 256, F.G, bx, DM, DM);
            EpiUp E{ws, as_global(kargs()->out), as_global(kargs()->in[I_CONVW]) + (size_t)layer * 3 * DFF2, as_global(kargs()->in[I_CONVB]) + (size_t)layer * DFF2, as_global(kargs()->in[I_SCONV]) + (size_t)layer * DECB * 2 * DFF2, F.lds, layer}; pg8::gemm_phase<EpiUp, pg8::StaticOrder>(F.lds, g, S, E, F.wave);
            if (layer < 3) { const unsigned job = layer == 0 ? CJ_UP0 : layer == 1 ? CJ_UP1 : CJ_UP2;
                if (F.G == 256) { if (bx >= 96) conv_run(F, kargs(), job, (bx - 96) * NWAVES + F.wave, 160 * NWAVES); }
                else conv_run(F, kargs(), job, bx * NWAVES + F.wave, F.G * NWAVES); }
        }
        SEAM();
        if (RUN()) act_fix_phase(F, kargs(), layer);
        SEAM();
        if (RUN()) {
            unsigned char* ws = lau_s(kargs()->ws);
            pg8::Gemm g{(const bf16_t*)(ws + WS_ACT), (const bf16_t*)(ws + WS_WDOWN) + (size_t)layer * DM * DFF, DFF, DFF, DFF};
            pg8::StaticOrder S; S.init(MT / 192, DM / 256, F.G, bx, DFF, DFF, 192);
            EpiRes<3> E{ws, as_global(kargs()->in[I_XP]), as_global(kargs()->in[I_XS]), 0, 2 * layer + 2}; pg8::gemm_phase<EpiRes<3>, pg8::StaticOrder, true, true, 3>(F.lds, g, S, E, F.wave);
        }
        SEAM();
        if (RUN()) rstd_phase(F, kargs(), 2 * layer + 2);
        SEAM();
    }
    if (RUN()) final_phase(F, kargs());
#undef RUN
#undef SEAM
}

extern "C" void kernel_launch(void* const* d_in, const int* in_sizes, int n_in, void* d_out, int out_size, void* d_ws, size_t ws_size, hipStream_t stream) {
    static int grid = 0;
    if (grid == 0) {
        if (n_in != N_IN || (size_t)out_size != O_END || ws_size < WS_END) { fprintf(stderr, "kernel_launch: shape mismatch (n_in %d out %d ws %zu, need %d %zu %zu)\n", n_in, out_size, ws_size, (int)N_IN, (size_t)O_END, (size_t)WS_END); grid = -1; return; }
        int dev = 0, cus = 0, per_cu = 0;
        if (hipGetDevice(&dev) != hipSuccess || hipDeviceGetAttribute(&cus, hipDeviceAttributeMultiprocessorCount, dev) != hipSuccess) { grid = -1; return; }
        if (hipFuncSetAttribute((const void*)mk_fwd, hipFuncAttributeMaxDynamicSharedMemorySize, LDS_BYTES) != hipSuccess) { fprintf(stderr, "kernel_launch: hipFuncSetAttribute failed\n"); grid = -1; return; }
        if (hipOccupancyMaxActiveBlocksPerMultiprocessor(&per_cu, (const void*)mk_fwd, NWAVES * 64, LDS_BYTES) != hipSuccess || per_cu < 1) { fprintf(stderr, "kernel_launch: occupancy query reports %d\n", per_cu); }
        (void)hipGetLastError();
        grid = cus;
    }
    if (grid < 0) return;
    (void)hipMemsetAsync((char*)d_ws + WS_CTL, 0, CTL_BYTES, stream);
    Args a{};
    for (int i = 0; i < N_IN; ++i) a.in[i] = (const float*)d_in[i];
    a.out = (float*)d_out; a.ws = (unsigned char*)d_ws; a.ph_lo = 0; a.ph_hi = 1000;
    hipLaunchKernelGGL(mk_fwd, dim3(grid), dim3(NWAVES * 64), LDS_BYTES, stream, a);
    const hipError_t le = hipPeekAtLastError();
    if (le != hipSuccess) fprintf(stderr, "kernel_launch: launch failed: %s\n", hipGetErrorName(le));
}
```

```cpp
#include <hip/hip_runtime.h>
#include <cstdio>
#include <cstdint>

#define GAS __attribute__((address_space(1)))
#define LAS __attribute__((address_space(3)))
typedef unsigned short bf16_t;
typedef short bf16x8 __attribute__((ext_vector_type(8)));
typedef short s16x4 __attribute__((ext_vector_type(4)));
typedef float f32x4 __attribute__((ext_vector_type(4)));
typedef float f32x2 __attribute__((ext_vector_type(2)));
typedef float f32x16 __attribute__((ext_vector_type(16)));
typedef unsigned u32x4 __attribute__((ext_vector_type(4)));
typedef unsigned u32x2 __attribute__((ext_vector_type(2)));

constexpr int DM = 2048, BATCH = 8, SEQ = 2048, DEPTH = 4, DECB = 32, DECS = 64, PAST = 4096;
constexpr int MP = BATCH * SEQ, MS = DECB * DECS, MT = MP + MS;
constexpr int NEVEN = 2, NODD = 2;
constexpr int HEADS = 8, QR = 512, KVR = 512, NOPE = 128, ROPE = 64, VD = 128, QKD = NOPE + ROPE;
constexpr int POOLW = 1024, POOLKEEP = 15;
constexpr int INA = 2112, INA_PAD = 2304;
constexpr int CHD = 16, HF = 128, HI = 128, INC = 8192;
constexpr int DFF = 5632, DFF2 = 11264;
constexpr int KVW = KVR + ROPE;
constexpr float EPS = 1e-6f;
constexpr int NPOS = SEQ + DECS;

constexpr size_t O_YP = 0;
constexpr size_t O_YS = O_YP + (size_t)MP * DM;
constexpr size_t O_LATP = O_YS + (size_t)MS * DM;
constexpr size_t O_KPEP = O_LATP + (size_t)NEVEN * MP * KVR;
constexpr size_t O_POOLP = O_KPEP + (size_t)NEVEN * MP * ROPE;
constexpr size_t O_HGP = O_POOLP + (size_t)NEVEN * BATCH * POOLKEEP * POOLW;
constexpr size_t O_CVP = O_HGP + (size_t)NODD * BATCH * CHD * HF * HI;
constexpr size_t O_LATS = O_CVP + (size_t)DEPTH * BATCH * 2 * DFF2;
constexpr size_t O_KPES = O_LATS + (size_t)NEVEN * MS * KVR;
constexpr size_t O_POOLS = O_KPES + (size_t)NEVEN * MS * ROPE;
constexpr size_t O_HGS = O_POOLS + (size_t)NEVEN * DECB * POOLKEEP * POOLW;
constexpr size_t O_CVS = O_HGS + (size_t)NODD * DECB * CHD * HF * HI;
constexpr size_t O_END = O_CVS + (size_t)DEPTH * DECB * 2 * DFF2;
static_assert(O_END == 84787200, "output size");

enum { I_XP = 0, I_XS, I_CLAT, I_CKPE, I_SPOOL, I_SHGRN, I_SCONV, I_GMIX, I_GFFN, I_GFINAL, I_WINA, I_GQA, I_WQB, I_GKVA, I_WUK, I_WUV,
       I_WPOOL, I_PSCALE, I_WOUTA, I_WINC, I_LB, I_GONORM, I_WOUTC, I_WUP, I_CONVW, I_CONVB, I_WDOWN, N_IN };

constexpr size_t al256(size_t x) { return (x + 255) / 256 * 256; }
constexpr size_t WS_CTL = 0, CTL_BYTES = 1u << 20;
constexpr size_t WS_WINA = WS_CTL + CTL_BYTES;
constexpr size_t WS_WQB = WS_WINA + al256((size_t)NEVEN * INA_PAD * DM * 2);
constexpr size_t WS_WKV = WS_WQB + al256((size_t)NEVEN * 1536 * QR * 2);
constexpr size_t WS_WUKBD = WS_WKV + al256((size_t)NEVEN * 2048 * KVR * 2);
constexpr size_t WS_WUVBD = WS_WUKBD + al256((size_t)NEVEN * 4096 * 1024 * 2);
constexpr size_t WS_WPOOL = WS_WUVBD + al256((size_t)NEVEN * 1024 * 4096 * 2);
constexpr size_t WS_WOUTA = WS_WPOOL + al256((size_t)NEVEN * 1024 * 256 * 2);
constexpr size_t WS_WINC = WS_WOUTA + al256((size_t)NEVEN * DM * DM * 2);
constexpr size_t WS_WOUTC = WS_WINC + al256((size_t)NODD * INC * DM * 2);
constexpr size_t WS_WUP = WS_WOUTC + al256((size_t)NODD * DM * DM * 2);
constexpr size_t WS_WDOWN = WS_WUP + al256((size_t)DEPTH * DFF2 * DM * 2);
constexpr size_t WS_KVC = WS_WDOWN + al256((size_t)DEPTH * DM * DFF * 2);
constexpr size_t WS_ROPE = WS_KVC + al256((size_t)NEVEN * DECB * PAST * KVW * 2);
constexpr size_t WS_LBS = WS_ROPE + al256((size_t)NPOS * 32 * 8);
constexpr size_t WS_SSQP = WS_LBS + al256((size_t)NODD * 2048 * 4);
constexpr size_t WS_RSTD = WS_SSQP + al256((size_t)9 * 32 * MT * 4);
constexpr size_t WS_SSQQ = WS_RSTD + al256((size_t)9 * MT * 4);
constexpr size_t WS_SSQKV = WS_SSQQ + al256((size_t)NEVEN * 8 * MT * 4);
constexpr size_t WS_HALO = WS_SSQKV + al256((size_t)NEVEN * 8 * MT * 4);
constexpr size_t WS_X = WS_HALO + al256((size_t)(MT / 256) * 4 * DFF2 * 4);
constexpr size_t WS_XB = WS_X + al256((size_t)MT * DM * 4);
constexpr size_t WS_YCAT = WS_XB + al256((size_t)MT * DM * 2);
constexpr size_t WS_BIG = WS_YCAT + al256((size_t)MT * DM * 2);
constexpr size_t WS_CQB = WS_BIG;
constexpr size_t WS_ZB = WS_CQB + al256((size_t)MT * QR * 2);
constexpr size_t WS_PB = WS_ZB + al256((size_t)MT * POOLW * 2);
constexpr size_t WS_KVN = WS_PB + al256((size_t)MT * POOLW * 2);
constexpr size_t WS_QP = WS_KVN + al256((size_t)MT * KVW * 2);
constexpr size_t WS_KP = WS_QP + al256((size_t)MP * HEADS * QKD * 2);
constexpr size_t WS_VP = WS_KP + al256((size_t)MP * HEADS * QKD * 2);
constexpr size_t WS_QNS = WS_VP + al256((size_t)MP * HEADS * VD * 2);
constexpr size_t WS_QS = WS_QNS + al256((size_t)MS * 1024 * 2);
constexpr size_t WS_OLAT = WS_QS + al256((size_t)MS * HEADS * KVW * 2);
constexpr size_t WS_EVEN_END = WS_OLAT + al256((size_t)MS * HEADS * KVR * 2);
constexpr size_t WS_FG = WS_BIG;
constexpr size_t WS_QSIL = WS_FG + al256((size_t)MT * 2048 * 4);
constexpr size_t WS_VB = WS_QSIL + al256((size_t)MT * 2048 * 2);
constexpr size_t WS_GS = WS_VB + al256((size_t)MT * 2048 * 2);
constexpr size_t WS_ODD_END = WS_GS + al256((size_t)MT * 2048 * 2);
constexpr size_t WS_HB = WS_BIG;
constexpr size_t WS_ACT = WS_HB + al256((size_t)MT * DFF2 * 2);
constexpr size_t WS_FFN_END = WS_ACT + al256((size_t)MT * DFF * 2);
constexpr size_t WS_END = WS_FFN_END > WS_EVEN_END ? (WS_FFN_END > WS_ODD_END ? WS_FFN_END : WS_ODD_END) : (WS_EVEN_END > WS_ODD_END ? WS_EVEN_END : WS_ODD_END);
static_assert(WS_END <= (size_t)2147483648u, "workspace map must fit 4 x largest input");

constexpr int CW_BAR = 4096;

constexpr int RING_BYTES = 159744;
constexpr int EPI_LDS = 131072;
constexpr int EPI_CW = EPI_LDS + 8192;
constexpr int EPI_RS = EPI_CW + 8192;
static_assert(EPI_RS + 2048 <= RING_BYTES, "epilogue LDS");
constexpr int MISC_OFF = RING_BYTES;
constexpr int LDS_BYTES = RING_BYTES + 256;
constexpr int NWAVES = 8;

#define LDS_WAIT() asm volatile("s_waitcnt lgkmcnt(0)" ::: "memory")
#define VM_WAIT() asm volatile("s_waitcnt vmcnt(0)" ::: "memory")
typedef __bf16 bf16x2_t __attribute__((ext_vector_type(2)));
__device__ __forceinline__ unsigned cvt_pk_bf16(float lo, float hi) { const f32x2 v = {lo, hi}; unsigned r = __builtin_bit_cast(unsigned, __builtin_convertvector(v, bf16x2_t)); asm volatile("" : "+v"(r)); return r; }
__device__ __forceinline__ float bf_lo(unsigned w) { return __uint_as_float(w << 16); }
__device__ __forceinline__ float bf_hi(unsigned w) { return __uint_as_float(w & 0xffff0000u); }
__device__ __forceinline__ float wave_sum(float v) {
#pragma unroll
    for (int o = 1; o < 64; o <<= 1) v += __shfl_xor(v, o);
    return v;
}
__device__ __forceinline__ float row4_sum(float x) {
    { const auto r = __builtin_amdgcn_permlane16_swap(__float_as_uint(x), __float_as_uint(x), false, false); x = __uint_as_float(r[0]) + __uint_as_float(r[1]); }
    { const auto r = __builtin_amdgcn_permlane32_swap(__float_as_uint(x), __float_as_uint(x), false, false); x = __uint_as_float(r[0]) + __uint_as_float(r[1]); }
    return x;
}
__device__ __forceinline__ float silu_f(float x) { return x * __builtin_amdgcn_rcpf(1.0f + __expf(-x)); }
__device__ __forceinline__ float sigmoid_f(float x) { return __builtin_amdgcn_rcpf(1.0f + __expf(-x)); }
template <class T> __device__ __forceinline__ T* as_global(T* p) { return (T*)(T GAS*)(unsigned long long)p; }
template <class T> __device__ __forceinline__ T* lau_s(T* p) { asm volatile("" : "+s"(p)); return as_global(p); }
template <class T> __device__ __forceinline__ T* lau_vp(T* p) { asm volatile("" : "+v"(p)); return as_global(p); }
__device__ __forceinline__ int lau_v(int x) { asm volatile("" : "+v"(x)); return x; }
__device__ __forceinline__ int lau_si(int x) { asm volatile("" : "+s"(x)); return x; }
__device__ __forceinline__ int lane_id() { int l; asm volatile("v_mbcnt_lo_u32_b32 %0, -1, 0\n\tv_mbcnt_hi_u32_b32 %0, -1, %0" : "=v"(l)); return l; }
#define XB_TMO      128
#define XB_XCNT(j)  (256  + 64 * (j))
#define XB_XSUB(j)  (1280 + 64 * (j))
#define XB_XGEN(j)  (2304 + 64 * (j))
#define XB_TOP      3328
#define XB_TOPGEN   3392
#define XCD_BAR_WORDS 3456
#define XB_SPIN_CAP (1u << 18)

__device__ __forceinline__ unsigned xb_ld(unsigned* p)              { return __hip_atomic_load(p, __ATOMIC_RELAXED, __HIP_MEMORY_SCOPE_AGENT); }
__device__ __forceinline__ unsigned xb_add(unsigned* p, unsigned v) { return __hip_atomic_fetch_add(p, v, __ATOMIC_RELAXED, __HIP_MEMORY_SCOPE_AGENT); }
__device__ __forceinline__ unsigned xb_xcc_id() { return (unsigned)__builtin_amdgcn_s_getreg((3 << 11) | 20) & 0xFu; }
#define XB_SPIN(cond, bar) do { unsigned _sp = 0; while (cond) { __builtin_amdgcn_s_sleep(1); \
    if ((++_sp & 255u) == 0u) { if (xb_ld(&(bar)[XB_TMO])) break; if (_sp > XB_SPIN_CAP) { atomicAdd(&(bar)[XB_TMO], 1u); break; } } } } while (0)

struct XcdBarrier {
    unsigned* bar; unsigned x;
    volatile LAS unsigned* st;
};

__device__ __forceinline__ XcdBarrier xcd_barrier_post(unsigned* bar, volatile LAS unsigned* st) {
    XcdBarrier b; b.bar = bar; b.x = xb_xcc_id(); b.st = st;
    if (threadIdx.x == 0) (void)xb_add(&bar[XB_XCNT(b.x)], 1u);
    return b;
}
__device__ __forceinline__ void xcd_barrier_complete(unsigned* bar, unsigned x, unsigned& nloc, unsigned& nx) {
    const unsigned G = gridDim.x * gridDim.y * gridDim.z;
    unsigned sum, cnt, mine, sp = 0u;
    for (;;) {
        sum = 0u; cnt = 0u; mine = 0u;
#pragma unroll
        for (unsigned j = 0; j < 16; ++j) { const unsigned c = xb_ld(&bar[XB_XCNT(j)]); sum += c; cnt += (c > 0u) ? 1u : 0u; mine = (j == x) ? c : mine; }
        if (sum == G) break;
        __builtin_amdgcn_s_sleep(1);
        if ((++sp & 255u) == 0u) { if (xb_ld(&bar[XB_TMO])) break; if (sp > XB_SPIN_CAP) { atomicAdd(&bar[XB_TMO], 1u); break; } }
    }
    nloc = mine > 0u ? mine : 1u; nx = cnt > 0u ? cnt : 1u;
}

__device__ __forceinline__ void xcd_barrier(const XcdBarrier& b) {
    asm volatile("s_waitcnt vmcnt(0)" ::: "memory");
    __syncthreads();
    if (threadIdx.x == 0) {
        unsigned* bar = b.bar;
        __builtin_amdgcn_s_waitcnt(0);
        unsigned nloc = b.st[0], nx = b.st[1];
        if (nloc == 0u) { xcd_barrier_complete(bar, b.x, nloc, nx); b.st[0] = nloc; b.st[1] = nx; }
        const unsigned old = xb_add(&bar[XB_XSUB(b.x)], 1u);
        const unsigned gen = old / nloc;
        if (old + 1u == (gen + 1u) * nloc) {
            __builtin_amdgcn_fence(__ATOMIC_RELEASE, "agent");
            asm volatile("s_waitcnt vmcnt(0)" ::: "memory");
            const unsigned og = xb_add(&bar[XB_TOP], 1u);
            const unsigned tg = og / nx;
            if (og + 1u == (tg + 1u) * nx) xb_add(&bar[XB_TOPGEN], 1u);
            else XB_SPIN(xb_ld(&bar[XB_TOPGEN]) == tg, bar);
            __builtin_amdgcn_fence(__ATOMIC_ACQUIRE, "agent");
            xb_add(&bar[XB_XGEN(b.x)], 1u);
            asm volatile("s_waitcnt vmcnt(0)" ::: "memory");
        } else {
            XB_SPIN(xb_ld(&bar[XB_XGEN(b.x)]) == gen, bar);
            __builtin_amdgcn_fence(__ATOMIC_ACQUIRE, "agent");
            asm volatile("s_waitcnt vmcnt(0)" ::: "memory");
        }
    }
    __syncthreads();
}

namespace pg8 {
constexpr int BM = 256, BK = 64, HALF = 128, HTB = HALF * BK * 2, STAGE_BYTES = 8 * HTB, NXCD = 8, WGM = 8;
__host__ __device__ __forceinline__ int lds_byte(int r, int c) { const int st = (r >> 4) * 2 + (c >> 5), rr = r & 15, cc = c & 31, ob = rr * 64 + cc * 2; return st * 1024 + (ob ^ (((ob >> 9) & 1) << 5)); }
__host__ __device__ __forceinline__ void stage_rc(int b, int& R, int& C) { const int st = b / 1024, sb = b % 1024, swz = sb ^ (((sb >> 9) & 1) << 5); R = (st >> 1) * 16 + swz / 64; C = (st & 1) * 32 + (swz % 64) / 2; }
__host__ __device__ __forceinline__ int perm32(int rho) { const int n = rho >> 4, i = rho & 15; return 8 * (i >> 2) + 4 * n + (i & 3); }

struct Unit { int pm, pn, par; };
struct Gemm { const bf16_t* A; const bf16_t* Bt; int lda, ldb, K; };

struct StaticOrder {
    int nM, nN, nwg, G, c, lda, ldb, bm;
    __device__ void init(int nM_, int nN_, int G_, int c_, int lda_, int ldb_, int bm_ = BM) { nM = nM_; nN = nN_; nwg = nM * nN; G = G_; c = c_; lda = lda_; ldb = ldb_; bm = bm_; }
    __device__ bool next(int i, Unit& u) const {
        const long L = (long)i * G + c; if (L >= nwg) return false;
        int wgid = (int)L; { const int q = nwg / NXCD, r = nwg % NXCD, xcd = wgid % NXCD, off = wgid / NXCD; wgid = (xcd < r ? xcd * (q + 1) : r * (q + 1) + (xcd - r) * q) + off; }
        const int nig = WGM * nN, gid = wgid / nig, fm = gid * WGM, gsz = (nM - fm) < WGM ? (nM - fm) : WGM;
        u.pm = fm + ((wgid % nig) % gsz); u.pn = (wgid % nig) / gsz; return true;
    }
    __device__ __forceinline__ size_t aoff(const Unit& u) const { return (size_t)u.pm * bm * lda * 2; }
    __device__ __forceinline__ size_t boff(const Unit& u) const { return (size_t)u.pn * BM * ldb * 2; }
};
struct GroupOrder {
    int nM, ng, nwg, G, c, lda, ldb, akoff;
    __device__ void init(int nM_, int ng_, int G_, int c_, int lda_, int ldb_, int akoff_) { nM = nM_; ng = ng_; nwg = nM * ng; G = G_; c = c_; lda = lda_; ldb = ldb_; akoff = akoff_; }
    __device__ bool next(int i, Unit& u) const {
        const long L = (long)i * G + c; if (L >= nwg) return false;
        u.pm = (int)(L / ng); u.pn = (int)(L % ng); return true;
    }
    __device__ __forceinline__ size_t aoff(const Unit& u) const { return ((size_t)u.pm * BM * lda + (size_t)u.pn * akoff) * 2; }
    __device__ __forceinline__ size_t boff(const Unit& u) const { return (size_t)u.pn * BM * ldb * 2; }
};

struct HeadOrder {
    int nM, nt, nwg, G, c, lda, ldb, akoff;
    __device__ void init(int nM_, int nt_, int G_, int c_, int lda_, int ldb_, int akoff_) { nM = nM_; nt = nt_; nwg = nM * nt; G = G_; c = c_; lda = lda_; ldb = ldb_; akoff = akoff_; }
    __device__ bool next(int i, Unit& u) const {
        const long L = (long)i * G + c; if (L >= nwg) return false;
        u.pm = (int)(L / nt); u.pn = (int)(L % nt); return true;
    }
    __device__ __forceinline__ size_t aoff(const Unit& u) const { return ((size_t)u.pm * BM * lda + (size_t)(u.pn >> 1) * akoff) * 2; }
    __device__ __forceinline__ size_t boff(const Unit& u) const { return (size_t)u.pn * BM * ldb * 2; }
};

template <class Epi, class Sched, bool ALIGN_EPI = true, bool SP2 = true, int NM = 4>
__device__ __forceinline__ void gemm_phase(LAS unsigned char* lds, const Gemm g, const Sched& S, const Epi& E, int wid) {
    const int lane = lau_v(lane_id()), tid = wid * 64 + lane, wr = wid >> 2, wc = wid & 3, fr = lane & 15, fq = lane >> 4;
    const int K = g.K, nt = K / BK;
    unsigned voffA[2], voffB[2];
#pragma unroll
    for (int i = 0; i < 2; ++i) { int R, C; stage_rc(tid * 16 + i * 8192, R, C); const int Rb = Epi::PERM ? ((R & ~31) + perm32(R & 31)) : R;
        voffA[i] = (unsigned)(R * g.lda + C) * 2u; voffB[i] = (unsigned)(Rb * g.ldb + C) * 2u; }
    const size_t kstep = (size_t)(BK * 2);
    const size_t hstepA = (size_t)(32 * NM) * g.lda * 2, hstepB = (size_t)HALF * g.ldb * 2;
    const unsigned ldsw = (unsigned)wid * 1024u;
    const int aoff = lds_byte(wr * (16 * NM) + fr, fq * 8), boff = lds_byte(wc * 32 + fr, fq * 8);
#define PG8_SA(b, h) (((b) * 2 + (h)) * HTB)
#define PG8_SB(b, h) ((4 + (b) * 2 + (h)) * HTB)
#define PG8_STAGE(bufoff, gbase, voff) do { _Pragma("unroll") for (int _i = 0; _i < 2; ++_i) \
        __builtin_amdgcn_global_load_lds((const unsigned*)((const char*)(gbase) + (voff)[_i]), (LAS unsigned*)(lds + (bufoff) + ldsw + _i * 8192), 16, 0, 0); } while (0)
#define PG8_LDA(dst, b, h) do { _Pragma("unroll") for (int m = 0; m < NM; ++m) _Pragma("unroll") for (int k = 0; k < 2; ++k) dst[m][k] = *(const LAS bf16x8*)(lds + PG8_SA(b, h) + aoff + m * 2048 + k * 1024); } while (0)
#define PG8_LDB(dst, b, h) do { _Pragma("unroll") for (int n = 0; n < 2; ++n) _Pragma("unroll") for (int k = 0; k < 2; ++k) dst[n][k] = *(const LAS bf16x8*)(lds + PG8_SB(b, h) + boff + n * 2048 + k * 1024); } while (0)
#define PG8_MMA(ai, bj, At, Bt) do { __builtin_amdgcn_s_setprio(1); _Pragma("unroll") for (int m = 0; m < NM; ++m) _Pragma("unroll") for (int n = 0; n < 2; ++n) _Pragma("unroll") for (int k = 0; k < 2; ++k) \
        acc[ai][bj][m][n] = __builtin_amdgcn_mfma_f32_16x16x32_bf16(Bt[n][k], At[m][k], acc[ai][bj][m][n], 0, 0, 0); __builtin_amdgcn_s_setprio(0); } while (0)
#define PG8_WAIT_V(n) asm volatile("s_waitcnt vmcnt(" #n ")" ::: "memory")
#define PG8_WAIT_L(n) asm volatile("s_waitcnt lgkmcnt(" #n ")" ::: "memory")
#define PG8_BAR __builtin_amdgcn_s_barrier()
#define PG8_SCHED __builtin_amdgcn_sched_barrier(0)
    Unit cur, nxt; int ui = 0;
    if (!S.next(0, cur)) return;
    cur.par = 0;
    f32x4 acc[2][2][NM][2];
#pragma unroll
    for (int a = 0; a < 2; ++a)
#pragma unroll
        for (int b = 0; b < 2; ++b)
#pragma unroll
            for (int m = 0; m < NM; ++m)
#pragma unroll
                for (int n = 0; n < 2; ++n) acc[a][b][m][n] = (f32x4){0.f, 0.f, 0.f, 0.f};
    bf16x8 At[NM][2], B0[2][2], B1[2][2];
    const char* cA = (const char*)g.A + S.aoff(cur); const char* cB = (const char*)g.Bt + S.boff(cur);
    if constexpr (SP2) {
        PG8_STAGE(PG8_SB(0, 0), cB, voffB); PG8_STAGE(PG8_SB(0, 1), cB + hstepB, voffB); PG8_STAGE(PG8_SA(0, 0), cA, voffA); PG8_STAGE(PG8_SA(0, 1), cA + hstepA, voffA);
        if (wr == 1) PG8_BAR;
        PG8_WAIT_V(2); PG8_BAR;
        PG8_STAGE(PG8_SB(1, 0), cB + kstep, voffB); PG8_STAGE(PG8_SA(1, 0), cA + kstep, voffA); PG8_STAGE(PG8_SB(1, 1), cB + hstepB + kstep, voffB);
        PG8_WAIT_V(6); PG8_BAR;
    } else {
        PG8_STAGE(PG8_SB(0, 0), cB, voffB); PG8_STAGE(PG8_SA(0, 0), cA, voffA); PG8_STAGE(PG8_SB(0, 1), cB + hstepB, voffB); PG8_STAGE(PG8_SA(0, 1), cA + hstepA, voffA);
        if (wr == 1) PG8_BAR;
        PG8_WAIT_V(4); PG8_BAR;
        PG8_STAGE(PG8_SB(1, 0), cB + kstep, voffB); PG8_STAGE(PG8_SA(1, 0), cA + kstep, voffA); PG8_STAGE(PG8_SB(1, 1), cB + hstepB + kstep, voffB);
        PG8_WAIT_V(6); PG8_BAR;
    }
    for (;;) {
        const bool has_next = S.next(ui + 1, nxt);
        const char* nA = has_next ? (const char*)g.A + S.aoff(nxt) : cA; const char* nB = has_next ? (const char*)g.Bt + S.boff(nxt) : cB;
        if constexpr (Epi::PRE) E.pre(lds, cur, wid);
        for (int t = 0; t < nt; t += 2) {
            const bool last = (t == nt - 2);
            const char* a1 = cA + (size_t)(t + 1) * kstep;
            const char* a2 = last ? nA : cA + (size_t)(t + 2) * kstep; const char* b2 = last ? nB : cB + (size_t)(t + 2) * kstep;
            const char* a3 = a2 + kstep; const char* b3 = b2 + kstep;
            if constexpr (SP2) {
            PG8_LDB(B0, 0, 0); PG8_LDB(B1, 0, 1); PG8_SCHED; PG8_LDA(At, 0, 0); PG8_STAGE(PG8_SA(1, 1), a1 + hstepA, voffA);
            PG8_WAIT_V(8); PG8_WAIT_L(0); PG8_BAR; PG8_MMA(0, 0, At, B0); PG8_MMA(0, 1, At, B1); PG8_BAR; PG8_SCHED;
            PG8_LDA(At, 0, 1); PG8_STAGE(PG8_SB(0, 0), b2, voffB); PG8_STAGE(PG8_SB(0, 1), b2 + hstepB, voffB); PG8_STAGE(PG8_SA(0, 0), a2, voffA);
            PG8_WAIT_V(8); PG8_WAIT_L(0); PG8_BAR; PG8_MMA(1, 0, At, B0); PG8_MMA(1, 1, At, B1); PG8_BAR; PG8_SCHED;
            PG8_LDB(B0, 1, 0); PG8_LDB(B1, 1, 1); PG8_SCHED; PG8_LDA(At, 1, 0); PG8_STAGE(PG8_SA(0, 1), a2 + hstepA, voffA);
            PG8_WAIT_V(8); PG8_WAIT_L(0); PG8_BAR; PG8_MMA(0, 0, At, B0); PG8_MMA(0, 1, At, B1); PG8_BAR; PG8_SCHED;
            PG8_LDA(At, 1, 1); PG8_STAGE(PG8_SB(1, 0), b3, voffB); PG8_STAGE(PG8_SB(1, 1), b3 + hstepB, voffB); PG8_STAGE(PG8_SA(1, 0), a3, voffA);
            PG8_WAIT_V(8); PG8_WAIT_L(0); PG8_BAR; PG8_MMA(1, 0, At, B0); PG8_MMA(1, 1, At, B1); PG8_BAR; PG8_SCHED;
            } else {
            PG8_LDB(B0, 0, 0); PG8_SCHED; PG8_LDA(At, 0, 0); PG8_STAGE(PG8_SA(1, 1), a1 + hstepA, voffA);
            PG8_WAIT_L(8); PG8_BAR; PG8_WAIT_L(0); PG8_MMA(0, 0, At, B0); PG8_BAR; PG8_SCHED;
            PG8_LDB(B1, 0, 1); PG8_STAGE(PG8_SB(0, 0), b2, voffB);
            PG8_BAR; PG8_WAIT_L(0); PG8_MMA(0, 1, At, B1); PG8_BAR;
            PG8_LDA(At, 0, 1); PG8_STAGE(PG8_SA(0, 0), a2, voffA);
            PG8_BAR; PG8_WAIT_L(0); PG8_MMA(1, 0, At, B0); PG8_BAR; PG8_SCHED;
            PG8_STAGE(PG8_SB(0, 1), b2 + hstepB, voffB);
            PG8_WAIT_V(6); PG8_BAR; PG8_MMA(1, 1, At, B1); PG8_BAR;
            PG8_LDB(B0, 1, 0); PG8_SCHED; PG8_LDA(At, 1, 0); PG8_STAGE(PG8_SA(0, 1), a2 + hstepA, voffA);
            PG8_WAIT_L(8); PG8_BAR; PG8_WAIT_L(0); PG8_MMA(0, 0, At, B0); PG8_BAR; PG8_SCHED;
            PG8_LDB(B1, 1, 1); PG8_STAGE(PG8_SB(1, 0), b3, voffB);
            PG8_BAR; PG8_WAIT_L(0); PG8_MMA(0, 1, At, B1); PG8_BAR;
            PG8_LDA(At, 1, 1); PG8_STAGE(PG8_SA(1, 0), a3, voffA);
            PG8_BAR; PG8_WAIT_L(0); PG8_MMA(1, 0, At, B0); PG8_BAR; PG8_SCHED;
            PG8_STAGE(PG8_SB(1, 1), b3 + hstepB, voffB);
            PG8_WAIT_V(6); PG8_BAR; PG8_MMA(1, 1, At, B1); PG8_BAR;
            }
        }
        if constexpr (ALIGN_EPI) { if (wr == 0) PG8_BAR; }
        E(acc, cur, wr, wc, fr, fq);
        if (!has_next) break;
#pragma unroll
        for (int a = 0; a < 2; ++a)
#pragma unroll
            for (int b = 0; b < 2; ++b)
#pragma unroll
                for (int m = 0; m < NM; ++m)
#pragma unroll
                    for (int n = 0; n < 2; ++n) acc[a][b][m][n] = (f32x4){0.f, 0.f, 0.f, 0.f};
        cur = nxt; cA = nA; cB = nB; ++ui; cur.par = ui & 1;
        if constexpr (ALIGN_EPI) { if (wr == 1) PG8_BAR; }
    }
    PG8_WAIT_V(0);
    if constexpr (!ALIGN_EPI) { if (wr == 0) PG8_BAR; }
    PG8_BAR;
#undef PG8_SA
#undef PG8_SB
#undef PG8_STAGE
#undef PG8_LDA
#undef PG8_LDB
#undef PG8_MMA
#undef PG8_WAIT_V
#undef PG8_WAIT_L
#undef PG8_BAR
#undef PG8_SCHED
}
}
struct Frame {
    LAS unsigned char* lds;
    volatile LAS unsigned* MISC;
    unsigned* ctl;
    float* ctlf;
    int wave;
    int vcu, G;
};
struct Args { const float* in[N_IN]; float* out; unsigned char* ws; int ph_lo, ph_hi; };
typedef const Args __attribute__((address_space(4))) KArgs;
__device__ __forceinline__ KArgs* kargs() { KArgs* p = (KArgs*)__builtin_amdgcn_kernarg_segment_ptr(); asm volatile("" : "+s"(p)); return p; }
__device__ __forceinline__ int rope_row(int r) { return r < MP ? (r & (SEQ - 1)) : SEQ + ((r - MP) & (DECS - 1)); }

__device__ __forceinline__ void tr_item(const float* W, int ldn, int k0, int n0, const float* ks, const float* ns, bf16_t* WT, size_t dld, int rbase, int rstride, int dcol0, LAS float* scr, int lane) {
    f32x4 v[8];
#pragma unroll
    for (int i = 0; i < 8; ++i) v[i] = *(const f32x4*)(W + (size_t)(k0 + 8 * i + (lane >> 3)) * ldn + n0 + 4 * (lane & 7));
#pragma unroll
    for (int i = 0; i < 8; ++i) { const int kk = 8 * i + (lane >> 3); const float s = ks ? ks[k0 + kk] : 1.0f; LAS float* d = scr + kk * 33 + 4 * (lane & 7);
        d[0] = v[i][0] * s; d[1] = v[i][1] * s; d[2] = v[i][2] * s; d[3] = v[i][3] * s; }
    LDS_WAIT(); asm volatile("" ::: "memory");
    const int c = lane & 7;
#pragma unroll
    for (int j = 0; j < 4; ++j) { const int n = (lane >> 3) + 8 * j; const LAS float* s = scr + (8 * c) * 33 + n; const float sc = ns ? ns[n] : 1.0f;
        u32x4 o; o.x = cvt_pk_bf16(s[0 * 33] * sc, s[1 * 33] * sc); o.y = cvt_pk_bf16(s[2 * 33] * sc, s[3 * 33] * sc); o.z = cvt_pk_bf16(s[4 * 33] * sc, s[5 * 33] * sc); o.w = cvt_pk_bf16(s[6 * 33] * sc, s[7 * 33] * sc);
        *(u32x4*)(WT + (size_t)(rbase + rstride * n) * dld + dcol0 + k0 + 8 * c) = o; }
    LDS_WAIT(); asm volatile("" ::: "memory");
}
struct TrMat { const float* W; int K, N; const float* ks; bf16_t* WT; size_t dld; int mode; const float* ns; };
__device__ __forceinline__ void tr_mat_item(const TrMat& t, int it, LAS float* scr, int lane) {
    const int nblk = t.N / 32, kb = it / nblk, nb = it % nblk, k0 = 64 * kb, n0 = 32 * nb;
    int rbase = n0, rstride = 1, dcol0 = 0;
    if (t.mode == 1) { rbase = n0 < 1024 ? n0 : (n0 < 1088 ? 2048 + (n0 - 1024) : 1024 + (n0 - 1088)); }
    else if (t.mode == 2) { const int h = n0 / 192, c = n0 % 192; if (c >= 128) { const int j0 = c - 128; rbase = h * 192 + 128 + (j0 >= 32 ? 1 : 0); rstride = 2; } }
    else if (t.mode == 3) { dcol0 = (n0 / 128) * 512; }
    else if (t.mode == 5) { const int isb = n0 >= DFF ? 1 : 0, j0 = n0 - isb * DFF; rbase = (j0 / 128) * 256 + isb * 128 + (j0 % 128); }
    tr_item(t.W, t.N, k0, n0, t.ks, t.ns ? t.ns + n0 : nullptr, t.WT, t.dld, rbase, rstride, dcol0, scr, lane);
}
__device__ __forceinline__ void sincos_red(float ang, float& sn, float& cs) {
    const double a = (double)ang, k = rint(a * 0.63661977236758134308), r = a - k * 1.57079632679489661923;
    const float x = (float)r, x2 = x * x;
    const float s = x + x * x2 * (-1.6666667e-1f + x2 * (8.3333333e-3f + x2 * (-1.9841270e-4f + x2 * 2.7557319e-6f)));
    const float c = 1.0f + x2 * (-0.5f + x2 * (4.1666667e-2f + x2 * (-1.3888889e-3f + x2 * (2.4801587e-5f + x2 * -2.7557319e-7f))));
    const int q = ((int)k) & 3;
    sn = (q == 0) ? s : (q == 1) ? c : (q == 2) ? -s : -c;
    cs = (q == 0) ? c : (q == 1) ? -s : (q == 2) ? -c : s;
}
enum { CM_WINA = 0, CM_WQB = 2, CM_WUK = 4, CM_WUV = 6, CM_WPOOL = 8, CM_WOUTA = 16, CM_WINC = 18, CM_WOUTC = 20, CM_WUP = 22, CM_WDOWN = 26, CM_FILL = 30 };
constexpr unsigned cm_attn(int i) { return (1u << (CM_WINA + i)) | (1u << (CM_WQB + i)) | (1u << (CM_WUK + i)) | (1u << (CM_WUV + i)) | (0xFu << (CM_WPOOL + 4 * i)) | (1u << (CM_WOUTA + i)) | (1u << (CM_FILL + i)); }
__device__ __forceinline__ TrMat conv_mat(KArgs* A_k, unsigned char* ws, int id) {
    TrMat t{};
    if (id < CM_WQB) { const int i = id - CM_WINA; t = TrMat{as_global(A_k->in[I_WINA]) + (size_t)i * DM * INA, DM, INA, as_global(A_k->in[I_GMIX]) + (size_t)(2 * i) * DM, (bf16_t*)(ws + WS_WINA) + (size_t)i * INA_PAD * DM, (size_t)DM, 1, nullptr}; }
    else if (id < CM_WUK) { const int i = id - CM_WQB; t = TrMat{as_global(A_k->in[I_WQB]) + (size_t)i * QR * 1536, QR, 1536, as_global(A_k->in[I_GQA]) + (size_t)i * QR, (bf16_t*)(ws + WS_WQB) + (size_t)i * 1536 * QR, (size_t)QR, 2, nullptr}; }
    else if (id < CM_WUV) { const int i = id - CM_WUK; t = TrMat{as_global(A_k->in[I_WUK]) + (size_t)i * KVR * 1024, KVR, 1024, nullptr, (bf16_t*)(ws + WS_WKV) + (size_t)i * 2048 * KVR, (size_t)KVR, 0, nullptr}; }
    else if (id < CM_WPOOL) { const int i = id - CM_WUV; t = TrMat{as_global(A_k->in[I_WUV]) + (size_t)i * KVR * 1024, KVR, 1024, nullptr, (bf16_t*)(ws + WS_WKV) + (size_t)i * 2048 * KVR + (size_t)1024 * KVR, (size_t)KVR, 0, nullptr}; }
    else if (id < CM_WOUTA) { const int ig = id - CM_WPOOL; t = TrMat{as_global(A_k->in[I_WPOOL]) + (size_t)ig * 256 * 256, 256, 256, nullptr, (bf16_t*)(ws + WS_WPOOL) + (size_t)ig * 256 * 256, (size_t)256, 0, as_global(A_k->in[I_PSCALE]) + (size_t)ig * 256}; }
    else if (id < CM_WINC) { const int i = id - CM_WOUTA; t = TrMat{as_global(A_k->in[I_WOUTA]) + (size_t)i * DM * DM, DM, DM, nullptr, (bf16_t*)(ws + WS_WOUTA) + (size_t)i * DM * DM, (size_t)DM, 0, nullptr}; }
    else if (id < CM_WOUTC) { const int i = id - CM_WINC; t = TrMat{as_global(A_k->in[I_WINC]) + (size_t)i * DM * INC, DM, INC, as_global(A_k->in[I_GMIX]) + (size_t)(2 * i + 1) * DM, (bf16_t*)(ws + WS_WINC) + (size_t)i * INC * DM, (size_t)DM, 0, nullptr}; }
    else if (id < CM_WUP) { const int i = id - CM_WOUTC; t = TrMat{as_global(A_k->in[I_WOUTC]) + (size_t)i * DM * DM, DM, DM, nullptr, (bf16_t*)(ws + WS_WOUTC) + (size_t)i * DM * DM, (size_t)DM, 0, nullptr}; }
    else if (id < CM_WDOWN) { const int l = id - CM_WUP; t = TrMat{as_global(A_k->in[I_WUP]) + (size_t)l * DM * DFF2, DM, DFF2, as_global(A_k->in[I_GFFN]) + (size_t)l * DM, (bf16_t*)(ws + WS_WUP) + (size_t)l * DFF2 * DM, (size_t)DM, 5, nullptr}; }
    else { const int l = id - CM_WDOWN; t = TrMat{as_global(A_k->in[I_WDOWN]) + (size_t)l * DFF * DM, DFF, DM, nullptr, (bf16_t*)(ws + WS_WDOWN) + (size_t)l * DM * DFF, (size_t)DFF, 0, nullptr}; }
    return t;
}
__device__ __forceinline__ void conv_run(const Frame& F, KArgs* A_k, unsigned mask, int widx, int nw) {
    LAS float* scr = (LAS float*)(F.lds + F.wave * 16384);
    const int lane = lau_v(lane_id()); unsigned char* ws = lau_s(A_k->ws);
    int first = widx;
#pragma unroll 1
    for (int id = 0; id < CM_FILL; ++id) {
        if (!((mask >> id) & 1u)) continue;
        const TrMat t = conv_mat(A_k, ws, id); const int n = (t.K / 64) * (t.N / 32);
        int it = first;
#pragma unroll 1
        for (; it < n; it += nw) tr_mat_item(t, it, scr, lane);
        first = it - n;
    }
#pragma unroll 1
    for (int i = 0; i < NEVEN; ++i) {
        if (!((mask >> (CM_FILL + i)) & 1u)) continue;
        const unsigned tix = (unsigned)(widx * 64 + lau_v(lane)), nthr = (unsigned)nw * 64u; const unsigned z_ = (unsigned)lau_v(0); const u32x4 z4 = {z_, z_, z_, z_};
        for (unsigned c = tix; c < (unsigned)((INA_PAD - INA) * DM / 8); c += nthr) *(u32x4*)((bf16_t*)(ws + WS_WINA) + ((size_t)i * INA_PAD + INA) * DM + (size_t)c * 8) = z4;
        for (unsigned c = tix; c < 4096u * 16u; c += nthr) {
            const int row = (int)(c / 16), d0 = (int)(c % 16) * 8, h = row / 512, r = row % 512;
            const float* s = as_global(A_k->in[I_WUK]) + (((size_t)i * KVR + r) * HEADS + h) * NOPE + d0; const f32x4 a = *(const f32x4*)s, b = *(const f32x4*)(s + 4);
            u32x4 o; o.x = cvt_pk_bf16(a[0], a[1]); o.y = cvt_pk_bf16(a[2], a[3]); o.z = cvt_pk_bf16(b[0], b[1]); o.w = cvt_pk_bf16(b[2], b[3]);
            *(u32x4*)((bf16_t*)(ws + WS_WUKBD) + (size_t)i * 4096 * 128 + (size_t)row * 128 + d0) = o; }
    }
}
constexpr unsigned CJ_PROLOGUE = cm_attn(0) | (1u << (CM_WUP + 0)) | (1u << (CM_WINC + 0)) | (1u << (CM_WINC + 1)) | (1u << (CM_WUP + 2));
constexpr unsigned CJ_INA0 = (1u << (CM_WOUTC + 0)), CJ_INA2 = (1u << (CM_WOUTC + 1));
constexpr unsigned CJ_UP0 = (1u << (CM_WDOWN + 0)), CJ_UP1 = (1u << (CM_WDOWN + 1)), CJ_UP2 = (1u << (CM_WDOWN + 2));
constexpr unsigned CJ_GLA1 = (1u << (CM_WUP + 1)) | cm_attn(1), CJ_GLA3 = (1u << (CM_WUP + 3)) | (1u << (CM_WDOWN + 3));
static_assert((CJ_PROLOGUE | CJ_INA0 | CJ_INA2 | CJ_UP0 | CJ_UP1 | CJ_UP2 | CJ_GLA1 | CJ_GLA3) == 0xFFFFFFFFu, "every matrix is converted exactly once");
static_assert((CJ_PROLOGUE ^ CJ_INA0 ^ CJ_INA2 ^ CJ_UP0 ^ CJ_UP1 ^ CJ_UP2 ^ CJ_GLA1 ^ CJ_GLA3) == 0xFFFFFFFFu, "every matrix is converted exactly once");
__device__ __forceinline__ void p0_prologue(const Frame& F, KArgs* A_k) {
    LAS float* scr = (LAS float*)(F.lds + F.wave * 16384);
    const int lane = lau_v(lane_id());
    const int gw = lau_si(F.vcu * NWAVES + F.wave), NGW = F.G * NWAVES;
    const size_t gt = (size_t)gw * 64 + lane, NGT = (size_t)NGW * 64;
    unsigned char* ws = lau_s(A_k->ws);
    conv_run(F, A_k, CJ_PROLOGUE, gw, NGW);
    for (size_t c = gt; c < (size_t)NPOS * 32; c += NGT) {
        const int pr = (int)(c / 32), j = (int)(c % 32); const float pos = (float)(pr < SEQ ? pr : PAST + (pr - SEQ));
        const float inv = exp2f(-((float)(2 * j) / 64.0f) * 13.287712379549449f); const float ang = pos * inv; float sn, cs; sincos_red(ang, sn, cs);
        ((f32x2*)(ws + WS_ROPE))[c] = (f32x2){cs, sn}; }
    for (size_t c = gt; c < (size_t)2048; c += NGT) {
        const float p0 = as_global(A_k->in[I_LB])[c], p1 = as_global(A_k->in[I_LB])[2048 + c], mx = fmaxf(p0, p1), e0 = expf(p0 - mx), e1 = expf(p1 - mx), s0 = e0 / (e0 + e1), s1 = e1 / (e0 + e1);
        float* lb = (float*)(ws + WS_LBS); lb[c] = fminf(fmaxf(s0 - s0, 0.f), 1.f); lb[2048 + c] = fminf(fmaxf((s0 + s1) - s0, 0.f), 1.f); }
    for (int r0 = gw; r0 < MT; r0 += 3 * NGW) {
        f32x4 v[3][8];
#pragma unroll
        for (int k = 0; k < 3; ++k) { const int r = r0 + k * NGW; if (r < MT) {
            const float* xr = r < MP ? as_global(A_k->in[I_XP]) + (size_t)r * DM : as_global(A_k->in[I_XS]) + (size_t)(r - MP) * DM;
#pragma unroll
            for (int j = 0; j < 8; ++j) v[k][j] = *(const f32x4*)(xr + (64 * j + lane) * 4); } }
        asm volatile("" ::: "memory");
#pragma unroll
        for (int k = 0; k < 3; ++k) { const int r = r0 + k * NGW; if (r < MT) {
            bf16_t* xb = (bf16_t*)(ws + WS_XB) + (size_t)r * DM; float s = 0.f;
#pragma unroll
            for (int j = 0; j < 8; ++j) { const f32x4 w = v[k][j]; s += (w[0] * w[0] + w[1] * w[1]) + (w[2] * w[2] + w[3] * w[3]);
                u32x2 o; o.x = cvt_pk_bf16(w[0], w[1]); o.y = cvt_pk_bf16(w[2], w[3]); *(u32x2*)(xb + (64 * j + lane) * 4) = o; }
            s = wave_sum(s); if (lane == 0) ((float*)(ws + WS_RSTD))[r] = rsqrtf(s * (1.0f / DM) + EPS); } }
    }
}
#define EPI_ROWS(u) { const int _l = lane_id(); fr = _l & 15; fq = _l >> 4; } const int row0 = (u).pm * 256 + wr * 64 + fr
#define EPI_ROW(ai, m) (row0 + (ai) * 128 + (m) * 16)

struct EpiInA {
    static constexpr bool PERM = false, PRE = true;
    unsigned char* ws; float* out; int li; LAS unsigned char* lds;
    __device__ __forceinline__ void pre(LAS unsigned char* l, const pg8::Unit& u, int wid) const {
        if (wid == 4) { const float* src = (const float*)(ws + WS_RSTD) + (size_t)(4 * li) * MT + u.pm * 256 + lane_id() * 4;
            __builtin_amdgcn_global_load_lds((const unsigned*)src, (LAS unsigned*)(l + EPI_RS + u.par * 1024), 16, 0, 0); }
    }
    __device__ __forceinline__ void operator()(const f32x4 (&acc)[2][2][4][2], const pg8::Unit& u, int wr, int wc, int fr, int fq) const {
        EPI_ROWS(u); const int pn = u.pn, cb = wc * 32 + 4 * fq;
        const LAS float* rsl = (const LAS float*)(lds + EPI_RS + u.par * 1024) + wr * 64 + fr; float* ssqq = (float*)(ws + WS_SSQQ) + (size_t)(li * 8 + (pn & 1) * 4 + wc) * MT; float* ssqkv = (float*)(ws + WS_SSQKV) + (size_t)(li * 8 + (pn & 1) * 4 + wc) * MT;
        bf16_t* cqb = (bf16_t*)(ws + WS_CQB); bf16_t* zb = (bf16_t*)(ws + WS_ZB);
#pragma unroll
        for (int ai = 0; ai < 2; ++ai)
#pragma unroll
            for (int m = 0; m < 4; ++m) {
                const int r = EPI_ROW(ai, m); const float rs = rsl[ai * 128 + m * 16];
                f32x4 v[2][2]; float sq = 0.f;
#pragma unroll
                for (int bj = 0; bj < 2; ++bj)
#pragma unroll
                    for (int n = 0; n < 2; ++n) { v[bj][n] = acc[ai][bj][m][n] * rs; sq += (v[bj][n][0] * v[bj][n][0] + v[bj][n][1] * v[bj][n][1]) + (v[bj][n][2] * v[bj][n][2] + v[bj][n][3] * v[bj][n][3]); }
                if (pn < 2) {
                    bf16_t* o = cqb + (size_t)r * QR + pn * 256 + cb;
#pragma unroll
                    for (int bj = 0; bj < 2; ++bj)
#pragma unroll
                        for (int n = 0; n < 2; ++n) { u32x2 w; w.x = cvt_pk_bf16(v[bj][n][0], v[bj][n][1]); w.y = cvt_pk_bf16(v[bj][n][2], v[bj][n][3]); *(u32x2*)(o + bj * 128 + n * 16) = w; }
                    sq = row4_sum(sq); if (fq == 0) ssqq[r] = sq;
                } else if (pn < 4) {
                    float* o = (r < MP ? out + O_LATP + ((size_t)li * MP + r) * KVR : out + O_LATS + ((size_t)li * MS + (r - MP)) * KVR) + (pn - 2) * 256 + cb;
#pragma unroll
                    for (int bj = 0; bj < 2; ++bj)
#pragma unroll
                        for (int n = 0; n < 2; ++n) *(f32x4*)(o + bj * 128 + n * 16) = v[bj][n];
                    sq = row4_sum(sq); if (fq == 0) ssqkv[r] = sq;
                } else if (pn < 8) {
                    bf16_t* o = zb + (size_t)r * POOLW + (pn - 4) * 256 + cb;
#pragma unroll
                    for (int bj = 0; bj < 2; ++bj)
#pragma unroll
                        for (int n = 0; n < 2; ++n) { u32x2 w; w.x = cvt_pk_bf16(v[bj][n][0], v[bj][n][1]); w.y = cvt_pk_bf16(v[bj][n][2], v[bj][n][3]); *(u32x2*)(o + bj * 128 + n * 16) = w; }
                    float* po = nullptr;
                    if (r < MP) { const int t = r & (SEQ - 1); if (t >= SEQ - POOLKEEP) po = out + O_POOLP + (((size_t)li * BATCH + (r >> 11)) * POOLKEEP + (t - (SEQ - POOLKEEP))) * POOLW; }
                    else { const int rr = r - MP, t = rr & (DECS - 1); if (t >= DECS - POOLKEEP) po = out + O_POOLS + (((size_t)li * DECB + (rr >> 6)) * POOLKEEP + (t - (DECS - POOLKEEP))) * POOLW; }
                    if (po) { po += (pn - 4) * 256 + cb;
#pragma unroll
                        for (int bj = 0; bj < 2; ++bj)
#pragma unroll
                            for (int n = 0; n < 2; ++n) *(f32x4*)(po + bj * 128 + n * 16) = v[bj][n]; }
                } else {
                    float* o = (r < MP ? out + O_KPEP + ((size_t)li * MP + r) * ROPE : out + O_KPES + ((size_t)li * MS + (r - MP)) * ROPE) + cb;
                    if (cb < 64) {
#pragma unroll
                        for (int n = 0; n < 2; ++n) *(f32x4*)(o + n * 16) = v[0][n]; }
                }
            }
    }
};

__device__ __forceinline__ void post_a_phase(const Frame& F, KArgs* A_, int li) {
    const int lane = lau_v(lane_id()); struct { unsigned char* ws; float* out; } A{lau_s(A_->ws), lau_s(A_->out)};
    const int gw = lau_si(F.vcu * NWAVES + F.wave), NGW = F.G * NWAVES;
    const float* ssqkv = (const float*)(A.ws + WS_SSQKV) + (size_t)li * 8 * MT; const float* gk = as_global(A_->in[I_GKVA]) + (size_t)li * KVR;
    bf16_t* kvn = (bf16_t*)(A.ws + WS_KVN); bf16_t* kp = (bf16_t*)(A.ws + WS_KP); const f32x2* rope = (const f32x2*)(A.ws + WS_ROPE);
    const f32x4 g0 = *(const f32x4*)(gk + lane * 8), g1 = *(const f32x4*)(gk + lane * 8 + 4);
    for (int r0 = gw; r0 < MT; r0 += 3 * NGW) {
        float pq[3][8]; f32x4 av[3], bv[3]; float x1[3] = {}, x2[3] = {}; f32x2 cs[3] = {};
#pragma unroll
        for (int k = 0; k < 3; ++k) { const int r = r0 + k * NGW; if (r < MT) {
#pragma unroll
            for (int s = 0; s < 8; ++s) pq[k][s] = ssqkv[(size_t)s * MT + r];
            const float* lp = (r < MP ? A.out + O_LATP + ((size_t)li * MP + r) * KVR : A.out + O_LATS + ((size_t)li * MS + (r - MP)) * KVR) + lane * 8;
            av[k] = *(const f32x4*)lp; bv[k] = *(const f32x4*)(lp + 4);
            const float* kq = (r < MP ? A.out + O_KPEP + ((size_t)li * MP + r) * ROPE : A.out + O_KPES + ((size_t)li * MS + (r - MP)) * ROPE);
            if (lane < 32) { x1[k] = kq[lane]; x2[k] = kq[32 + lane]; cs[k] = rope[(size_t)rope_row(r) * 32 + lane]; } } }
        asm volatile("" ::: "memory");
#pragma unroll
        for (int k = 0; k < 3; ++k) { const int r = r0 + k * NGW; if (r < MT) {
            float sk = 0.f;
#pragma unroll
            for (int s = 0; s < 8; ++s) sk += pq[k][s];
            const float rs = rsqrtf(sk * (1.0f / KVR) + EPS);
            float* lp = (r < MP ? A.out + O_LATP + ((size_t)li * MP + r) * KVR : A.out + O_LATS + ((size_t)li * MS + (r - MP)) * KVR) + lane * 8;
            const f32x4 a = av[k] * rs * g0, b = bv[k] * rs * g1;
            *(f32x4*)lp = a; *(f32x4*)(lp + 4) = b;
            u32x4 o; o.x = cvt_pk_bf16(a[0], a[1]); o.y = cvt_pk_bf16(a[2], a[3]); o.z = cvt_pk_bf16(b[0], b[1]); o.w = cvt_pk_bf16(b[2], b[3]);
            *(u32x4*)(kvn + (size_t)r * KVW + lane * 8) = o;
            float* kq = (r < MP ? A.out + O_KPEP + ((size_t)li * MP + r) * ROPE : A.out + O_KPES + ((size_t)li * MS + (r - MP)) * ROPE);
            if (lane < 32) {
                const float o1 = x1[k] * cs[k].x - x2[k] * cs[k].y, o2 = x1[k] * cs[k].y + x2[k] * cs[k].x;
                kq[lane] = o1; kq[32 + lane] = o2;
                const unsigned pk = cvt_pk_bf16(o1, o2);
                *(unsigned*)(kvn + (size_t)r * KVW + KVR + 2 * lane) = pk;
                if (r < MP) {
#pragma unroll
                    for (int h = 0; h < HEADS; ++h) *(unsigned*)(kp + ((size_t)r * HEADS + h) * QKD + NOPE + 2 * lane) = pk; }
            } } }
    }
}

__device__ __forceinline__ void unpk8(const u32x4 q, float (&z)[8]) { z[0] = bf_lo(q.x); z[1] = bf_hi(q.x); z[2] = bf_lo(q.y); z[3] = bf_hi(q.y); z[4] = bf_lo(q.z); z[5] = bf_hi(q.z); z[6] = bf_lo(q.w); z[7] = bf_hi(q.w); }
template <int W, int KIND> __device__ __forceinline__ void pool_item(const bf16_t* zrow0  , const float* st  , bf16_t* prow0, int t0, bool prompt) {
    u32x4 zc[16]; u32x4 pp[KIND == 0 ? W - 1 : 1]; f32x4 sa[KIND == 2 ? W - 1 : 1], sb[KIND == 2 ? W - 1 : 1];
#pragma unroll
    for (int tt = 0; tt < 16; ++tt) zc[tt] = *(const u32x4*)(zrow0 + (size_t)tt * POOLW);
#pragma unroll
    for (int j = 1; j < W; ++j) {
        if (KIND == 0) pp[j - 1] = *(const u32x4*)(zrow0 - (size_t)j * POOLW);
        if (KIND == 2) { sa[j - 1] = *(const f32x4*)(st - (size_t)(j - 1) * POOLW); sb[j - 1] = *(const f32x4*)(st - (size_t)(j - 1) * POOLW + 4); } }
    asm volatile("" ::: "memory");
    float pz[W - 1][8];
#pragma unroll
    for (int j = 1; j < W; ++j) {
        if (KIND == 0) unpk8(pp[j - 1], pz[j - 1]);
        else if (KIND == 2) { pz[j - 1][0] = sa[j - 1][0]; pz[j - 1][1] = sa[j - 1][1]; pz[j - 1][2] = sa[j - 1][2]; pz[j - 1][3] = sa[j - 1][3]; pz[j - 1][4] = sb[j - 1][0]; pz[j - 1][5] = sb[j - 1][1]; pz[j - 1][6] = sb[j - 1][2]; pz[j - 1][7] = sb[j - 1][3]; }
        else {
#pragma unroll
            for (int e = 0; e < 8; ++e) pz[j - 1][e] = 0.f; } }
    float sum[8];
#pragma unroll
    for (int e = 0; e < 8; ++e) sum[e] = 0.f;
#pragma unroll
    for (int j = 1; j < W; ++j)
#pragma unroll
        for (int e = 0; e < 8; ++e) sum[e] += pz[j - 1][e];
#pragma unroll
    for (int tt = 0; tt < 16; ++tt) {
        float z[8], zo[8]; unpk8(zc[tt], z);
        if (tt - W + 1 >= 0) unpk8(zc[tt - W + 1 >= 0 ? tt - W + 1 : 0], zo);
        else {
#pragma unroll
            for (int e = 0; e < 8; ++e) zo[e] = pz[(W - 1 - tt >= 1 ? W - 1 - tt : 1) - 1][e]; }
        const int t = t0 + tt; const float cnt = prompt ? (float)((t + 1) < W ? (t + 1) : W) : (float)W; const float ic = 1.0f / cnt;
        float p[8];
#pragma unroll
        for (int e = 0; e < 8; ++e) { sum[e] += z[e]; p[e] = sum[e] * ic - z[e]; sum[e] -= zo[e]; }
        u32x4 o; o.x = cvt_pk_bf16(p[0], p[1]); o.y = cvt_pk_bf16(p[2], p[3]); o.z = cvt_pk_bf16(p[4], p[5]); o.w = cvt_pk_bf16(p[6], p[7]);
        *(u32x4*)(prow0 + (size_t)tt * POOLW) = o;
    }
}
template <int W> __device__ __forceinline__ void pool_item_w(const bf16_t* zrow0, const float* st, bf16_t* prow0, int t0, bool prompt) {
    if (t0 > 0) pool_item<W, 0>(zrow0, st, prow0, t0, prompt);
    else if (prompt) pool_item<W, 1>(zrow0, st, prow0, t0, prompt);
    else pool_item<W, 2>(zrow0, st, prow0, t0, prompt);
}
__device__ __forceinline__ void pool_prep_phase(const Frame& F, KArgs* A_, int li) {
    const int lane = lau_v(lane_id()); struct { unsigned char* ws; } A{lau_s(A_->ws)};
    const int gw = lau_si(F.vcu * NWAVES + F.wave), NGW = F.G * NWAVES;
    const size_t gt = (size_t)gw * 64 + lane, NGT = (size_t)NGW * 64;
    const bf16_t* zb = (const bf16_t*)(A.ws + WS_ZB); bf16_t* pb = (bf16_t*)(A.ws + WS_PB);
    const float* sp = as_global(A_->in[I_SPOOL]) + (size_t)li * DECB * POOLKEEP * POOLW;
    for (size_t it = gt; it < (size_t)(MT / 16) * 128; it += NGT) {
        const int rb = (int)(it / 128), cg = (int)(it % 128), col = cg * 8, wsel = cg >> 5;
        const int r0 = rb * 16; const bool prompt = r0 < MP;
        const int t0 = prompt ? (r0 & (SEQ - 1)) : ((r0 - MP) & (DECS - 1));
        const int bs = prompt ? 0 : (r0 - MP) >> 6;
        const bf16_t* zrow0 = zb + (size_t)r0 * POOLW + col; bf16_t* prow0 = pb + (size_t)r0 * POOLW + col;
        const float* st = sp + ((size_t)bs * POOLKEEP + (POOLKEEP - 1)) * POOLW + col;
        if (wsel == 0) pool_item_w<2>(zrow0, st, prow0, t0, prompt);
        else if (wsel == 1) pool_item_w<4>(zrow0, st, prow0, t0, prompt);
        else if (wsel == 2) pool_item_w<8>(zrow0, st, prow0, t0, prompt);
        else pool_item_w<16>(zrow0, st, prow0, t0, prompt);
    }
}
__device__ __forceinline__ u32x4 pack8(const f32x4 a, const f32x4 b) { u32x4 w; w.x = cvt_pk_bf16(a[0], a[1]); w.y = cvt_pk_bf16(a[2], a[3]); w.z = cvt_pk_bf16(b[0], b[1]); w.w = cvt_pk_bf16(b[2], b[3]); return w; }

template <int MODE> struct EpiStore {
    static constexpr bool PERM = true, PRE = false;
    unsigned char* ws;
    __device__ __forceinline__ void operator()(const f32x4 (&acc)[2][2][4][2], const pg8::Unit& u, int wr, int wc, int fr, int fq) const {
        EPI_ROWS(u); const int cl = wc * 32 + 8 * fq;
#pragma unroll
        for (int bj = 0; bj < 2; ++bj) {
            bf16_t* base; size_t ldc;
            if (MODE == 0) { if (u.pn < 4) { base = (bf16_t*)(ws + WS_KP) + (2 * u.pn + bj) * QKD; ldc = HEADS * QKD; } else { base = (bf16_t*)(ws + WS_VP) + (u.pn - 4) * 256 + bj * 128; ldc = HEADS * VD; } }
            else if (MODE == 1) { base = (bf16_t*)(ws + WS_QS) + (u.pn >> 1) * KVW + (u.pn & 1) * 256 + bj * 128; ldc = HEADS * KVW; }
            else if (MODE == 2) { base = (bf16_t*)(ws + WS_YCAT) + 1024 + u.pn * 256 + bj * 128; ldc = DM; }
            else { base = (bf16_t*)(ws + WS_YCAT) + (size_t)MP * DM + u.pn * 256 + bj * 128; ldc = DM; }
#pragma unroll
            for (int ai = 0; ai < 2; ++ai)
#pragma unroll
                for (int m = 0; m < 4; ++m) *(u32x4*)(base + (size_t)EPI_ROW(ai, m) * ldc + cl) = pack8(acc[ai][bj][m][0], acc[ai][bj][m][1]);
        }
    }
};

struct EpiQ {
    static constexpr bool PERM = true, PRE = true;
    unsigned char* ws; int li; LAS unsigned char* lds;
    __device__ __forceinline__ void pre(LAS unsigned char* l, const pg8::Unit& u, int wid) const {
        const float* src = (const float*)(ws + WS_SSQQ) + ((size_t)li * 8 + wid) * MT + u.pm * 256 + lane_id() * 4;
        __builtin_amdgcn_global_load_lds((const unsigned*)src, (LAS unsigned*)(l + EPI_LDS + u.par * 8192 + wid * 1024), 16, 0, 0);
    }
    __device__ __forceinline__ void operator()(const f32x4 (&acc)[2][2][4][2], const pg8::Unit& u, int wr, int wc, int fr, int fq) const {
        EPI_ROWS(u); const LAS float* sql = (const LAS float*)(lds + EPI_LDS + u.par * 8192) + wr * 64 + fr; const f32x4* rope = (const f32x4*)(ws + WS_ROPE);
        bf16_t* qp = (bf16_t*)(ws + WS_QP); bf16_t* qns = (bf16_t*)(ws + WS_QNS); bf16_t* qs = (bf16_t*)(ws + WS_QS);
        int hh[2], cc[2];
#pragma unroll
        for (int bj = 0; bj < 2; ++bj) { const int c = u.pn * 256 + bj * 128 + wc * 32 + 8 * fq; hh[bj] = c / QKD; cc[bj] = c - hh[bj] * QKD; }
        f32x4 T[2][2] = {}, Tn[2][2] = {};
#define EPIQ_ROPE(dst, ai_, m_) do { const int rr_ = rope_row(EPI_ROW(ai_, m_)); _Pragma("unroll") for (int bj = 0; bj < 2; ++bj) if (cc[bj] >= NOPE) { \
            const size_t ix_ = ((size_t)rr_ * 32 + ((cc[bj] - NOPE) >> 1)) >> 1; dst[bj][0] = rope[ix_]; dst[bj][1] = rope[ix_ + 1]; } } while (0)
        EPIQ_ROPE(T, 0, 0);
#pragma unroll
        for (int k = 0; k < 8; ++k) {
            const int ai = k >> 2, m = k & 3;
            if (k < 7) EPIQ_ROPE(Tn, (k + 1) >> 2, (k + 1) & 3);
            asm volatile("" ::: "memory");
            const int r = EPI_ROW(ai, m); float sk = 0.f;
#pragma unroll
            for (int s = 0; s < 8; ++s) sk += sql[s * 256 + ai * 128 + m * 16];
            const float rs = rsqrtf(sk * (1.0f / QR) + EPS);
#pragma unroll
            for (int bj = 0; bj < 2; ++bj) {
                const int h = hh[bj], c2 = cc[bj];
                f32x4 a = acc[ai][bj][m][0] * rs, b = acc[ai][bj][m][1] * rs;
                if (c2 >= NOPE) {
                    const f32x4 t0 = T[bj][0], t1 = T[bj][1];
                    f32x4 ra, rb;
                    ra[0] = a[0] * t0[0] - a[1] * t0[1]; ra[1] = a[0] * t0[1] + a[1] * t0[0]; ra[2] = a[2] * t0[2] - a[3] * t0[3]; ra[3] = a[2] * t0[3] + a[3] * t0[2];
                    rb[0] = b[0] * t1[0] - b[1] * t1[1]; rb[1] = b[0] * t1[1] + b[1] * t1[0]; rb[2] = b[2] * t1[2] - b[3] * t1[3]; rb[3] = b[2] * t1[3] + b[3] * t1[2];
                    a = ra; b = rb;
                }
                const u32x4 w = pack8(a, b);
                if (r < MP) *(u32x4*)(qp + ((size_t)r * HEADS + h) * QKD + c2) = w;
                else if (c2 < NOPE) *(u32x4*)(qns + (size_t)(r - MP) * 1024 + h * NOPE + c2) = w;
                else *(u32x4*)(qs + ((size_t)(r - MP) * HEADS + h) * KVW + KVR + (c2 - NOPE)) = w;
            }
#pragma unroll
            for (int bj = 0; bj < 2; ++bj) { T[bj][0] = Tn[bj][0]; T[bj][1] = Tn[bj][1]; }
        }
#undef EPIQ_ROPE
    }
};

template <int NM> struct EpiRes {
    static constexpr bool PERM = true, PRE = false;
    unsigned char* ws; const float* xp; const float* xs; int first; int nidx;
    __device__ __forceinline__ void operator()(const f32x4 (&acc)[2][2][NM][2], const pg8::Unit& u, int wr, int wc, int fr, int fq) const {
        { const int _l = lane_id(); fr = _l & 15; fq = _l >> 4; } const int row0 = u.pm * (64 * NM) + wr * (16 * NM) + fr;
        const int c0 = u.pn * 256 + wc * 32 + 8 * fq; bf16_t* XB = (bf16_t*)(ws + WS_XB); float* ssq = (float*)(ws + WS_SSQP) + (size_t)(nidx * 32 + u.pn * 4 + wc) * MT;
        u32x4 q[2][NM][2];
        if (!first) {
#pragma unroll
            for (int ai = 0; ai < 2; ++ai)
#pragma unroll
                for (int m = 0; m < NM; ++m)
#pragma unroll
                    for (int bj = 0; bj < 2; ++bj) q[ai][m][bj] = *(const u32x4*)(XB + (size_t)(row0 + ai * (32 * NM) + m * 16) * DM + c0 + bj * 128);
            asm volatile("" ::: "memory");
        }
        float sqv[2][NM];
#pragma unroll
        for (int ai = 0; ai < 2; ++ai)
#pragma unroll
            for (int m = 0; m < NM; ++m) {
                const int r = row0 + ai * (32 * NM) + m * 16; float sq = 0.f;
#pragma unroll
                for (int bj = 0; bj < 2; ++bj) { const int c = c0 + bj * 128; f32x4 a, b;
                    if (first) { const float* xo = (r < MP ? xp + (size_t)r * DM : xs + (size_t)(r - MP) * DM) + c; a = *(const f32x4*)xo; b = *(const f32x4*)(xo + 4); }
                    else { const u32x4 w = q[ai][m][bj]; a = (f32x4){bf_lo(w.x), bf_hi(w.x), bf_lo(w.y), bf_hi(w.y)}; b = (f32x4){bf_lo(w.z), bf_hi(w.z), bf_lo(w.w), bf_hi(w.w)}; }
                    a = a + acc[ai][bj][m][0]; b = b + acc[ai][bj][m][1];
                    *(u32x4*)(XB + (size_t)r * DM + c) = pack8(a, b);
                    sq += ((a[0] * a[0] + a[1] * a[1]) + (a[2] * a[2] + a[3] * a[3])) + ((b[0] * b[0] + b[1] * b[1]) + (b[2] * b[2] + b[3] * b[3])); }
                sqv[ai][m] = sq;
            }
#pragma unroll
        for (int ai = 0; ai < 2; ++ai)
#pragma unroll
            for (int m = 0; m < NM; ++m) { const float sq = row4_sum(sqv[ai][m]); if (fq == 0) ssq[row0 + ai * (32 * NM) + m * 16] = sq; }
    }
};

__device__ __forceinline__ float dpp_ror1(float x) { return __builtin_bit_cast(float, __builtin_amdgcn_update_dpp(0, __builtin_bit_cast(int, x), 0x121, 0xf, 0xf, true)); }
__device__ __forceinline__ float dpp_ror2(float x) { return __builtin_bit_cast(float, __builtin_amdgcn_update_dpp(0, __builtin_bit_cast(int, x), 0x122, 0xf, 0xf, true)); }
struct EpiUp {
    static constexpr bool PERM = true, PRE = true;
    unsigned char* ws; float* out; const float* cw; const float* cb; const float* past; LAS unsigned char* lds; int layer;
    __device__ __forceinline__ void pre(LAS unsigned char* l, const pg8::Unit& u, int wid) const {
        const int lane = lane_id();
        if (wid < 4) { const int seg = 2 * wid + (lane >> 5), bj = seg & 1; const float* src = (seg < 6 ? cw + (size_t)(seg >> 1) * DFF2 : cb) + bj * DFF + u.pn * 128 + (lane & 31) * 4;
            __builtin_amdgcn_global_load_lds((const unsigned*)src, (LAS unsigned*)(l + EPI_CW + u.par * 4096 + wid * 1024), 16, 0, 0); }
        else if (wid == 4) { const float* src = (const float*)(ws + WS_RSTD) + (size_t)(2 * layer + 1) * MT + u.pm * 256 + lane * 4;
            __builtin_amdgcn_global_load_lds((const unsigned*)src, (LAS unsigned*)(l + EPI_RS + u.par * 1024), 16, 0, 0); }
    }
    __device__ __forceinline__ void operator()(const f32x4 (&acc_)[2][2][4][2], const pg8::Unit& u, int wr, int wc, int fr, int fq) const {
        f32x4 (&acc)[2][2][4][2] = const_cast<f32x4 (&)[2][2][4][2]>(acc_);
        EPI_ROWS(u); const LAS float* rsl = (const LAS float*)(lds + EPI_RS + u.par * 1024) + wr * 64 + fr; const LAS float* cwl = (const LAS float*)(lds + EPI_CW + u.par * 4096) + wc * 32 + 8 * fq; bf16_t* act = (bf16_t*)(ws + WS_ACT); float* halo = (float*)(ws + WS_HALO) + (size_t)u.pm * 4 * DFF2;
        const int ch = u.pn * 128 + wc * 32 + 8 * fq;
        const bool prompt = u.pm < MP / 256;
        LAS float* hl = (LAS float*)(lds + EPI_LDS);
#pragma unroll
        for (int ai = 0; ai < 2; ++ai)
#pragma unroll
            for (int m = 0; m < 4; ++m) {
                const int r = EPI_ROW(ai, m); const float rs = rsl[ai * 128 + m * 16];
#pragma unroll
                for (int bj = 0; bj < 2; ++bj) { acc[ai][bj][m][0] = acc[ai][bj][m][0] * rs; acc[ai][bj][m][1] = acc[ai][bj][m][1] * rs; }
                float* so = nullptr;
                if (prompt) { const int t = r & (SEQ - 1); if (t >= SEQ - 2) so = out + O_CVP + (((size_t)layer * BATCH + (r >> 11)) * 2 + (t - (SEQ - 2))) * DFF2; }
                else { const int rr = r - MP, t = rr & (DECS - 1); if (t >= DECS - 2) so = out + O_CVS + (((size_t)layer * DECB + (rr >> 6)) * 2 + (t - (DECS - 2))) * DFF2; }
                if (so) {
#pragma unroll
                    for (int bj = 0; bj < 2; ++bj) { *(f32x4*)(so + bj * DFF + ch) = acc[ai][bj][m][0]; *(f32x4*)(so + bj * DFF + ch + 4) = acc[ai][bj][m][1]; } }
                if (m == 3 && fr >= 14) {
#pragma unroll
                    for (int bj = 0; bj < 2; ++bj) { LAS float* d = hl + ((((ai * 2 + wr) * 4 + wc) * 2 + (fr - 14)) * 4 + fq) * 16 + bj * 8; *(LAS f32x4*)d = acc[ai][bj][m][0]; *(LAS f32x4*)(d + 4) = acc[ai][bj][m][1]; } }
                if (prompt) { int sel = -1; if (ai == 0 && wr == 0 && m == 0 && fr < 2) sel = fr; if (ai == 1 && wr == 1 && m == 3 && fr >= 14) sel = fr - 12;
                    if (sel >= 0) {
#pragma unroll
                        for (int bj = 0; bj < 2; ++bj) { float* d = halo + (size_t)sel * DFF2 + bj * DFF + ch; *(f32x4*)d = acc[ai][bj][m][0]; *(f32x4*)(d + 4) = acc[ai][bj][m][1]; } } }
            }
        asm volatile("s_waitcnt lgkmcnt(0)" ::: "memory"); __builtin_amdgcn_s_barrier(); asm volatile("" ::: "memory");
#pragma unroll
        for (int ai = 0; ai < 2; ++ai) {
            const int blk0 = u.pm * 256 + ai * 128 + wr * 64;
#pragma unroll
            for (int eh = 0; eh < 2; ++eh) {
                f32x4 w[2][3], bia[2], hm1[2], hm2[2];
#pragma unroll
                for (int bj = 0; bj < 2; ++bj) {
                    const int cc = bj * DFF + ch + 4 * eh;
#pragma unroll
                    for (int j = 0; j < 3; ++j) w[bj][j] = *(const LAS f32x4*)(cwl + (2 * j + bj) * 128 + 4 * eh);
                    bia[bj] = *(const LAS f32x4*)(cwl + (6 + bj) * 128 + 4 * eh);
                    if (!prompt) { const float* ps = past + (size_t)((blk0 - MP) >> 6) * 2 * DFF2 + cc; hm2[bj] = *(const f32x4*)ps; hm1[bj] = *(const f32x4*)(ps + DFF2); }
                    else if (ai == 0 && wr == 0) { hm1[bj] = (f32x4){0.f, 0.f, 0.f, 0.f}; hm2[bj] = hm1[bj]; }
                    else { const int pb = ai * 2 + wr - 1; const LAS float* s = hl + (((pb * 4 + wc) * 2 + 0) * 4 + fq) * 16 + bj * 8 + 4 * eh; hm2[bj] = *(const LAS f32x4*)s; hm1[bj] = *(const LAS f32x4*)(s + 64); }
                }
                u32x2 pk[4]; f32x4 pr1[2], pr2[2];
#pragma unroll
                for (int bj = 0; bj < 2; ++bj)
#pragma unroll
                    for (int e = 0; e < 4; ++e) { pr1[bj][e] = hm1[bj][e]; pr2[bj][e] = (fr == 0) ? hm2[bj][e] : hm1[bj][e]; }
#pragma unroll
                for (int m = 0; m < 4; ++m) {
                    f32x4 c[2];
#pragma unroll
                    for (int bj = 0; bj < 2; ++bj) {
                        const f32x4 h0 = acc[ai][bj][m][eh]; f32x4 p1, p2;
#pragma unroll
                        for (int e = 0; e < 4; ++e) {
                            const float r1 = dpp_ror1(h0[e]), r2 = dpp_ror2(h0[e]);
                            p1[e] = (fr >= 1) ? r1 : pr1[bj][e]; p2[e] = (fr >= 2) ? r2 : pr2[bj][e];
                            pr1[bj][e] = r1; pr2[bj][e] = r2;
                        }
                        c[bj] = bia[bj] + w[bj][0] * p2 + w[bj][1] * p1 + w[bj][2] * h0;
                    }
                    f32x4 o;
#pragma unroll
                    for (int e = 0; e < 4; ++e) o[e] = silu_f(c[0][e]) * c[1][e];
                    pk[m].x = cvt_pk_bf16(o[0], o[1]); pk[m].y = cvt_pk_bf16(o[2], o[3]);
                }
#pragma unroll
                for (int m = 0; m < 4; ++m) *(u32x2*)(act + (size_t)(blk0 + 16 * m + fr) * DFF + ch + 4 * eh) = pk[m];
            }
        }
    }
};

struct EpiInC {
    static constexpr bool PERM = true, PRE = true;
    unsigned char* ws; int layer; LAS unsigned char* lds;
    __device__ __forceinline__ void pre(LAS unsigned char* l, const pg8::Unit& u, int wid) const {
        if (wid == 4) { const float* src = (const float*)(ws + WS_RSTD) + (size_t)(2 * layer) * MT + u.pm * 256 + lane_id() * 4;
            __builtin_amdgcn_global_load_lds((const unsigned*)src, (LAS unsigned*)(l + EPI_RS + u.par * 1024), 16, 0, 0); }
    }
    __device__ __forceinline__ void operator()(const f32x4 (&acc)[2][2][4][2], const pg8::Unit& u, int wr, int wc, int fr, int fq) const {
        EPI_ROWS(u); const LAS float* rsl = (const LAS float*)(lds + EPI_RS + u.par * 1024) + wr * 64 + fr; const int sec = u.pn >> 3, c0 = (u.pn & 7) * 256 + wc * 32 + 8 * fq;
        const float* lbs = (const float*)(ws + WS_LBS) + (layer >> 1) * 2048;
        f32x4 lb[2][2] = {};
        if (sec == 1) {
#pragma unroll
            for (int bj = 0; bj < 2; ++bj) { lb[bj][0] = *(const f32x4*)(lbs + c0 + bj * 128); lb[bj][1] = *(const f32x4*)(lbs + c0 + bj * 128 + 4); }
            asm volatile("" ::: "memory"); }
#pragma unroll
        for (int ai = 0; ai < 2; ++ai)
#pragma unroll
            for (int m = 0; m < 4; ++m) {
                const int r = EPI_ROW(ai, m); const float rs = rsl[ai * 128 + m * 16];
#pragma unroll
                for (int bj = 0; bj < 2; ++bj) { f32x4 a = acc[ai][bj][m][0] * rs, b = acc[ai][bj][m][1] * rs; const int c = c0 + bj * 128;
                    if (sec == 1) { const f32x4 l0 = lb[bj][0], l1 = lb[bj][1];
#pragma unroll
                        for (int e = 0; e < 4; ++e) { a[e] = (1.0f - l0[e]) * sigmoid_f(-a[e]); b[e] = (1.0f - l1[e]) * sigmoid_f(-b[e]); }
                        bf16_t* o = (bf16_t*)(ws + WS_FG) + (size_t)r * 2048 + c; *(u32x4*)o = pack8(a, b); }
                    else { if (sec != 2) {
#pragma unroll
                            for (int e = 0; e < 4; ++e) { a[e] = silu_f(a[e]); b[e] = silu_f(b[e]); } }
                        bf16_t* o = (bf16_t*)(ws + (sec == 0 ? WS_QSIL : sec == 2 ? WS_VB : WS_GS)) + (size_t)r * 2048 + c; *(u32x4*)o = pack8(a, b); }
                }
            }
    }
};

__device__ __forceinline__ void act_fix_phase(const Frame& F, KArgs* A_, int layer) {
    const int lane = lau_v(lane_id()); unsigned char* ws = lau_s(A_->ws);
    const int gw = lau_si(F.vcu * NWAVES + F.wave), NGW = F.G * NWAVES;
    const size_t gt = (size_t)gw * 64 + lane, NGT = (size_t)NGW * 64;
    const float* halo = (const float*)(ws + WS_HALO); bf16_t* act = (bf16_t*)(ws + WS_ACT);
    const float* cw = as_global(A_->in[I_CONVW]) + (size_t)layer * 3 * DFF2; const float* cbias = as_global(A_->in[I_CONVB]) + (size_t)layer * DFF2;
    constexpr int NT = MP / 256, CG = DFF / 4;
    for (size_t it = gt; it < (size_t)NT * 2 * CG; it += NGT) {
        const int pm = (int)(it / (2 * CG)), rem = (int)(it % (2 * CG)), i = rem / CG, col = (rem % CG) * 4;
        if ((pm & 7) == 0) continue;
        const float* H = halo + (size_t)pm * 4 * DFF2; const float* Hp = H - (size_t)4 * DFF2;
        const float* h0p = H + (size_t)i * DFF2; const float* h1p = i == 0 ? Hp + (size_t)3 * DFF2 : H; const float* h2p = i == 0 ? Hp + (size_t)2 * DFF2 : Hp + (size_t)3 * DFF2;
        f32x4 c[2];
#pragma unroll
        for (int s = 0; s < 2; ++s) { const int cc = s * DFF + col;
            c[s] = *(const f32x4*)(cbias + cc) + *(const f32x4*)(cw + cc) * *(const f32x4*)(h2p + cc) + *(const f32x4*)(cw + DFF2 + cc) * *(const f32x4*)(h1p + cc) + *(const f32x4*)(cw + 2 * DFF2 + cc) * *(const f32x4*)(h0p + cc); }
        u32x2 pk; pk.x = cvt_pk_bf16(silu_f(c[0][0]) * c[1][0], silu_f(c[0][1]) * c[1][1]); pk.y = cvt_pk_bf16(silu_f(c[0][2]) * c[1][2], silu_f(c[0][3]) * c[1][3]);
        *(u32x2*)(act + (size_t)(pm * 256 + i) * DFF + col) = pk;
    }
}

__device__ __forceinline__ void final_phase(const Frame& F, KArgs* A_) {
    const int lane = lau_v(lane_id()); unsigned char* ws = lau_s(A_->ws); float* out = lau_s(A_->out);
    const int gw = lau_si(F.vcu * NWAVES + F.wave), NGW = F.G * NWAVES;
    const float* rstd = (const float*)(ws + WS_RSTD) + 8 * MT; const bf16_t* XB = (const bf16_t*)(ws + WS_XB); const float* g = as_global(A_->in[I_GFINAL]);
    f32x4 gg[4][2];
#pragma unroll
    for (int j = 0; j < 4; ++j) { const int c = (64 * j + lane) * 8; gg[j][0] = *(const f32x4*)(g + c); gg[j][1] = *(const f32x4*)(g + c + 4); }
    for (int r0 = gw; r0 < MT; r0 += 3 * NGW) {
        u32x4 q[3][4]; float rs[3] = {};
#pragma unroll
        for (int k = 0; k < 3; ++k) { const int r = r0 + k * NGW; if (r < MT) { rs[k] = rstd[r];
#pragma unroll
            for (int j = 0; j < 4; ++j) q[k][j] = *(const u32x4*)(XB + (size_t)r * DM + (64 * j + lane) * 8); } }
        asm volatile("" ::: "memory");
#pragma unroll
        for (int k = 0; k < 3; ++k) { const int r = r0 + k * NGW; if (r < MT) {
#pragma unroll
            for (int j = 0; j < 4; ++j) { const int c = (64 * j + lane) * 8; const u32x4 w = q[k][j];
                const f32x4 a = (f32x4){bf_lo(w.x), bf_hi(w.x), bf_lo(w.y), bf_hi(w.y)} * rs[k] * gg[j][0], b = (f32x4){bf_lo(w.z), bf_hi(w.z), bf_lo(w.w), bf_hi(w.w)} * rs[k] * gg[j][1];
                *(f32x4*)(out + (size_t)r * DM + c) = a; *(f32x4*)(out + (size_t)r * DM + c + 4) = b; } } }
    }
}

__device__ __forceinline__ void rstd_phase(const Frame& F, KArgs* A_, int nidx) {
    const int lane = lau_v(lane_id()); unsigned char* ws = lau_s(A_->ws);
    const int gw = lau_si(F.vcu * NWAVES + F.wave), NGW = F.G * NWAVES;
    const float* part = (const float*)(ws + WS_SSQP) + (size_t)nidx * 32 * MT; float* rstd = (float*)(ws + WS_RSTD) + (size_t)nidx * MT;
    for (int r = gw * 64 + lane; r < MT; r += NGW * 64) { float s = 0.f;
#pragma unroll 8
        for (int k = 0; k < 32; ++k) s += part[(size_t)k * MT + r];
        rstd[r] = rsqrtf(s * (1.0f / DM) + EPS); }
}
constexpr float MLA_SCALE = 0.07216878364870322f;

template <bool SAMPLE>
__device__ __forceinline__ void naive_attn_phase(const Frame& F, KArgs* A_, int li) {
    constexpr int DQ = SAMPLE ? KVW : QKD, DV = SAMPLE ? KVR : VD, NKMAX = SAMPLE ? PAST + DECS : SEQ, EV = DV / 64;
    const int lane = lau_v(lane_id()); unsigned char* ws = lau_s(A_->ws);
    const int gw = lau_si(F.vcu * NWAVES + F.wave), NGW = F.G * NWAVES;
    LAS float* qf = (LAS float*)(F.lds + F.wave * ((DQ + NKMAX) * 4)); LAS float* sc = qf + DQ;
    const int nitems = (SAMPLE ? MS : MP) * HEADS;
    for (int it = gw; it < nitems; it += NGW) {
        const int r = it >> 3, h = it & 7;
        const bf16_t* qrow; int nk, b;
        if (SAMPLE) { qrow = (const bf16_t*)(ws + WS_QS) + ((size_t)r * HEADS + h) * KVW; nk = PAST + DECS; b = r >> 6; }
        else { qrow = (const bf16_t*)(ws + WS_QP) + ((size_t)r * HEADS + h) * QKD; const int t = r & (SEQ - 1); nk = ((t >> 6) + 1) * 64; b = r >> 11; }
        for (int d = lane; d < DQ; d += 64) qf[d] = __uint_as_float(((unsigned)qrow[d]) << 16);
        LDS_WAIT(); asm volatile("" ::: "memory");
        auto krow = [&](int k) -> const bf16_t* {
            if (SAMPLE) return k < PAST ? (const bf16_t*)(ws + WS_KVC) + (((size_t)li * DECB + b) * PAST + k) * KVW : (const bf16_t*)(ws + WS_KVN) + ((size_t)MP + (size_t)b * DECS + (k - PAST)) * KVW;
            return (const bf16_t*)(ws + WS_KP) + (((size_t)b * SEQ + k) * HEADS + h) * QKD; };
        float mx = -3.0e38f;
        for (int k = lane; k < nk; k += 64) {
            const bf16_t* kr = krow(k); float dot = 0.f;
#pragma unroll 4
            for (int c = 0; c < DQ / 8; ++c) { const u32x4 w = *(const u32x4*)(kr + c * 8); const f32x4 q0 = *(const LAS f32x4*)(qf + c * 8), q1 = *(const LAS f32x4*)(qf + c * 8 + 4);
                dot += bf_lo(w.x) * q0[0] + bf_hi(w.x) * q0[1] + bf_lo(w.y) * q0[2] + bf_hi(w.y) * q0[3] + bf_lo(w.z) * q1[0] + bf_hi(w.z) * q1[1] + bf_lo(w.w) * q1[2] + bf_hi(w.w) * q1[3]; }
            dot *= MLA_SCALE; sc[k] = dot; mx = fmaxf(mx, dot);
        }
#pragma unroll
        for (int o = 1; o < 64; o <<= 1) mx = fmaxf(mx, __shfl_xor(mx, o));
        float sum = 0.f;
        for (int k = lane; k < nk; k += 64) { const float p = __expf(sc[k] - mx); sc[k] = p; sum += p; }
        sum = wave_sum(sum);
        LDS_WAIT(); asm volatile("" ::: "memory");
        float o[EV];
#pragma unroll
        for (int e = 0; e < EV; ++e) o[e] = 0.f;
        for (int k = 0; k < nk; ++k) {
            const float p = sc[k];
            const bf16_t* vr = SAMPLE ? krow(k) : (const bf16_t*)(ws + WS_VP) + (((size_t)b * SEQ + k) * HEADS + h) * VD;
            if constexpr (!SAMPLE) { const unsigned w = *(const unsigned*)(vr + lane * 2); o[0] += p * bf_lo(w); o[1] += p * bf_hi(w); }
            else { const u32x4 w = *(const u32x4*)(vr + lane * 8); o[0] += p * bf_lo(w.x); o[1] += p * bf_hi(w.x); o[2] += p * bf_lo(w.y); o[3] += p * bf_hi(w.y);
                o[4] += p * bf_lo(w.z); o[5] += p * bf_hi(w.z); o[6] += p * bf_lo(w.w); o[7] += p * bf_hi(w.w); }
        }
        const float inv = 1.0f / sum;
        if constexpr (!SAMPLE) *(unsigned*)((bf16_t*)(ws + WS_YCAT) + (size_t)r * DM + h * VD + lane * 2) = cvt_pk_bf16(o[0] * inv, o[1] * inv);
        else { u32x4 w; w.x = cvt_pk_bf16(o[0] * inv, o[1] * inv); w.y = cvt_pk_bf16(o[2] * inv, o[3] * inv); w.z = cvt_pk_bf16(o[4] * inv, o[5] * inv); w.w = cvt_pk_bf16(o[6] * inv, o[7] * inv);
            *(u32x4*)((bf16_t*)(ws + WS_OLAT) + ((size_t)r * HEADS + h) * KVR + lane * 8) = w; }
        LDS_WAIT(); asm volatile("" ::: "memory");
    }
}

__device__ __forceinline__ void naive_gla_phase(const Frame& F, KArgs* A_, int li) {
    const int lane = lau_v(lane_id()), wave = F.wave, tid = wave * 64 + lane; unsigned char* ws = lau_s(A_->ws); float* out = lau_s(A_->out);
    LAS float* fL = (LAS float*)F.lds;
    LAS float* qL = fL + 16 * 128;
    LAS float* vL = qL + 16 * 128;
    LAS float* oL = vL + 16 * 128;
    const float* FG = (const float*)(ws + WS_FG); const bf16_t* QS = (const bf16_t*)(ws + WS_QSIL); const bf16_t* VB = (const bf16_t*)(ws + WS_VB); const bf16_t* GS = (const bf16_t*)(ws + WS_GS);
    bf16_t* yc = (bf16_t*)(ws + WS_YCAT); const float* gon = as_global(A_->in[I_GONORM]) + (size_t)li * HI;
    const int col = tid & 127, kg = tid >> 7;
    const int nitems = (BATCH + DECB) * CHD;
    for (int it = F.vcu; it < nitems; it += F.G) {
        const bool prompt = it < BATCH * CHD; const int sq = prompt ? it / CHD : (it - BATCH * CHD) / CHD, h = it % CHD;
        const int row0 = prompt ? sq * SEQ : MP + sq * DECS, L = prompt ? SEQ : DECS;
        float S[32];
        float* so = prompt ? out + O_HGP + ((((size_t)li * BATCH + sq) * CHD + h) * HF) * HI : out + O_HGS + ((((size_t)li * DECB + sq) * CHD + h) * HF) * HI;
        if (prompt) {
#pragma unroll
            for (int i = 0; i < 32; ++i) S[i] = 0.f; }
        else { const float* s0 = as_global(A_->in[I_SHGRN]) + ((((size_t)li * DECB + sq) * CHD + h) * HF) * HI;
#pragma unroll
            for (int i = 0; i < 32; ++i) S[i] = s0[(size_t)(kg * 32 + i) * HI + col]; }
        for (int c0 = 0; c0 < L; c0 += 16) {
            __syncthreads();
            for (int e = tid; e < 16 * 128; e += 512) { const int tt = e >> 7, k = e & 127; const size_t g = (size_t)(row0 + c0 + tt) * 2048 + h * 128 + k;
                fL[e] = FG[g]; qL[e] = __uint_as_float(((unsigned)QS[g]) << 16); vL[e] = __uint_as_float(((unsigned)VB[g]) << 16); }
            __syncthreads();
            for (int tt = 0; tt < 16; ++tt) {
                const float v = vL[tt * 128 + col]; float acc = 0.f;
#pragma unroll
                for (int i4 = 0; i4 < 8; ++i4) { const f32x4 f4 = *(const LAS f32x4*)(fL + tt * 128 + kg * 32 + i4 * 4), q4 = *(const LAS f32x4*)(qL + tt * 128 + kg * 32 + i4 * 4);
#pragma unroll
                    for (int e = 0; e < 4; ++e) { const float f = f4[e]; S[i4 * 4 + e] = fmaxf(f, 1e-30f) * S[i4 * 4 + e] + (1.0f - f) * v; acc += q4[e] * S[i4 * 4 + e]; } }
                oL[(tt * 4 + kg) * 128 + col] = acc;
            }
            __syncthreads();
            for (int tt = wave; tt < 16; tt += 8) {
                const int r = row0 + c0 + tt; float o0 = 0.f, o1 = 0.f;
#pragma unroll
                for (int g = 0; g < 4; ++g) { const f32x2 p = *(const LAS f32x2*)(oL + (tt * 4 + g) * 128 + lane * 2); o0 += p.x; o1 += p.y; }
                const float ms = wave_sum(o0 * o0 + o1 * o1) * (1.0f / HI), rs = rsqrtf(ms + EPS);
                const unsigned gw2 = *(const unsigned*)(GS + (size_t)r * 2048 + h * 128 + lane * 2); const f32x2 gn = *(const f32x2*)(gon + lane * 2);
                *(unsigned*)(yc + (size_t)r * DM + h * 128 + lane * 2) = cvt_pk_bf16(o0 * rs * gn.x * bf_lo(gw2), o1 * rs * gn.y * bf_hi(gw2));
            }
        }
#pragma unroll
        for (int i = 0; i < 32; ++i) so[(size_t)(kg * 32 + i) * HI + col] = S[i];
    }
}
namespace attnp {
constexpr int NW = 8, QBLK = 32, KVBLK = 64, DQK = QKD, DVV = VD, ND0 = DQK / 16;
constexpr int LDQ = HEADS * QKD, LDKK = HEADS * QKD, LDV = HEADS * VD, LDO = DM;
constexpr size_t SHM_V = KVBLK * DVV * 2, SHM_K = KVBLK * DQK * 2;
constexpr size_t SHM_ATTN = 2 * SHM_V + 2 * SHM_K + NW * 64 * 4;
constexpr float C_EXP = MLA_SCALE * 1.4426950408889634f;
constexpr float THR = 8.f;
#define AP_KSWZ(row, colB) ((row) * 384 + ((colB) ^ ((((row) >> 1) & 7) << 4)))
#define AP_SBAR() __builtin_amdgcn_sched_barrier(0)
__device__ __forceinline__ int crow(int r, int hi) { return (r & 3) + 8 * (r >> 2) + 4 * hi; }

__device__ __forceinline__ void partialSM(f32x16& p0, f32x16& p1, float& m_reg, float& mn, float& alpha) {
  float pmax = p0[0];
#pragma unroll
  for (int r = 1; r < 16; ++r) pmax = fmaxf(pmax, p0[r]);
#pragma unroll
  for (int r = 0; r < 16; ++r) pmax = fmaxf(pmax, p1[r]);
  { auto rr = __builtin_amdgcn_permlane32_swap(__float_as_uint(pmax), __float_as_uint(pmax), false, false);
    pmax = fmaxf(__uint_as_float(rr[0]), __uint_as_float(rr[1])); }
  if (__builtin_expect(__all(pmax - m_reg <= THR / MLA_SCALE), 1)) { mn = m_reg; alpha = 1.f; }
  else { mn = fmaxf(m_reg, pmax); alpha = __builtin_amdgcn_exp2f((m_reg - mn) * C_EXP); m_reg = mn; }
  const float mnC = -mn * C_EXP;
#pragma unroll
  for (int r = 0; r < 16; ++r) p0[r] = fmaf(p0[r], C_EXP, mnC);
#pragma unroll
  for (int r = 0; r < 16; ++r) p1[r] = fmaf(p1[r], C_EXP, mnC);
#pragma unroll
  for (int r = 0; r < 16; ++r) p0[r] = __builtin_amdgcn_exp2f(p0[r]);
}
__device__ __forceinline__ void finishSM(f32x16& p0, f32x16& p1, float alpha, float& l_reg, bf16x8& pa0, bf16x8& pa1, bf16x8& pa2, bf16x8& pa3) {
#pragma unroll
  for (int r = 0; r < 16; ++r) p1[r] = __builtin_amdgcn_exp2f(p1[r]);
  float ps = 0;
#pragma unroll
  for (int r = 0; r < 16; ++r) ps += p0[r];
#pragma unroll
  for (int r = 0; r < 16; ++r) ps += p1[r];
  { auto rr = __builtin_amdgcn_permlane32_swap(__float_as_uint(ps), __float_as_uint(ps), false, false);
    ps = __uint_as_float(rr[0]) + __uint_as_float(rr[1]); }
  l_reg = l_reg * alpha + ps;
#define AP_PK4(P, BASE, OUT) do { unsigned a0 = cvt_pk_bf16(P[BASE + 0], P[BASE + 1]), a1 = cvt_pk_bf16(P[BASE + 2], P[BASE + 3]);   \
    unsigned b0 = cvt_pk_bf16(P[BASE + 4], P[BASE + 5]), b1 = cvt_pk_bf16(P[BASE + 6], P[BASE + 7]);                              \
    auto r0 = __builtin_amdgcn_permlane32_swap(a0, b0, false, false); auto r1 = __builtin_amdgcn_permlane32_swap(a1, b1, false, false); \
    u32x4 w = {r0[0], r1[0], r0[1], r1[1]}; OUT = *reinterpret_cast<bf16x8*>(&w); } while (0)
  AP_PK4(p0, 0, pa0); AP_PK4(p0, 8, pa1); AP_PK4(p1, 0, pa2); AP_PK4(p1, 8, pa3);
#undef AP_PK4
}
__device__ __forceinline__ void qkt(f32x16& p0, f32x16& p1, const char* Ks, const bf16x8* qr, const int (&kb)[4]) {
  p0 = f32x16{}; p1 = f32x16{};
  bf16x8 kf[3][2];
#define QK_LD(set_, d_) do { kf[set_][0] = *reinterpret_cast<const bf16x8*>(Ks + kb[(d_) & 3] + ((d_) >> 2) * 128); kf[set_][1] = *reinterpret_cast<const bf16x8*>(Ks + kb[(d_) & 3] + ((d_) >> 2) * 128 + 32 * 384); } while (0)
  QK_LD(0, 0); QK_LD(1, 1);
#pragma unroll
  for (int d0 = 0; d0 < ND0; ++d0) {
    if (d0 + 2 < ND0) QK_LD((d0 + 2) % 3, d0 + 2);
    __builtin_amdgcn_sched_barrier(0);
    p0 = __builtin_amdgcn_mfma_f32_32x32x16_bf16(kf[d0 % 3][0], qr[d0], p0, 0, 0, 0);
    p1 = __builtin_amdgcn_mfma_f32_32x32x16_bf16(kf[d0 % 3][1], qr[d0], p1, 0, 0, 0);
    __builtin_amdgcn_sched_barrier(0); }
#undef QK_LD
}
__device__ __forceinline__ int v_st(int k, int c) { const int kk = (k & ~0xC) | ((k & 4) << 1) | ((k & 8) >> 1); return ((kk >> 3) * 4 + (c >> 5)) * 512 + ((kk & 7) * 32 + (c & 31)) * 2; }
__device__ __forceinline__ int v_rd_base(int lane) { return ((lane & 3) << 3) | (((lane >> 2) & 3) << 6) | (((lane >> 4) & 1) << 5) | (((lane >> 5) & 1) << 8); }
constexpr int v_rd_off(int d0, int ks, int half) { return d0 * 512 + ks * 4096 + half * 2048; }
template <int OFF> __device__ __forceinline__ s16x4 tr_read(int vb) {
  s16x4 r; asm volatile("ds_read_b64_tr_b16 %0, %1 offset:%2" : "=&v"(r) : "v"(vb), "i"(OFF) : "memory"); return r;
}
template <int D0> __device__ __forceinline__ void pv_one(f32x16& od, int vb, bf16x8 pa0, bf16x8 pa1, bf16x8 pa2, bf16x8 pa3) {
  const s16x4 l0 = tr_read<v_rd_off(D0, 0, 0)>(vb), h0 = tr_read<v_rd_off(D0, 0, 1)>(vb), l1 = tr_read<v_rd_off(D0, 1, 0)>(vb), h1 = tr_read<v_rd_off(D0, 1, 1)>(vb);
  const s16x4 l2 = tr_read<v_rd_off(D0, 2, 0)>(vb), h2 = tr_read<v_rd_off(D0, 2, 1)>(vb), l3 = tr_read<v_rd_off(D0, 3, 0)>(vb), h3 = tr_read<v_rd_off(D0, 3, 1)>(vb);
  asm volatile("s_waitcnt lgkmcnt(0)" ::: "memory"); AP_SBAR();
#define AP_PK(L, H) (bf16x8){L[0], L[1], L[2], L[3], H[0], H[1], H[2], H[3]}
  od = __builtin_amdgcn_mfma_f32_32x32x16_bf16(pa0, AP_PK(l0, h0), od, 0, 0, 0);
  od = __builtin_amdgcn_mfma_f32_32x32x16_bf16(pa1, AP_PK(l1, h1), od, 0, 0, 0);
  od = __builtin_amdgcn_mfma_f32_32x32x16_bf16(pa2, AP_PK(l2, h2), od, 0, 0, 0);
  od = __builtin_amdgcn_mfma_f32_32x32x16_bf16(pa3, AP_PK(l3, h3), od, 0, 0, 0);
#undef AP_PK
}
__device__ __forceinline__ void pv_d0(f32x16* o, int vb, bf16x8 pa0, bf16x8 pa1, bf16x8 pa2, bf16x8 pa3) {
  pv_one<0>(o[0], vb, pa0, pa1, pa2, pa3); pv_one<1>(o[1], vb, pa0, pa1, pa2, pa3); pv_one<2>(o[2], vb, pa0, pa1, pa2, pa3); pv_one<3>(o[3], vb, pa0, pa1, pa2, pa3);
}

__device__ __forceinline__ void unit(const bf16_t* __restrict__ Qb, const bf16_t* __restrict__ Kh, const bf16_t* __restrict__ Vh, bf16_t* __restrict__ Ob, int qt, char* lds, int wid, int lane) {
  const int tid = wid * 64 + lane, r32 = lane & 31, hi = lane >> 5;
  char* V_lds = lds; char* K_lds = lds + 2 * SHM_V;
  float* wsf = (float*)(lds + 2 * SHM_V + 2 * SHM_K) + wid * 64; float* li_l = wsf; float* al_l = wsf + 32;
  float m_reg = -1e30f, l_reg = 0; f32x16 o[4] = {}; bf16x8 qr[ND0];
  const bf16_t* Qw = Qb + (long)(wid * QBLK + r32) * LDQ + hi * 8;
#pragma unroll
  for (int d0 = 0; d0 < ND0; ++d0) qr[d0] = *reinterpret_cast<const bf16x8*>(Qw + d0 * 16);
  const int cq = 4 * qt + (wid >> 1);
  int kb[4];
#pragma unroll
  for (int q = 0; q < 4; ++q) kb[q] = r32 * 384 + ((q * 32 + hi * 16) ^ (((r32 >> 1) & 7) << 4));
  const int NT = 4 * qt + 4;
  const int sr = tid >> 4, sc = (tid & 15) * 8, vst0 = v_st(sr, sc), vst1 = v_st(32 + sr, sc);
  const unsigned vo0 = (unsigned)(sr * LDV + sc) * 2u, vo1 = (unsigned)((32 + sr) * LDV + sc) * 2u;
  unsigned ko[3]; int kst[3];
#pragma unroll
  for (int j = 0; j < 3; ++j) { const int c = tid + 512 * j, kr = c / 24, kc = c % 24; ko[j] = (unsigned)(kr * LDKK + kc * 8) * 2u; kst[j] = AP_KSWZ(kr, kc * 16); }
  const int vb0 = (int)(uintptr_t)V_lds + v_rd_base(lane);
  bf16x8 vs0, vs1, ks0, ks1, ks2;
#define AP_SLOAD(k0) do { const char* vt_ = (const char*)Vh + (size_t)(k0) * (LDV * 2); const char* kt_ = (const char*)Kh + (size_t)(k0) * (LDKK * 2); \
    vs0 = *reinterpret_cast<const bf16x8*>(vt_ + vo0); vs1 = *reinterpret_cast<const bf16x8*>(vt_ + vo1); \
    ks0 = *reinterpret_cast<const bf16x8*>(kt_ + ko[0]); ks1 = *reinterpret_cast<const bf16x8*>(kt_ + ko[1]); ks2 = *reinterpret_cast<const bf16x8*>(kt_ + ko[2]); } while (0)
#define AP_SWRITE(b) do { *(bf16x8*)(V_lds + (b) * SHM_V + vst0) = vs0; *(bf16x8*)(V_lds + (b) * SHM_V + vst1) = vs1; \
    *(bf16x8*)(K_lds + (b) * SHM_K + kst[0]) = ks0; *(bf16x8*)(K_lds + (b) * SHM_K + kst[1]) = ks1; *(bf16x8*)(K_lds + (b) * SHM_K + kst[2]) = ks2; } while (0)
#define AP_RESC(a) do { if (__any((a) < 1.f)) { if (hi == 0) al_l[r32] = (a); asm volatile("s_waitcnt lgkmcnt(0)" ::: "memory"); \
    _Pragma("unroll") for (int d = 0; d < 4; ++d) _Pragma("unroll") for (int r = 0; r < 16; ++r) o[d][r] *= al_l[crow(r, hi)]; } } while (0)
#define AP_MASK(pa, pb, j) do { if ((j) > cq) { _Pragma("unroll") for (int r = 0; r < 16; ++r) { pa[r] = -1e30f; pb[r] = -1e30f; } } } while (0)
  f32x16 p0, p1; float mn, al; bf16x8 pa0, pa1, pa2, pa3;
  AP_SLOAD(0); asm volatile("s_waitcnt vmcnt(0)" ::: "memory"); AP_SWRITE(0); __syncthreads();
#pragma unroll 1
  for (int j = 0; j < NT; ++j) {
    const int bsel = j & 1;
    if (j + 1 < NT) AP_SLOAD((j + 1) * KVBLK);
    AP_SBAR(); qkt(p0, p1, K_lds + bsel * SHM_K, qr, kb); AP_MASK(p0, p1, j);
    partialSM(p0, p1, m_reg, mn, al); AP_RESC(al);
    finishSM(p0, p1, al, l_reg, pa0, pa1, pa2, pa3); AP_SBAR();
    pv_d0(o, vb0 + bsel * (int)SHM_V, pa0, pa1, pa2, pa3);
    if (j + 1 < NT) { asm volatile("s_waitcnt vmcnt(0)" ::: "memory"); AP_SWRITE(bsel ^ 1); }
    __syncthreads();
  }
  if (hi == 0) li_l[r32] = l_reg; asm volatile("s_waitcnt lgkmcnt(0)" ::: "memory");
  float rli[16];
#pragma unroll
  for (int r = 0; r < 16; ++r) rli[r] = __builtin_amdgcn_rcpf(li_l[crow(r, hi)]);
  char* Ow = (char*)(Ob + (size_t)(wid * QBLK) * LDO); const int le = lau_v(lane), r32e = le & 31, hie = le >> 5;
#pragma unroll
  for (int r = 0; r < 16; ++r) { const unsigned oo = (unsigned)(crow(r, hie) * LDO + r32e) * 2u;
#pragma unroll
    for (int d0 = 0; d0 < 4; ++d0) *(bf16_t*)(Ow + oo + d0 * 64) = (bf16_t)(cvt_pk_bf16(o[d0][r] * rli[r], 0.f) & 0xffffu); }
#undef AP_SLOAD
#undef AP_SWRITE
#undef AP_RESC
#undef AP_MASK
}
}

__device__ __forceinline__ void attn_prompt_phase(const Frame& F, KArgs* A_, int first_wg) {
  const int lane = lau_v(lane_id()); unsigned char* ws = lau_s(A_->ws);
  const int w = F.vcu - first_wg; if (w < 0 || w >= 256) return;
  const int bh = w >> 2, p = w & 3, b = bh >> 3, h = bh & 7;
  const bf16_t* Qp = (const bf16_t*)(ws + WS_QP); const bf16_t* Kp = (const bf16_t*)(ws + WS_KP); const bf16_t* Vp = (const bf16_t*)(ws + WS_VP); bf16_t* Y = (bf16_t*)(ws + WS_YCAT);
  const bf16_t* Kh = Kp + ((size_t)b * SEQ * HEADS + h) * QKD; const bf16_t* Vh = Vp + ((size_t)b * SEQ * HEADS + h) * VD;
#pragma unroll 1
  for (int s = 0; s < 2; ++s) { const int qt = s == 0 ? 7 - p : p; const size_t row0 = (size_t)b * SEQ + (size_t)qt * 256;
    attnp::unit(Qp + (row0 * HEADS + h) * QKD, Kh, Vh, Y + row0 * DM + h * VD, qt, (char*)F.lds, F.wave, lane); }
}
namespace attns {
constexpr int QIMG = 0, KIMG = 65536, KPE = KIMG + 65536, SX = KIMG + 73728, SXLD = 272, WSCR = SX + 64 * SXLD, LDS_END = WSCR + 8 * 256;
static_assert(LDS_END <= RING_BYTES, "sample attention LDS");
constexpr float C_EXP = MLA_SCALE * 1.4426950408889634f, THR = 8.f;
__device__ __forceinline__ unsigned off_b(unsigned row, unsigned ch) { return 256u * row + 16u * (ch ^ (((row & 3) << 2) | ((row >> 2) & 3))); }
__device__ __forceinline__ int crow(int r, int hi) { return (r & 3) + 8 * (r >> 2) + 4 * hi; }
template <int OFF> __device__ __forceinline__ s16x4 tr_read(int vb) { s16x4 r; asm volatile("ds_read_b64_tr_b16 %0, %1 offset:%2" : "=&v"(r) : "v"(vb), "i"(OFF) : "memory"); return r; }

__device__ __forceinline__ void unit(const bf16_t* __restrict__ Qs_bh  , const float* __restrict__ Clat  , const float* __restrict__ Ckpe  , const bf16_t* __restrict__ Kn  ,
                                     const bf16_t* __restrict__ Wv  , bf16_t* __restrict__ Yb  , char* lds, int wid, int lane) {
  const int tid = wid * 64 + lane, qh = wid >> 2, cq = wid & 3, l15 = lane & 15, g4 = lane >> 4, r32 = lane & 31, hi = lane >> 5;
  float* wsf = (float*)(lds + WSCR) + wid * 64; float* li_l = wsf; float* al_l = wsf + 32;
#pragma unroll
  for (int j = 0; j < 8; ++j) { const int c = lau_v(tid) + 512 * j, q = c >> 6, ch = c & 63;
    *(bf16x8*)(lds + QIMG + (ch >> 4) * 16384 + off_b(q, ch & 15)) = *reinterpret_cast<const bf16x8*>(Qs_bh + (size_t)q * (HEADS * KVW) + ch * 8); }
  bf16x8 qpe[2][2];
#pragma unroll
  for (int sb = 0; sb < 2; ++sb)
#pragma unroll
    for (int s2 = 0; s2 < 2; ++s2) { const int lq = lau_v(lane); qpe[sb][s2] = *reinterpret_cast<const bf16x8*>(Qs_bh + (unsigned)((32 * qh + 16 * sb + (lq & 15)) * (HEADS * KVW) + KVR + 32 * s2 + 8 * (lq >> 4))); }
  int kb0, qb0, xsh, kpb[2];
  { const int ln2 = lau_v(lane), l15b = ln2 & 15, g4b = ln2 >> 4; const int krow_ = 16 * cq + l15b, qrow_ = 32 * qh + l15b, clo = 16 * (g4b ^ ((l15b >> 2) & 3));
    kb0 = KIMG + 256 * krow_ + clo; qb0 = QIMG + 256 * qrow_ + clo; xsh = (l15b & 3) << 6;
#pragma unroll
    for (int s = 0; s < 2; ++s) kpb[s] = KPE + krow_ * 128 + 16 * ((4 * s + g4b) ^ (krow_ & 7)); }
  int vb[2], q4s;
  { const int blk = (lane >> 4) & 1, q4 = (lane & 15) >> 2, p4 = lane & 3, c0 = 2 * blk + (p4 >> 1);
    q4s = q4 << 6;
#pragma unroll
    for (int t = 0; t < 2; ++t) vb[t] = (int)(uintptr_t)lds + KIMG + cq * 16384 + 256 * (8 * hi + 4 * t + q4) + 16 * (c0 ^ ((2 * hi + t) & 3)) + 8 * (p4 & 1); }
  const int sxw = SX + (32 * qh + l15) * SXLD + (16 * cq + 4 * g4) * 4;
  const int sxr = SX + (32 * qh + r32) * SXLD + (8 * hi) * 4;
  constexpr int NT = (PAST + DECS) / 64;
  constexpr int N1 = 4, N2 = 8 - N1;
  bf16x8 cv[9]; f32x4 r1a[N1], r1b[N1], r2a[N2 + 1], r2b[N2 + 1];
#define AS_CVL(A, B) ({ u32x4 w_; w_.x = cvt_pk_bf16(A[0], A[1]); w_.y = cvt_pk_bf16(A[2], A[3]); w_.z = cvt_pk_bf16(B[0], B[1]); w_.w = cvt_pk_bf16(B[2], B[3]); *reinterpret_cast<bf16x8*>(&w_); })
#define AS_CVP(A, B) ({ u32x4 w_; w_.x = cvt_pk_bf16(A[0], B[0]); w_.y = cvt_pk_bf16(A[1], B[1]); w_.z = cvt_pk_bf16(A[2], B[2]); w_.w = cvt_pk_bf16(A[3], B[3]); *reinterpret_cast<bf16x8*>(&w_); })
#define AS_BC(x) (*reinterpret_cast<const bf16x8*>(&(x)))
#define AS_LD1(j_) do { if ((j_) < PAST / 64) { const unsigned tl_ = (unsigned)lau_v(tid) * 32u; const char* tb_ = (const char*)(Clat + (size_t)(j_) * (64 * KVR)); \
      _Pragma("unroll") for (int i_ = 0; i_ < N1; ++i_) { r1a[i_] = *(const f32x4*)(tb_ + (tl_ + 16384u * i_)); r1b[i_] = *(const f32x4*)(tb_ + (tl_ + 16384u * i_ + 16u)); } } \
    else { const int t2_ = lau_v(tid); _Pragma("unroll") for (int i_ = 0; i_ < N1; ++i_) { const int c_ = t2_ + 512 * i_; r1a[i_] = *reinterpret_cast<const f32x4*>(Kn + (unsigned)((c_ >> 6) * KVW + (c_ & 63) * 8)); } } } while (0)
#define AS_CV1(j_) do { if ((j_) < PAST / 64) { _Pragma("unroll") for (int i_ = 0; i_ < N1; ++i_) cv[i_] = AS_CVL(r1a[i_], r1b[i_]); } \
    else { _Pragma("unroll") for (int i_ = 0; i_ < N1; ++i_) cv[i_] = AS_BC(r1a[i_]); } } while (0)
#define AS_LD2(j_) do { const int t2_ = lau_v(tid); if ((j_) < PAST / 64) { const char* tb_ = (const char*)(Clat + (size_t)(j_) * (64 * KVR)); const float* tp_ = Ckpe + (size_t)(j_) * (64 * ROPE) + (unsigned)((t2_ >> 3) * ROPE + (t2_ & 7) * 4); \
      _Pragma("unroll") for (int i_ = 0; i_ < N2; ++i_) { r2a[i_] = *(const f32x4*)(tb_ + ((unsigned)t2_ * 32u + 16384u * (N1 + i_))); r2b[i_] = *(const f32x4*)(tb_ + ((unsigned)t2_ * 32u + 16384u * (N1 + i_) + 16u)); } \
      r2a[N2] = *(const f32x4*)tp_; r2b[N2] = *(const f32x4*)(tp_ + 32); } \
    else { _Pragma("unroll") for (int i_ = 0; i_ < N2; ++i_) { const int c_ = t2_ + 512 * (N1 + i_); r2a[i_] = *reinterpret_cast<const f32x4*>(Kn + (unsigned)((c_ >> 6) * KVW + (c_ & 63) * 8)); } \
      r2a[N2] = *reinterpret_cast<const f32x4*>(Kn + (unsigned)((t2_ >> 3) * KVW + KVR + (t2_ & 7) * 8)); } } while (0)
#define AS_CV2(j_) do { if ((j_) < PAST / 64) { _Pragma("unroll") for (int i_ = 0; i_ < N2; ++i_) cv[N1 + i_] = AS_CVL(r2a[i_], r2b[i_]); cv[8] = AS_CVP(r2a[N2], r2b[N2]); } \
    else { _Pragma("unroll") for (int i_ = 0; i_ < N2; ++i_) cv[N1 + i_] = AS_BC(r2a[i_]); cv[8] = AS_BC(r2a[N2]); } } while (0)
  float m_reg = -1e30f, l_reg = 0.f; f32x16 o[4] = {};
  AS_LD1(0); AS_LD2(0); AS_CV1(0);
#pragma unroll 1
  for (int j = 0; j < NT; ++j) {
    AS_CV2(j);
    __syncthreads();
    { const int tl = lau_v(tid);
#pragma unroll
      for (int i = 0; i < 8; ++i) { const int c = tl + 512 * i, row = c >> 6, ch = c & 63; *(bf16x8*)(lds + KIMG + (ch >> 4) * 16384 + (int)off_b(row, ch & 15)) = cv[i]; }
      { const int row = tl >> 3, cp = tl & 7; *(bf16x8*)(lds + KPE + row * 128 + 16 * (cp ^ (row & 7))) = cv[8]; } }
    __syncthreads();
    if (j + 1 < NT) AS_LD1(j + 1);
    f32x4 sa[2] = {{0.f, 0.f, 0.f, 0.f}, {0.f, 0.f, 0.f, 0.f}};
    const int xsl = lau_v(xsh);
    bf16x8 fa[2][2], fb0[2][2], fb1[2][2], fp[2];
#define AS_SLD(set, g_) do { _Pragma("unroll") for (int i_ = 0; i_ < 2; ++i_) { const int s_ = 2 * (g_) + i_; const int xs_ = (64 * (s_ & 3)) ^ xsl; \
        fa[set][i_] = *(const bf16x8*)(lds + kb0 + xs_ + (s_ >> 2) * 16384); fb0[set][i_] = *(const bf16x8*)(lds + qb0 + xs_ + (s_ >> 2) * 16384); fb1[set][i_] = *(const bf16x8*)(lds + qb0 + xs_ + (s_ >> 2) * 16384 + 4096); } } while (0)
    AS_SLD(0, 0);
#pragma unroll
    for (int g = 0; g < 8; ++g) {
      if (g < 7) AS_SLD((g + 1) & 1, g + 1); else { fp[0] = *(const bf16x8*)(lds + kpb[0]); fp[1] = *(const bf16x8*)(lds + kpb[1]); }
      __builtin_amdgcn_sched_barrier(0);
#pragma unroll
      for (int i = 0; i < 2; ++i) {
        sa[0] = __builtin_amdgcn_mfma_f32_16x16x32_bf16(fa[g & 1][i], fb0[g & 1][i], sa[0], 0, 0, 0);
        sa[1] = __builtin_amdgcn_mfma_f32_16x16x32_bf16(fa[g & 1][i], fb1[g & 1][i], sa[1], 0, 0, 0); }
      __builtin_amdgcn_sched_barrier(0);
    }
#undef AS_SLD
#pragma unroll
    for (int s = 0; s < 2; ++s) {
      sa[0] = __builtin_amdgcn_mfma_f32_16x16x32_bf16(fp[s], qpe[0][s], sa[0], 0, 0, 0);
      sa[1] = __builtin_amdgcn_mfma_f32_16x16x32_bf16(fp[s], qpe[1][s], sa[1], 0, 0, 0); }
    *(f32x4*)(lds + sxw) = sa[0]; *(f32x4*)(lds + sxw + 16 * SXLD) = sa[1];
    __syncthreads();
    if (j + 1 < NT) { AS_CV1(j + 1); AS_LD2(j + 1); }
    float sv[4][8];
#pragma unroll
    for (int ks = 0; ks < 4; ++ks) { const f32x4 x = *(const f32x4*)(lds + sxr + ks * 64), y = *(const f32x4*)(lds + sxr + ks * 64 + 16);
      sv[ks][0] = x[0]; sv[ks][1] = x[1]; sv[ks][2] = x[2]; sv[ks][3] = x[3]; sv[ks][4] = y[0]; sv[ks][5] = y[1]; sv[ks][6] = y[2]; sv[ks][7] = y[3]; }
    float pmax = sv[0][0];
#pragma unroll
    for (int ks = 0; ks < 4; ++ks)
#pragma unroll
      for (int e = 0; e < 8; ++e) pmax = fmaxf(pmax, sv[ks][e]);
    { auto rr = __builtin_amdgcn_permlane32_swap(__float_as_uint(pmax), __float_as_uint(pmax), false, false); pmax = fmaxf(__uint_as_float(rr[0]), __uint_as_float(rr[1])); }
    float mn, alpha;
    if (__builtin_expect(__all(pmax - m_reg <= THR / MLA_SCALE), 1)) { mn = m_reg; alpha = 1.f; }
    else { mn = fmaxf(m_reg, pmax); alpha = __builtin_amdgcn_exp2f((m_reg - mn) * C_EXP); m_reg = mn; }
    const float mnC = -mn * C_EXP; float ps = 0.f;
#pragma unroll
    for (int ks = 0; ks < 4; ++ks)
#pragma unroll
      for (int e = 0; e < 8; ++e) { sv[ks][e] = __builtin_amdgcn_exp2f(fmaf(sv[ks][e], C_EXP, mnC)); ps += sv[ks][e]; }
    { auto rr = __builtin_amdgcn_permlane32_swap(__float_as_uint(ps), __float_as_uint(ps), false, false); ps = __uint_as_float(rr[0]) + __uint_as_float(rr[1]); }
    l_reg = l_reg * alpha + ps;
    if (__any(alpha < 1.f)) { if (hi == 0) al_l[r32] = alpha; asm volatile("s_waitcnt lgkmcnt(0)" ::: "memory");
#pragma unroll
      for (int d = 0; d < 4; ++d)
#pragma unroll
        for (int r = 0; r < 16; ++r) o[d][r] *= al_l[crow(r, hi)]; }
    bf16x8 pa[4];
#pragma unroll
    for (int ks = 0; ks < 4; ++ks) { u32x4 w; w.x = cvt_pk_bf16(sv[ks][0], sv[ks][1]); w.y = cvt_pk_bf16(sv[ks][2], sv[ks][3]); w.z = cvt_pk_bf16(sv[ks][4], sv[ks][5]); w.w = cvt_pk_bf16(sv[ks][6], sv[ks][7]); pa[ks] = *reinterpret_cast<bf16x8*>(&w); }
#pragma unroll
    for (int d0 = 0; d0 < 4; ++d0) {
      const int xd = (64 * d0) ^ lau_v(q4s), va0 = vb[0] + xd, va1 = vb[1] + xd;
      const s16x4 l0 = tr_read<0>(va0), h0 = tr_read<0>(va1), l1 = tr_read<4096>(va0), h1 = tr_read<4096>(va1);
      const s16x4 l2 = tr_read<8192>(va0), h2 = tr_read<8192>(va1), l3 = tr_read<12288>(va0), h3 = tr_read<12288>(va1);
      asm volatile("s_waitcnt lgkmcnt(0)" ::: "memory"); __builtin_amdgcn_sched_barrier(0);
#define AS_PK(L, H) (bf16x8){L[0], L[1], L[2], L[3], H[0], H[1], H[2], H[3]}
      o[d0] = __builtin_amdgcn_mfma_f32_32x32x16_bf16(pa[0], AS_PK(l0, h0), o[d0], 0, 0, 0);
      o[d0] = __builtin_amdgcn_mfma_f32_32x32x16_bf16(pa[1], AS_PK(l1, h1), o[d0], 0, 0, 0);
      o[d0] = __builtin_amdgcn_mfma_f32_32x32x16_bf16(pa[2], AS_PK(l2, h2), o[d0], 0, 0, 0);
      o[d0] = __builtin_amdgcn_mfma_f32_32x32x16_bf16(pa[3], AS_PK(l3, h3), o[d0], 0, 0, 0);
#undef AS_PK
    }
  }
  if (hi == 0) li_l[r32] = l_reg; asm volatile("s_waitcnt lgkmcnt(0)" ::: "memory");
  { const int le = lau_v(lane), r32e = le & 31, hie = le >> 5;
#pragma unroll
    for (int r = 0; r < 16; ++r) { const int q = 32 * qh + crow(r, hie); const float rl = __builtin_amdgcn_rcpf(li_l[crow(r, hie)]);
#pragma unroll
      for (int d0 = 0; d0 < 4; ++d0) { const int cc = 32 * d0 + r32e;
        *(bf16_t*)(lds + QIMG + cq * 16384 + off_b(q, cc >> 3) + (cc & 7) * 2) = (bf16_t)(cvt_pk_bf16(o[d0][r] * rl, 0.f) & 0xffffu); } } }
  __syncthreads();
  { f32x4 ya[4] = {{0.f, 0.f, 0.f, 0.f}, {0.f, 0.f, 0.f, 0.f}, {0.f, 0.f, 0.f, 0.f}, {0.f, 0.f, 0.f, 0.f}};
    const bf16_t* wrow = lau_vp(Wv + (size_t)(16 * wid + (lau_v(lane) & 15)) * KVR + 8 * (lau_v(lane) >> 4));
    int ob[4];
#pragma unroll
    for (int s = 0; s < 4; ++s) { const int le2 = lau_v(lane); ob[s] = QIMG + off_b(le2 & 15, 4 * s + (le2 >> 4)); }
#pragma unroll
    for (int s = 0; s < 16; ++s) { const bf16x8 b = *reinterpret_cast<const bf16x8*>(wrow + 32 * s);
#pragma unroll
      for (int qb2 = 0; qb2 < 4; ++qb2) { const bf16x8 a = *(const bf16x8*)(lds + ob[s & 3] + (s >> 2) * 16384 + qb2 * 4096); ya[qb2] = __builtin_amdgcn_mfma_f32_16x16x32_bf16(a, b, ya[qb2], 0, 0, 0); } }
    { const int l2 = lau_v(lane); const unsigned yo = (unsigned)((4 * (l2 >> 4)) * DM + 16 * wid + (l2 & 15)) * 2u;
#pragma unroll
      for (int qb2 = 0; qb2 < 4; ++qb2)
#pragma unroll
        for (int e = 0; e < 4; ++e) *(bf16_t*)((char*)Yb + yo + (unsigned)((16 * qb2 + e) * DM * 2)) = (bf16_t)(cvt_pk_bf16(ya[qb2][e], 0.f) & 0xffffu); } }
  __syncthreads();
#undef AS_LD1
#undef AS_LD2
#undef AS_CV1
#undef AS_CV2
#undef AS_CVL
#undef AS_BC
#undef AS_CVP
}
}

__device__ __forceinline__ void attn_sample_phase(const Frame& F, KArgs* A_, int li) {
  const int lane = lau_v(lane_id()); unsigned char* ws = lau_s(A_->ws);
  for (int it = F.vcu; it < DECB * HEADS; it += F.G) {
    const int b = it >> 3, h = it & 7;
    attns::unit((const bf16_t*)(ws + WS_QS) + ((size_t)b * DECS * HEADS + h) * KVW, as_global(A_->in[I_CLAT]) + ((size_t)li * DECB + b) * PAST * KVR, as_global(A_->in[I_CKPE]) + ((size_t)li * DECB + b) * PAST * ROPE,
                (const bf16_t*)(ws + WS_KVN) + ((size_t)MP + (size_t)b * DECS) * KVW, (const bf16_t*)(ws + WS_WKV) + ((size_t)li * 2048 + 1024 + h * VD) * KVR,
                (bf16_t*)(ws + WS_YCAT) + ((size_t)MP + (size_t)b * DECS) * DM + h * VD, (char*)F.lds, F.wave, lane);
  }
}
namespace gla {
constexpr int QT = 0, KT = 8192, KH = 16384, VT = 24576, EL = 32768, SSX = 33280, GB = 33792;
constexpr int GON = 2 * GB, QPO = GON + 512;
static_assert(QPO + 4096 <= RING_BYTES, "gla LDS");
__device__ __forceinline__ int crow(int r, int hi) { return (r & 3) + 8 * (r >> 2) + 4 * hi; }
template <int OFF> __device__ __forceinline__ s16x4 tr_read(int a) { s16x4 r; asm volatile("ds_read_b64_tr_b16 %0, %1 offset:%2" : "=&v"(r) : "v"(a), "i"(OFF) : "memory"); return r; }
#define GLA_PK(L, H) (bf16x8){L[0], L[1], L[2], L[3], H[0], H[1], H[2], H[3]}
__device__ __forceinline__ bf16x8 cvt8(const f32x16& x, int base) {
    u32x4 w; w.x = cvt_pk_bf16(x[base + 0], x[base + 1]); w.y = cvt_pk_bf16(x[base + 2], x[base + 3]); w.z = cvt_pk_bf16(x[base + 4], x[base + 5]); w.w = cvt_pk_bf16(x[base + 6], x[base + 7]); return *reinterpret_cast<bf16x8*>(&w); }

__device__ __forceinline__ void run(unsigned char* ws, const float* s0  , float* sout, const float* gon, int row0, int h, int nch, char* lds, int wave, int lane) {
    const bool scan = wave < 4; const int vq = wave & 3;
    const int r32 = lane & 31, hi = lane >> 5, th = vq >> 1; const unsigned kd = 64u * (vq & 1) + (unsigned)lane;
    const bf16_t* FGp = (const bf16_t*)(ws + WS_FG) + (size_t)row0 * 2048 + h * 128;
    const bf16_t* QSp = (const bf16_t*)(ws + WS_QSIL) + (size_t)row0 * 2048 + h * 128;
    const bf16_t* VBp = (const bf16_t*)(ws + WS_VB) + (size_t)row0 * 2048 + h * 128;
    const bf16_t* GSp = (const bf16_t*)(ws + WS_GS) + (size_t)row0 * 2048 + h * 128;
    bf16_t* YCp = (bf16_t*)(ws + WS_YCAT) + (size_t)row0 * DM + h * 128;
    char* gb = lds;
    const int trq = (lane & 15) >> 2, trf = (2 * hi + (trq >> 1)) & 3;
    const int trb = (int)(uintptr_t)gb + (4 * hi + trq) * 64 + (((2 * ((lane >> 4) & 1) + ((lane & 3) >> 1)) ^ trf) * 16) + 8 * (lane & 1);
    float* gonL = (float*)(lds + GON);
    const int tq = vq; const unsigned dp2 = 2u * (unsigned)lane;
#define GLA_LOAD(F2, QV, VV, c_) do { const size_t ro_ = (size_t)(32 * (c_) + 8 * tq) * 2048; \
    const bf16_t* f1_ = lau_s(FGp + ro_); const bf16_t* q1_ = lau_s(QSp + ro_); const bf16_t* v1_ = lau_s(VBp + ro_); const unsigned kl_ = (unsigned)lau_v((int)dp2); \
    _Pragma("unroll") for (int i_ = 0; i_ < 8; ++i_) { F2[i_] = *(const unsigned*)(f1_ + kl_ + 2048u * i_); QV[i_] = *(const unsigned*)(q1_ + kl_ + 2048u * i_); VV[i_] = *(const unsigned*)(v1_ + kl_ + 2048u * i_); } } while (0)
#define GLA_PROD(F2, n_) do { float p0_ = 1.f, p1_ = 1.f; \
    _Pragma("unroll") for (int i_ = 0; i_ < 8; ++i_) { p0_ *= fmaxf(1.0f - bf_lo(F2[i_]), 1e-30f); p1_ *= fmaxf(1.0f - bf_hi(F2[i_]), 1e-30f); } \
    *(f32x2*)(lds + QPO + ((((n_) & 1) * 4 + tq) * 128 + (int)dp2) * 4) = (f32x2){p0_, p1_}; } while (0)
#define GLA_PREP(F2, QV, VV, par_) do { char* ib_ = gb + (par_) * GB; \
    const f32x2 g0_ = *(const f32x2*)(lds + QPO + (((par_) * 4 + 0) * 128 + (int)dp2) * 4), g1_ = *(const f32x2*)(lds + QPO + (((par_) * 4 + 1) * 128 + (int)dp2) * 4); \
    const f32x2 g2_ = *(const f32x2*)(lds + QPO + (((par_) * 4 + 2) * 128 + (int)dp2) * 4), g3_ = *(const f32x2*)(lds + QPO + (((par_) * 4 + 3) * 128 + (int)dp2) * 4); \
    _Pragma("unroll") for (int d_ = 0; d_ < 2; ++d_) { \
        const float q0_ = d_ ? g0_.y : g0_.x, q1p_ = d_ ? g1_.y : g1_.x, q2_ = d_ ? g2_.y : g2_.x, q3_ = d_ ? g3_.y : g3_.x; \
        const float pre_ = (tq > 0 ? q0_ : 1.f) * (tq > 1 ? q1p_ : 1.f) * (tq > 2 ? q2_ : 1.f), post_ = (tq < 1 ? q1p_ : 1.f) * (tq < 2 ? q2_ : 1.f) * (tq < 3 ? q3_ : 1.f); \
        float E_ = pre_; float qt_[8], kt_[8], kh_[8], fv_[8], kv_[8]; \
        _Pragma("unroll") for (int i_ = 0; i_ < 8; ++i_) { kv_[i_] = d_ ? bf_hi(F2[i_]) : bf_lo(F2[i_]); fv_[i_] = 1.0f - kv_[i_]; E_ *= fmaxf(fv_[i_], 1e-30f); const float Ec_ = fmaxf(E_, 1e-30f); \
            qt_[i_] = __uint_as_float(d_ ? (QV[i_] & 0xffff0000u) : (QV[i_] << 16)) * Ec_; kt_[i_] = kv_[i_] * __builtin_amdgcn_rcpf(Ec_); } \
        float suf_ = post_; \
        _Pragma("unroll") for (int i_ = 7; i_ >= 0; --i_) { kh_[i_] = kv_[i_] * suf_; suf_ *= fmaxf(fv_[i_], 1e-30f); } \
        if (tq == 0) *(float*)(ib_ + EL + ((int)dp2 + d_) * 4) = E_ * post_; \
        u32x4 a_, b_, c_, dd_; \
        a_.x = cvt_pk_bf16(qt_[0], qt_[1]); a_.y = cvt_pk_bf16(qt_[2], qt_[3]); a_.z = cvt_pk_bf16(qt_[4], qt_[5]); a_.w = cvt_pk_bf16(qt_[6], qt_[7]); \
        b_.x = cvt_pk_bf16(kt_[0], kt_[1]); b_.y = cvt_pk_bf16(kt_[2], kt_[3]); b_.z = cvt_pk_bf16(kt_[4], kt_[5]); b_.w = cvt_pk_bf16(kt_[6], kt_[7]); \
        c_.x = cvt_pk_bf16(kh_[0], kh_[1]); c_.y = cvt_pk_bf16(kh_[2], kh_[3]); c_.z = cvt_pk_bf16(kh_[4], kh_[5]); c_.w = cvt_pk_bf16(kh_[6], kh_[7]); \
        if (d_) { dd_.x = (VV[0] >> 16) | (VV[1] & 0xffff0000u); dd_.y = (VV[2] >> 16) | (VV[3] & 0xffff0000u); dd_.z = (VV[4] >> 16) | (VV[5] & 0xffff0000u); dd_.w = (VV[6] >> 16) | (VV[7] & 0xffff0000u); } \
        else { dd_.x = (VV[0] & 0xffffu) | (VV[1] << 16); dd_.y = (VV[2] & 0xffffu) | (VV[3] << 16); dd_.z = (VV[4] & 0xffffu) | (VV[5] << 16); dd_.w = (VV[6] & 0xffffu) | (VV[7] << 16); } \
        const int o_ = ((int)dp2 + d_) * 64 + ((tq ^ (lane & 3)) * 16);   \
        *(u32x4*)(ib_ + QT + o_) = a_; *(u32x4*)(ib_ + KT + o_) = b_; *(u32x4*)(ib_ + KH + o_) = c_; *(u32x4*)(ib_ + VT + o_) = dd_; } } while (0)
    f32x16 S[4]; f32x16 o = {}; u32x2 gsv[4] = {}; f32x4 gnr[4] = {};
#define GLA_FINAL(c_, par_) do { const float* sx_ = (const float*)(gb + (par_) * GB + SSX); \
    const float tot_ = (sx_[r32] + sx_[32 + r32]) + (sx_[64 + r32] + sx_[96 + r32]); const float rs_ = rsqrtf(tot_ * (1.0f / HI) + EPS); \
    const size_t ro_ = (size_t)(32 * (c_) + r32) * 2048; \
    _Pragma("unroll") for (int g_ = 0; g_ < 4; ++g_) { const int v0_ = 32 * vq + 8 * g_ + 4 * hi; const f32x4 gn_ = gnr[g_]; const u32x2 gw_ = gsv[g_]; \
        u32x2 w_; w_.x = cvt_pk_bf16(o[4 * g_ + 0] * rs_ * gn_[0] * bf_lo(gw_.x), o[4 * g_ + 1] * rs_ * gn_[1] * bf_hi(gw_.x)); w_.y = cvt_pk_bf16(o[4 * g_ + 2] * rs_ * gn_[2] * bf_lo(gw_.y), o[4 * g_ + 3] * rs_ * gn_[3] * bf_hi(gw_.y)); \
        *(u32x2*)(YCp + ro_ + v0_) = w_; } } while (0)
#define GLA_GSLOAD(c_) do { const size_t ro_ = (size_t)(32 * (c_) + r32) * 2048; _Pragma("unroll") for (int g_ = 0; g_ < 4; ++g_) gsv[g_] = *(const u32x2*)(GSp + ro_ + 32 * vq + 8 * g_ + 4 * hi); } while (0)
#define GLA_FR2(kt_) do { const s16x4 ql_ = tr_read<QT + (32 * kt_) * 64>(ia), qh_ = tr_read<QT + (32 * kt_ + 8) * 64>(ia), kl_ = tr_read<KT + (32 * kt_) * 64>(ia), kh2_ = tr_read<KT + (32 * kt_ + 8) * 64>(ia); \
        const s16x4 ql3_ = tr_read<QT + (32 * kt_ + 16) * 64>(ia), qh3_ = tr_read<QT + (32 * kt_ + 24) * 64>(ia), kl3_ = tr_read<KT + (32 * kt_ + 16) * 64>(ia), kh3_ = tr_read<KT + (32 * kt_ + 24) * 64>(ia); \
        asm volatile("s_waitcnt lgkmcnt(0)" ::: "memory"); __builtin_amdgcn_sched_barrier(0); \
        qf[kt_][0] = GLA_PK(ql_, qh_); qf[kt_][1] = GLA_PK(ql3_, qh3_); \
        P = __builtin_amdgcn_mfma_f32_32x32x16_bf16(GLA_PK(kl_, kh2_), qf[kt_][0], P, 0, 0, 0); P1 = __builtin_amdgcn_mfma_f32_32x32x16_bf16(GLA_PK(kl3_, kh3_), qf[kt_][1], P1, 0, 0, 0); } while (0)
#define GLA_SCAN(par_) do { const int ia = trb + (par_) * GB; const char* ib = gb + (par_) * GB; \
        bf16x8 qf[4][2]; f32x16 P = {}, P1 = {}; \
        GLA_FR2(0); GLA_FR2(1); GLA_FR2(2); GLA_FR2(3); \
        P = P + P1; \
        _Pragma("unroll") for (int r = 0; r < 16; ++r) P[r] = (crow(r, hi) <= r32) ? P[r] : 0.f; \
        o = f32x16{}; \
        _Pragma("unroll") for (int kt = 0; kt < 4; ++kt) _Pragma("unroll") for (int s2 = 0; s2 < 2; ++s2) o = __builtin_amdgcn_mfma_f32_32x32x16_bf16(cvt8(S[kt], 8 * s2), qf[kt][s2], o, 0, 0, 0); \
        const char* vrow = ib + VT + (32 * vq + r32) * 64; const int fr_ = (r32 >> 1) & 3; \
        { s16x4 vlo_[2], vhh_[2]; \
          _Pragma("unroll") for (int ks = 0; ks < 2; ++ks) { vlo_[ks] = *(const s16x4*)(vrow + (((2 * ks) ^ fr_) * 16) + 8 * hi); vhh_[ks] = *(const s16x4*)(vrow + (((2 * ks + 1) ^ fr_) * 16) + 8 * hi); } \
          __builtin_amdgcn_sched_barrier(0); \
          _Pragma("unroll") for (int ks = 0; ks < 2; ++ks) o = __builtin_amdgcn_mfma_f32_32x32x16_bf16(GLA_PK(vlo_[ks], vhh_[ks]), cvt8(P, 8 * ks), o, 0, 0, 0); } \
        { float ss = 0.f; \
          _Pragma("unroll") for (int r = 0; r < 16; ++r) ss += o[r] * o[r]; \
          auto rr = __builtin_amdgcn_permlane32_swap(__float_as_uint(ss), __float_as_uint(ss), false, false); ss = __uint_as_float(rr[0]) + __uint_as_float(rr[1]); \
          if (hi == 0) *(float*)(gb + (par_) * GB + SSX + (vq * 32 + r32) * 4) = ss; } \
          \
        { bf16x8 ka_[4][2], vb_[2]; f32x4 el_[4][4]; \
          _Pragma("unroll") for (int ks = 0; ks < 2; ++ks) vb_[ks] = *(const bf16x8*)(vrow + (((2 * ks + hi) ^ fr_) * 16)); \
          _Pragma("unroll") for (int kt = 0; kt < 4; ++kt) { \
            _Pragma("unroll") for (int ks = 0; ks < 2; ++ks) ka_[kt][ks] = *(const bf16x8*)(ib + KH + (32 * kt + r32) * 64 + (((2 * ks + hi) ^ fr_) * 16)); \
            _Pragma("unroll") for (int g = 0; g < 4; ++g) el_[kt][g] = *(const f32x4*)(ib + EL + (32 * kt + 8 * g + 4 * hi) * 4); } \
          __builtin_amdgcn_sched_barrier(0); \
          _Pragma("unroll") for (int kt = 0; kt < 4; ++kt) { \
            _Pragma("unroll") for (int g = 0; g < 4; ++g) { S[kt][4 * g + 0] *= el_[kt][g][0]; S[kt][4 * g + 1] *= el_[kt][g][1]; S[kt][4 * g + 2] *= el_[kt][g][2]; S[kt][4 * g + 3] *= el_[kt][g][3]; } \
            _Pragma("unroll") for (int ks = 0; ks < 2; ++ks) S[kt] = __builtin_amdgcn_mfma_f32_32x32x16_bf16(ka_[kt][ks], vb_[ks], S[kt], 0, 0, 0); } } } while (0)
#define GLA_BAR() do { asm volatile("s_waitcnt lgkmcnt(0)" ::: "memory"); __builtin_amdgcn_s_barrier(); asm volatile("" ::: "memory"); } while (0)
    if (scan) {
        if (s0) { const unsigned sl = (unsigned)((4 * hi) * HI + 32 * vq + r32) * 4u;
#pragma unroll
            for (int kt = 0; kt < 4; ++kt)
#pragma unroll
                for (int r = 0; r < 16; ++r) S[kt][r] = *(const float*)((const char*)s0 + sl + (unsigned)((32 * kt + (r & 3) + 8 * (r >> 2)) * HI * 4));
        } else {
#pragma unroll
            for (int kt = 0; kt < 4; ++kt) S[kt] = f32x16{};
        }
        GLA_BAR();
#pragma unroll
        for (int g = 0; g < 4; ++g) gnr[g] = *(const f32x4*)(gonL + 32 * vq + 8 * g + 4 * hi);
#pragma unroll 1
        for (int c = 0; c < nch; ++c) {
            const int par = c & 1;
            GLA_BAR();
            if (c > 0) GLA_FINAL(c - 1, par ^ 1);
            GLA_GSLOAD(c);
            GLA_SCAN(par);
        }
        GLA_BAR();
        GLA_FINAL(nch - 1, (nch - 1) & 1);
        const int le = lau_v(lane); const unsigned sl = (unsigned)((4 * (le >> 5)) * HI + 32 * vq + (le & 31)) * 4u;
#pragma unroll
        for (int kt = 0; kt < 4; ++kt)
#pragma unroll
            for (int r = 0; r < 16; ++r) *(float*)((char*)sout + sl + (unsigned)((32 * kt + (r & 3) + 8 * (r >> 2)) * HI * 4)) = S[kt][r];
    } else {
        unsigned fA[8], fB[8]; unsigned qvA[8], vvA[8], qvB[8], vvB[8];
        if (tq < 2) { const int lg = lau_v(lane); gonL[64 * tq + lg] = lau_s(gon)[64 * tq + lg]; }
        GLA_LOAD(fA, qvA, vvA, 0); if (nch > 1) GLA_LOAD(fB, qvB, vvB, 1);
        GLA_PROD(fA, 0); if (nch > 1) GLA_PROD(fB, 1);
        GLA_BAR();
        GLA_PREP(fA, qvA, vvA, 0); if (nch > 2) GLA_LOAD(fA, qvA, vvA, 2);
#pragma unroll 1
        for (int j = 0; j < nch; j += 2) {
            GLA_BAR();
            if (j + 1 < nch) GLA_PREP(fB, qvB, vvB, 1);
            if (j + 3 < nch) GLA_LOAD(fB, qvB, vvB, j + 3);
            if (j + 2 < nch) GLA_PROD(fA, j + 2);
            if (j + 1 < nch) {
                GLA_BAR();
                if (j + 2 < nch) GLA_PREP(fA, qvA, vvA, 0);
                if (j + 4 < nch) GLA_LOAD(fA, qvA, vvA, j + 4);
                if (j + 3 < nch) GLA_PROD(fB, j + 3);
            }
        }
        GLA_BAR();
    }
    __syncthreads();
#undef GLA_BAR
#undef GLA_LOAD
#undef GLA_PREP
#undef GLA_PROD
#undef GLA_FINAL
#undef GLA_GSLOAD
#undef GLA_SCAN
#undef GLA_FR2
}
#undef GLA_PK
}

__device__ __forceinline__ void gla_phase(const Frame& F, KArgs* A_, int li) {
    const int lane = lau_v(lane_id()); unsigned char* ws = lau_s(A_->ws); float* out = lau_s(A_->out);
    const float* gon = as_global(A_->in[I_GONORM]) + (size_t)li * HI;
    const int bx = (int)blockIdx.x, G = F.G, nit = BATCH * CHD + DECB * CHD;
    for (int k = 0;; ++k) {
        int item;
        if (G == 256) { if (bx < 128) { if (k > 0) break; item = bx; } else { if (k >= 4) break; item = 128 + (bx - 128) + 128 * k; } }
        else { item = bx + k * G; if (item >= nit) break; }
        const bool prompt = item < BATCH * CHD; const int it2 = prompt ? item : item - BATCH * CHD, sq = it2 >> 4, h = it2 & 15;
        if (prompt) gla::run(ws, nullptr, out + O_HGP + ((((size_t)li * BATCH + sq) * CHD + h) * HF) * HI, gon, sq * SEQ, h, SEQ / 32, (char*)F.lds, F.wave, lane);
        else gla::run(ws, as_global(A_->in[I_SHGRN]) + ((((size_t)li * DECB + sq) * CHD + h) * HF) * HI, out + O_HGS + ((((size_t)li * DECB + sq) * CHD + h) * HF) * HI, gon, MP + sq * DECS, h, DECS / 32, (char*)F.lds, F.wave, lane);
    }
}
__global__ void __launch_bounds__(NWAVES * 64, 2) mk_fwd(Args args) {
    extern __shared__ __attribute__((aligned(16))) unsigned char lds[];
    Frame F;
    F.lds = (LAS unsigned char*)lds;
    F.MISC = (volatile LAS unsigned*)(F.lds + MISC_OFF);
    F.wave = __builtin_amdgcn_readfirstlane((int)threadIdx.x >> 6);
    F.G = gridDim.x; { const int bx = blockIdx.x; F.vcu = (F.G % 8 == 0) ? (bx % 8) * (F.G / 8) + bx / 8 : bx; }
    F.ctl = (unsigned*)(args.ws + WS_CTL); F.ctlf = (float*)(args.ws + WS_CTL);
    if (threadIdx.x < 64) ((LAS unsigned*)(F.lds + MISC_OFF))[threadIdx.x] = 0u;
    __syncthreads();
    XcdBarrier bar = xcd_barrier_post(F.ctl + CW_BAR, F.MISC + 8);
#define RUN() (true)
#define SEAM() xcd_barrier(bar)

    if (RUN()) p0_prologue(F, kargs());
    SEAM();

    for (int layer = 0; layer < DEPTH; ++layer) {
        asm volatile("" : "+s"(F.lds), "+s"(F.MISC), "+s"(F.ctl), "+s"(F.ctlf), "+s"(F.wave), "+s"(F.vcu), "+s"(F.G), "+s"(bar.bar), "+s"(bar.x), "+s"(bar.st));
        const int bx = lau_si((int)blockIdx.x);
        const int li = layer >> 1;
        if ((layer & 1) == 0) {
            if (RUN()) {
                unsigned char* ws = lau_s(kargs()->ws);
                pg8::Gemm g{(const bf16_t*)(ws + WS_XB), (const bf16_t*)(ws + WS_WINA) + (size_t)li * INA_PAD * DM, DM, DM, DM};
                pg8::StaticOrder S; S.init(MT / 256, INA_PAD / 256, F.G, bx, DM, DM);
                EpiInA E{ws, as_global(kargs()->out), li, F.lds};
                pg8::gemm_phase<EpiInA, pg8::StaticOrder>(F.lds, g, S, E, F.wave);
                { const unsigned job = layer == 0 ? CJ_INA0 : CJ_INA2;
                    if (F.G == 256) { if (bx >= 136) conv_run(F, kargs(), job, (bx - 136) * NWAVES + F.wave, 120 * NWAVES); }
                    else conv_run(F, kargs(), job, bx * NWAVES + F.wave, F.G * NWAVES); }
            }
            SEAM();
            if (RUN()) {
                post_a_phase(F, kargs(), li); pool_prep_phase(F, kargs(), li);
                __syncthreads();
                unsigned char* ws = lau_s(kargs()->ws);
                pg8::Gemm g{(const bf16_t*)(ws + WS_CQB), (const bf16_t*)(ws + WS_WQB) + (size_t)li * 1536 * QR, QR, QR, QR};
                pg8::StaticOrder S; S.init(MT / 256, 1536 / 256, F.G, bx, QR, QR);
                EpiQ E{ws, li, F.lds};
                pg8::gemm_phase<EpiQ, pg8::StaticOrder>(F.lds, g, S, E, F.wave);
            }
            SEAM();
            if (RUN()) {
                unsigned char* ws = lau_s(kargs()->ws);
                { pg8::Gemm g{(const bf16_t*)(ws + WS_KVN), (const bf16_t*)(ws + WS_WKV) + (size_t)li * 2048 * KVR, KVW, KVR, KVR};
                  pg8::StaticOrder S; S.init(MP / 256, 2048 / 256, F.G, bx, KVW, KVR);
                  EpiStore<0> E{ws}; pg8::gemm_phase<EpiStore<0>, pg8::StaticOrder>(F.lds, g, S, E, F.wave); }
                { pg8::Gemm g{(const bf16_t*)(ws + WS_QNS), (const bf16_t*)(ws + WS_WUKBD) + (size_t)li * 4096 * 128, 1024, 128, 128};
                  pg8::HeadOrder S; S.init(MS / 256, 4096 / 256, F.G, (bx + 128) % F.G, 1024, 128, 128);
                  EpiStore<1> E{ws}; pg8::gemm_phase<EpiStore<1>, pg8::HeadOrder>(F.lds, g, S, E, F.wave); }
                { pg8::Gemm g{(const bf16_t*)(ws + WS_PB), (const bf16_t*)(ws + WS_WPOOL) + (size_t)li * 1024 * 256, POOLW, 256, 256};
                  pg8::GroupOrder S; S.init(MT / 256, 4, F.G, bx, POOLW, 256, 256);
                  EpiStore<2> E{ws}; pg8::gemm_phase<EpiStore<2>, pg8::GroupOrder>(F.lds, g, S, E, F.wave); }
            }
            SEAM();
            if (RUN()) { attn_sample_phase(F, kargs(), li); __syncthreads(); attn_prompt_phase(F, kargs(), 0); }
            SEAM();
        } else {
            if (RUN()) {
                unsigned char* ws = lau_s(kargs()->ws);
                pg8::Gemm g{(const bf16_t*)(ws + WS_XB), (const bf16_t*)(ws + WS_WINC) + (size_t)li * INC * DM, DM, DM, DM};
                pg8::StaticOrder S; S.init(MT / 256, INC / 256, F.G, bx, DM, DM);
                EpiInC E{ws, layer, F.lds}; pg8::gemm_phase<EpiInC, pg8::StaticOrder>(F.lds, g, S, E, F.wave);
            }
            SEAM();
            if (RUN()) { gla_phase(F, kargs(), li);
                { const unsigned job = layer == 1 ? CJ_GLA1 : CJ_GLA3;
                    if (F.G == 256) { if ((int)blockIdx.x >= 128) conv_run(F, kargs(), job, ((int)blockIdx.x - 128) * NWAVES + F.wave, 128 * NWAVES); }
                    else conv_run(F, kargs(), job, (int)blockIdx.x * NWAVES + F.wave, F.G * NWAVES); } }
            SEAM();
        }
        if (RUN()) {
            unsigned char* ws = lau_s(kargs()->ws);
            const bf16_t* W = (layer & 1) ? (const bf16_t*)(ws + WS_WOUTC) + (size_t)li * DM * DM : (const bf16_t*)(ws + WS_WOUTA) + (size_t)li * DM * DM;
            pg8::Gemm g{(const bf16_t*)(ws + WS_YCAT), W, DM, DM, DM};
            pg8::StaticOrder S; S.init(MT / 192, DM / 256, F.G, bx, DM, DM, 192);
            EpiRes<3> E{ws, as_global(kargs()->in[I_XP]), as_global(kargs()->in[I_XS]), layer == 0 ? 1 : 0, 2 * layer + 1}; pg8::gemm_phase<EpiRes<3>, pg8::StaticOrder, true, true, 3>(F.lds, g, S, E, F.wave);
        }
        SEAM();
        if (RUN()) rstd_phase(F, kargs(), 2 * layer + 1);
        SEAM();
        if (RUN()) {
            unsigned char* ws = lau_s(kargs()->ws);
            pg8::Gemm g{(const bf16_t*)(ws + WS_XB), (const bf16_t*)(ws + WS_WUP) + (size_t)layer * DFF2 * DM, DM, DM, DM};
            pg8::StaticOrder S; S.init(MT / 256, DFF2 / 256, F.G, bx, DM, DM);
            EpiUp E{ws, as_global(kargs()->out), as_global(kargs()->in[I_CONVW]) + (size_t)layer * 3 * DFF2, as_global(kargs()->in[I_CONVB]) + (size_t)layer * DFF2, as_global(kargs()->in[I_SCONV]) + (size_t)layer * DECB * 2 * DFF2, F.lds, layer}; pg8::gemm_phase<EpiUp, pg8::StaticOrder>(F.lds, g, S, E, F.wave);
            if (layer < 3) { const unsigned job = layer == 0 ? CJ_UP0 : layer == 1 ? CJ_UP1 : CJ_UP2;
                if (F.G == 256) { if (bx >= 96) conv_run(F, kargs(), job, (bx - 96) * NWAVES + F.wave, 160 * NWAVES); }
                else conv_run(F, kargs(), job, bx * NWAVES + F.wave, F.G * NWAVES); }
        }
        SEAM();
        if (RUN()) act_fix_phase(F, kargs(), layer);
        SEAM();
        if (RUN()) {
            unsigned char* ws = lau_s(kargs()->ws);
            pg8::Gemm g{(const bf16_t*)(ws + WS_ACT), (const bf16_t*)(ws + WS_WDOWN) + (size_t)layer * DM * DFF, DFF, DFF, DFF};
            pg8::StaticOrder S; S.init(MT / 192, DM / 256, F.G, bx, DFF, DFF, 192);
            EpiRes<3> E{ws, as_global(kargs()->in[I_XP]), as_global(kargs()->in[I_XS]), 0, 2 * layer + 2}; pg8::gemm_phase<EpiRes<3>, pg8::StaticOrder, true, true, 3>(F.lds, g, S, E, F.wave);
        }
        SEAM();
        if (RUN()) rstd_phase(F, kargs(), 2 * layer + 2);
        SEAM();
    }
    if (RUN()) final_phase(F, kargs());
#undef RUN
#undef SEAM
}

extern "C" void kernel_launch(void* const* d_in, const int* in_sizes, int n_in, void* d_out, int out_size, void* d_ws, size_t ws_size, hipStream_t stream) {
    static int grid = 0;
    if (grid == 0) {
        if (n_in != N_IN || (size_t)out_size != O_END || ws_size < WS_END) { fprintf(stderr, "kernel_launch: shape mismatch (n_in %d out %d ws %zu, need %d %zu %zu)\n", n_in, out_size, ws_size, (int)N_IN, (size_t)O_END, (size_t)WS_END); grid = -1; return; }
        int dev = 0, cus = 0, per_cu = 0;
        if (hipGetDevice(&dev) != hipSuccess || hipDeviceGetAttribute(&cus, hipDeviceAttributeMultiprocessorCount, dev) != hipSuccess) { grid = -1; return; }
        if (hipFuncSetAttribute((const void*)mk_fwd, hipFuncAttributeMaxDynamicSharedMemorySize, LDS_BYTES) != hipSuccess) { fprintf(stderr, "kernel_launch: hipFuncSetAttribute failed\n"); grid = -1; return; }
        if (hipOccupancyMaxActiveBlocksPerMultiprocessor(&per_cu, (const void*)mk_fwd, NWAVES * 64, LDS_BYTES) != hipSuccess || per_cu < 1) { fprintf(stderr, "kernel_launch: occupancy query reports %d\n", per_cu); }
        (void)hipGetLastError();
        grid = cus;
    }
    if (grid < 0) return;
    (void)hipMemsetAsync((char*)d_ws + WS_CTL, 0, CTL_BYTES, stream);
    Args a{};
    for (int i = 0; i < N_IN; ++i) a.in[i] = (const float*)d_in[i];
    a.out = (float*)d_out; a.ws = (unsigned char*)d_ws; a.ph_lo = 0; a.ph_hi = 1000;
    hipLaunchKernelGGL(mk_fwd, dim3(grid), dim3(NWAVES * 64), LDS_BYTES, stream, a);
    const hipError_t le = hipPeekAtLastError();
    if (le != hipSuccess) fprintf(stderr, "kernel_launch: launch failed: %s\n", hipGetErrorName(le));
}
```

```cpp
#include <hip/hip_runtime.h>
#include <cstdio>
#include <cstdint>

#define GAS __attribute__((address_space(1)))
#define LAS __attribute__((address_space(3)))
typedef unsigned short bf16_t;
typedef short bf16x8 __attribute__((ext_vector_type(8)));
typedef short s16x4 __attribute__((ext_vector_type(4)));
typedef float f32x4 __attribute__((ext_vector_type(4)));
typedef float f32x2 __attribute__((ext_vector_type(2)));
typedef float f32x16 __attribute__((ext_vector_type(16)));
typedef unsigned u32x4 __attribute__((ext_vector_type(4)));
typedef unsigned u32x2 __attribute__((ext_vector_type(2)));

constexpr int DM = 2048, BATCH = 8, SEQ = 2048, DEPTH = 4, DECB = 32, DECS = 64, PAST = 4096;
constexpr int MP = BATCH * SEQ, MS = DECB * DECS, MT = MP + MS;
constexpr int NEVEN = 2, NODD = 2;
constexpr int HEADS = 8, QR = 512, KVR = 512, NOPE = 128, ROPE = 64, VD = 128, QKD = NOPE + ROPE;
constexpr int POOLW = 1024, POOLKEEP = 15;
constexpr int INA = 2112, INA_PAD = 2304;
constexpr int CHD = 16, HF = 128, HI = 128, INC = 8192;
constexpr int DFF = 5632, DFF2 = 11264;
constexpr int KVW = KVR + ROPE;
constexpr float EPS = 1e-6f;
constexpr int NPOS = SEQ + DECS;

constexpr size_t O_YP = 0;
constexpr size_t O_YS = O_YP + (size_t)MP * DM;
constexpr size_t O_LATP = O_YS + (size_t)MS * DM;
constexpr size_t O_KPEP = O_LATP + (size_t)NEVEN * MP * KVR;
constexpr size_t O_POOLP = O_KPEP + (size_t)NEVEN * MP * ROPE;
constexpr size_t O_HGP = O_POOLP + (size_t)NEVEN * BATCH * POOLKEEP * POOLW;
constexpr size_t O_CVP = O_HGP + (size_t)NODD * BATCH * CHD * HF * HI;
constexpr size_t O_LATS = O_CVP + (size_t)DEPTH * BATCH * 2 * DFF2;
constexpr size_t O_KPES = O_LATS + (size_t)NEVEN * MS * KVR;
constexpr size_t O_POOLS = O_KPES + (size_t)NEVEN * MS * ROPE;
constexpr size_t O_HGS = O_POOLS + (size_t)NEVEN * DECB * POOLKEEP * POOLW;
constexpr size_t O_CVS = O_HGS + (size_t)NODD * DECB * CHD * HF * HI;
constexpr size_t O_END = O_CVS + (size_t)DEPTH * DECB * 2 * DFF2;
static_assert(O_END == 84787200, "output size");

enum { I_XP = 0, I_XS, I_CLAT, I_CKPE, I_SPOOL, I_SHGRN, I_SCONV, I_GMIX, I_GFFN, I_GFINAL, I_WINA, I_GQA, I_WQB, I_GKVA, I_WUK, I_WUV,
       I_WPOOL, I_PSCALE, I_WOUTA, I_WINC, I_LB, I_GONORM, I_WOUTC, I_WUP, I_CONVW, I_CONVB, I_WDOWN, N_IN };

constexpr size_t al256(size_t x) { return (x + 255) / 256 * 256; }
constexpr size_t WS_CTL = 0, CTL_BYTES = 1u << 20;
constexpr size_t WS_WINA = WS_CTL + CTL_BYTES;
constexpr size_t WS_WQB = WS_WINA + al256((size_t)NEVEN * INA_PAD * DM * 2);
constexpr size_t WS_WKV = WS_WQB + al256((size_t)NEVEN * 1536 * QR * 2);
constexpr size_t WS_WUKBD = WS_WKV + al256((size_t)NEVEN * 2048 * KVR * 2);
constexpr size_t WS_WUVBD = WS_WUKBD + al256((size_t)NEVEN * 4096 * 1024 * 2);
constexpr size_t WS_WPOOL = WS_WUVBD + al256((size_t)NEVEN * 1024 * 4096 * 2);
constexpr size_t WS_WOUTA = WS_WPOOL + al256((size_t)NEVEN * 1024 * 256 * 2);
constexpr size_t WS_WINC = WS_WOUTA + al256((size_t)NEVEN * DM * DM * 2);
constexpr size_t WS_WOUTC = WS_WINC + al256((size_t)NODD * INC * DM * 2);
constexpr size_t WS_WUP = WS_WOUTC + al256((size_t)NODD * DM * DM * 2);
constexpr size_t WS_WDOWN = WS_WUP + al256((size_t)DEPTH * DFF2 * DM * 2);
constexpr size_t WS_KVC = WS_WDOWN + al256((size_t)DEPTH * DM * DFF * 2);
constexpr size_t WS_ROPE = WS_KVC + al256((size_t)NEVEN * DECB * PAST * KVW * 2);
constexpr size_t WS_LBS = WS_ROPE + al256((size_t)NPOS * 32 * 8);
constexpr size_t WS_SSQP = WS_LBS + al256((size_t)NODD * 2048 * 4);
constexpr size_t WS_RSTD = WS_SSQP + al256((size_t)9 * 32 * MT * 4);
constexpr size_t WS_SSQQ = WS_RSTD + al256((size_t)9 * MT * 4);
constexpr size_t WS_SSQKV = WS_SSQQ + al256((size_t)NEVEN * 8 * MT * 4);
constexpr size_t WS_HALO = WS_SSQKV + al256((size_t)NEVEN * 8 * MT * 4);
constexpr size_t WS_X = WS_HALO + al256((size_t)(MT / 256) * 4 * DFF2 * 4);
constexpr size_t WS_XB = WS_X + al256((size_t)MT * DM * 4);
constexpr size_t WS_YCAT = WS_XB + al256((size_t)MT * DM * 2);
constexpr size_t WS_BIG = WS_YCAT + al256((size_t)MT * DM * 2);
constexpr size_t WS_CQB = WS_BIG;
constexpr size_t WS_ZB = WS_CQB + al256((size_t)MT * QR * 2);
constexpr size_t WS_PB = WS_ZB + al256((size_t)MT * POOLW * 2);
constexpr size_t WS_KVN = WS_PB + al256((size_t)MT * POOLW * 2);
constexpr size_t WS_QP = WS_KVN + al256((size_t)MT * KVW * 2);
constexpr size_t WS_KP = WS_QP + al256((size_t)MP * HEADS * QKD * 2);
constexpr size_t WS_VP = WS_KP + al256((size_t)MP * HEADS * QKD * 2);
constexpr size_t WS_QNS = WS_VP + al256((size_t)MP * HEADS * VD * 2);
constexpr size_t WS_QS = WS_QNS + al256((size_t)MS * 1024 * 2);
constexpr size_t WS_OLAT = WS_QS + al256((size_t)MS * HEADS * KVW * 2);
constexpr size_t WS_EVEN_END = WS_OLAT + al256((size_t)MS * HEADS * KVR * 2);
constexpr size_t WS_FG = WS_BIG;
constexpr size_t WS_QSIL = WS_FG + al256((size_t)MT * 2048 * 4);
constexpr size_t WS_VB = WS_QSIL + al256((size_t)MT * 2048 * 2);
constexpr size_t WS_GS = WS_VB + al256((size_t)MT * 2048 * 2);
constexpr size_t WS_ODD_END = WS_GS + al256((size_t)MT * 2048 * 2);
constexpr size_t WS_HB = WS_BIG;
constexpr size_t WS_ACT = WS_HB + al256((size_t)MT * DFF2 * 2);
constexpr size_t WS_FFN_END = WS_ACT + al256((size_t)MT * DFF * 2);
constexpr size_t WS_END = WS_FFN_END > WS_EVEN_END ? (WS_FFN_END > WS_ODD_END ? WS_FFN_END : WS_ODD_END) : (WS_EVEN_END > WS_ODD_END ? WS_EVEN_END : WS_ODD_END);
static_assert(WS_END <= (size_t)2147483648u, "workspace map must fit 4 x largest input");

constexpr int CW_BAR = 4096;

constexpr int RING_BYTES = 159744;
constexpr int EPI_LDS = 131072;
constexpr int EPI_CW = EPI_LDS + 8192;
constexpr int EPI_RS = EPI_CW + 8192;
static_assert(EPI_RS + 2048 <= RING_BYTES, "epilogue LDS");
constexpr int MISC_OFF = RING_BYTES;
constexpr int LDS_BYTES = RING_BYTES + 256;
constexpr int NWAVES = 8;

#define LDS_WAIT() asm volatile("s_waitcnt lgkmcnt(0)" ::: "memory")
#define VM_WAIT() asm volatile("s_waitcnt vmcnt(0)" ::: "memory")
typedef __bf16 bf16x2_t __attribute__((ext_vector_type(2)));
__device__ __forceinline__ unsigned cvt_pk_bf16(float lo, float hi) { const f32x2 v = {lo, hi}; unsigned r = __builtin_bit_cast(unsigned, __builtin_convertvector(v, bf16x2_t)); asm volatile("" : "+v"(r)); return r; }
__device__ __forceinline__ float bf_lo(unsigned w) { return __uint_as_float(w << 16); }
__device__ __forceinline__ float bf_hi(unsigned w) { return __uint_as_float(w & 0xffff0000u); }
__device__ __forceinline__ float wave_sum(float v) {
#pragma unroll
    for (int o = 1; o < 64; o <<= 1) v += __shfl_xor(v, o);
    return v;
}
__device__ __forceinline__ float row4_sum(float x) {
    { const auto r = __builtin_amdgcn_permlane16_swap(__float_as_uint(x), __float_as_uint(x), false, false); x = __uint_as_float(r[0]) + __uint_as_float(r[1]); }
    { const auto r = __builtin_amdgcn_permlane32_swap(__float_as_uint(x), __float_as_uint(x), false, false); x = __uint_as_float(r[0]) + __uint_as_float(r[1]); }
    return x;
}
__device__ __forceinline__ float silu_f(float x) { return x * __builtin_amdgcn_rcpf(1.0f + __expf(-x)); }
__device__ __forceinline__ float sigmoid_f(float x) { return __builtin_amdgcn_rcpf(1.0f + __expf(-x)); }
template <class T> __device__ __forceinline__ T* as_global(T* p) { return (T*)(T GAS*)(unsigned long long)p; }
template <class T> __device__ __forceinline__ T* lau_s(T* p) { asm volatile("" : "+s"(p)); return as_global(p); }
template <class T> __device__ __forceinline__ T* lau_vp(T* p) { asm volatile("" : "+v"(p)); return as_global(p); }
__device__ __forceinline__ int lau_v(int x) { asm volatile("" : "+v"(x)); return x; }
__device__ __forceinline__ int lau_si(int x) { asm volatile("" : "+s"(x)); return x; }
__device__ __forceinline__ int lane_id() { int l; asm volatile("v_mbcnt_lo_u32_b32 %0, -1, 0\n\tv_mbcnt_hi_u32_b32 %0, -1, %0" : "=v"(l)); return l; }
#define XB_TMO      128
#define XB_XCNT(j)  (256  + 64 * (j))
#define XB_XSUB(j)  (1280 + 64 * (j))
#define XB_XGEN(j)  (2304 + 64 * (j))
#define XB_TOP      3328
#define XB_TOPGEN   3392
#define XCD_BAR_WORDS 3456
#define XB_SPIN_CAP (1u << 18)

__device__ __forceinline__ unsigned xb_ld(unsigned* p)              { return __hip_atomic_load(p, __ATOMIC_RELAXED, __HIP_MEMORY_SCOPE_AGENT); }
__device__ __forceinline__ unsigned xb_add(unsigned* p, unsigned v) { return __hip_atomic_fetch_add(p, v, __ATOMIC_RELAXED, __HIP_MEMORY_SCOPE_AGENT); }
__device__ __forceinline__ unsigned xb_xcc_id() { return (unsigned)__builtin_amdgcn_s_getreg((3 << 11) | 20) & 0xFu; }
#define XB_SPIN(cond, bar) do { unsigned _sp = 0; while (cond) { __builtin_amdgcn_s_sleep(1); \
    if ((++_sp & 255u) == 0u) { if (xb_ld(&(bar)[XB_TMO])) break; if (_sp > XB_SPIN_CAP) { atomicAdd(&(bar)[XB_TMO], 1u); break; } } } } while (0)

struct XcdBarrier {
    unsigned* bar; unsigned x;
    volatile LAS unsigned* st;
};

__device__ __forceinline__ XcdBarrier xcd_barrier_post(unsigned* bar, volatile LAS unsigned* st) {
    XcdBarrier b; b.bar = bar; b.x = xb_xcc_id(); b.st = st;
    if (threadIdx.x == 0) (void)xb_add(&bar[XB_XCNT(b.x)], 1u);
    return b;
}
__device__ __forceinline__ void xcd_barrier_complete(unsigned* bar, unsigned x, unsigned& nloc, unsigned& nx) {
    const unsigned G = gridDim.x * gridDim.y * gridDim.z;
    unsigned sum, cnt, mine, sp = 0u;
    for (;;) {
        sum = 0u; cnt = 0u; mine = 0u;
#pragma unroll
        for (unsigned j = 0; j < 16; ++j) { const unsigned c = xb_ld(&bar[XB_XCNT(j)]); sum += c; cnt += (c > 0u) ? 1u : 0u; mine = (j == x) ? c : mine; }
        if (sum == G) break;
        __builtin_amdgcn_s_sleep(1);
        if ((++sp & 255u) == 0u) { if (xb_ld(&bar[XB_TMO])) break; if (sp > XB_SPIN_CAP) { atomicAdd(&bar[XB_TMO], 1u); break; } }
    }
    nloc = mine > 0u ? mine : 1u; nx = cnt > 0u ? cnt : 1u;
}

__device__ __forceinline__ void xcd_barrier(const XcdBarrier& b) {
    asm volatile("s_waitcnt vmcnt(0)" ::: "memory");
    __syncthreads();
    if (threadIdx.x == 0) {
        unsigned* bar = b.bar;
        __builtin_amdgcn_s_waitcnt(0);
        unsigned nloc = b.st[0], nx = b.st[1];
        if (nloc == 0u) { xcd_barrier_complete(bar, b.x, nloc, nx); b.st[0] = nloc; b.st[1] = nx; }
        const unsigned old = xb_add(&bar[XB_XSUB(b.x)], 1u);
        const unsigned gen = old / nloc;
        if (old + 1u == (gen + 1u) * nloc) {
            __builtin_amdgcn_fence(__ATOMIC_RELEASE, "agent");
            asm volatile("s_waitcnt vmcnt(0)" ::: "memory");
            const unsigned og = xb_add(&bar[XB_TOP], 1u);
            const unsigned tg = og / nx;
            if (og + 1u == (tg + 1u) * nx) xb_add(&bar[XB_TOPGEN], 1u);
            else XB_SPIN(xb_ld(&bar[XB_TOPGEN]) == tg, bar);
            __builtin_amdgcn_fence(__ATOMIC_ACQUIRE, "agent");
            xb_add(&bar[XB_XGEN(b.x)], 1u);
            asm volatile("s_waitcnt vmcnt(0)" ::: "memory");
        } else {
            XB_SPIN(xb_ld(&bar[XB_XGEN(b.x)]) == gen, bar);
            __builtin_amdgcn_fence(__ATOMIC_ACQUIRE, "agent");
            asm volatile("s_waitcnt vmcnt(0)" ::: "memory");
        }
    }
    __syncthreads();
}

namespace pg8 {
constexpr int BM = 256, BK = 64, HALF = 128, HTB = HALF * BK * 2, STAGE_BYTES = 8 * HTB, NXCD = 8, WGM = 8;
__host__ __device__ __forceinline__ int lds_byte(int r, int c) { const int st = (r >> 4) * 2 + (c >> 5), rr = r & 15, cc = c & 31, ob = rr * 64 + cc * 2; return st * 1024 + (ob ^ (((ob >> 9) & 1) << 5)); }
__host__ __device__ __forceinline__ void stage_rc(int b, int& R, int& C) { const int st = b / 1024, sb = b % 1024, swz = sb ^ (((sb >> 9) & 1) << 5); R = (st >> 1) * 16 + swz / 64; C = (st & 1) * 32 + (swz % 64) / 2; }
__host__ __device__ __forceinline__ int perm32(int rho) { const int n = rho >> 4, i = rho & 15; return 8 * (i >> 2) + 4 * n + (i & 3); }

struct Unit { int pm, pn, par; };
struct Gemm { const bf16_t* A; const bf16_t* Bt; int lda, ldb, K; };

struct StaticOrder {
    int nM, nN, nwg, G, c, lda, ldb, bm;
    __device__ void init(int nM_, int nN_, int G_, int c_, int lda_, int ldb_, int bm_ = BM) { nM = nM_; nN = nN_; nwg = nM * nN; G = G_; c = c_; lda = lda_; ldb = ldb_; bm = bm_; }
    __device__ bool next(int i, Unit& u) const {
        const long L = (long)i * G + c; if (L >= nwg) return false;
        int wgid = (int)L; { const int q = nwg / NXCD, r = nwg % NXCD, xcd = wgid % NXCD, off = wgid / NXCD; wgid = (xcd < r ? xcd * (q + 1) : r * (q + 1) + (xcd - r) * q) + off; }
        const int nig = WGM * nN, gid = wgid / nig, fm = gid * WGM, gsz = (nM - fm) < WGM ? (nM - fm) : WGM;
        u.pm = fm + ((wgid % nig) % gsz); u.pn = (wgid % nig) / gsz; return true;
    }
    __device__ __forceinline__ size_t aoff(const Unit& u) const { return (size_t)u.pm * bm * lda * 2; }
    __device__ __forceinline__ size_t boff(const Unit& u) const { return (size_t)u.pn * BM * ldb * 2; }
};
struct GroupOrder {
    int nM, ng, nwg, G, c, lda, ldb, akoff;
    __device__ void init(int nM_, int ng_, int G_, int c_, int lda_, int ldb_, int akoff_) { nM = nM_; ng = ng_; nwg = nM * ng; G = G_; c = c_; lda = lda_; ldb = ldb_; akoff = akoff_; }
    __device__ bool next(int i, Unit& u) const {
        const long L = (long)i * G + c; if (L >= nwg) return false;
        u.pm = (int)(L / ng); u.pn = (int)(L % ng); return true;
    }
    __device__ __forceinline__ size_t aoff(const Unit& u) const { return ((size_t)u.pm * BM * lda + (size_t)u.pn * akoff) * 2; }
    __device__ __forceinline__ size_t boff(const Unit& u) const { return (size_t)u.pn * BM * ldb * 2; }
};

struct HeadOrder {
    int nM, nt, nwg, G, c, lda, ldb, akoff;
    __device__ void init(int nM_, int nt_, int G_, int c_, int lda_, int ldb_, int akoff_) { nM = nM_; nt = nt_; nwg = nM * nt; G = G_; c = c_; lda = lda_; ldb = ldb_; akoff = akoff_; }
    __device__ bool next(int i, Unit& u) const {
        const long L = (long)i * G + c; if (L >= nwg) return false;
        u.pm = (int)(L / nt); u.pn = (int)(L % nt); return true;
    }
    __device__ __forceinline__ size_t aoff(const Unit& u) const { return ((size_t)u.pm * BM * lda + (size_t)(u.pn >> 1) * akoff) * 2; }
    __device__ __forceinline__ size_t boff(const Unit& u) const { return (size_t)u.pn * BM * ldb * 2; }
};

template <class Epi, class Sched, bool ALIGN_EPI = true, bool SP2 = true, int NM = 4>
__device__ __forceinline__ void gemm_phase(LAS unsigned char* lds, const Gemm g, const Sched& S, const Epi& E, int wid) {
    const int lane = lau_v(lane_id()), tid = wid * 64 + lane, wr = wid >> 2, wc = wid & 3, fr = lane & 15, fq = lane >> 4;
    const int K = g.K, nt = K / BK;
    unsigned voffA[2], voffB[2];
#pragma unroll
    for (int i = 0; i < 2; ++i) { int R, C; stage_rc(tid * 16 + i * 8192, R, C); const int Rb = Epi::PERM ? ((R & ~31) + perm32(R & 31)) : R;
        voffA[i] = (unsigned)(R * g.lda + C) * 2u; voffB[i] = (unsigned)(Rb * g.ldb + C) * 2u; }
    const size_t kstep = (size_t)(BK * 2);
    const size_t hstepA = (size_t)(32 * NM) * g.lda * 2, hstepB = (size_t)HALF * g.ldb * 2;
    const unsigned ldsw = (unsigned)wid * 1024u;
    const int aoff = lds_byte(wr * (16 * NM) + fr, fq * 8), boff = lds_byte(wc * 32 + fr, fq * 8);
#define PG8_SA(b, h) (((b) * 2 + (h)) * HTB)
#define PG8_SB(b, h) ((4 + (b) * 2 + (h)) * HTB)
#define PG8_STAGE(bufoff, gbase, voff) do { _Pragma("unroll") for (int _i = 0; _i < 2; ++_i) \
        __builtin_amdgcn_global_load_lds((const unsigned*)((const char*)(gbase) + (voff)[_i]), (LAS unsigned*)(lds + (bufoff) + ldsw + _i * 8192), 16, 0, 0); } while (0)
#define PG8_LDA(dst, b, h) do { _Pragma("unroll") for (int m = 0; m < NM; ++m) _Pragma("unroll") for (int k = 0; k < 2; ++k) dst[m][k] = *(const LAS bf16x8*)(lds + PG8_SA(b, h) + aoff + m * 2048 + k * 1024); } while (0)
#define PG8_LDB(dst, b, h) do { _Pragma("unroll") for (int n = 0; n < 2; ++n) _Pragma("unroll") for (int k = 0; k < 2; ++k) dst[n][k] = *(const LAS bf16x8*)(lds + PG8_SB(b, h) + boff + n * 2048 + k * 1024); } while (0)
#define PG8_MMA(ai, bj, At, Bt) do { __builtin_amdgcn_s_setprio(1); _Pragma("unroll") for (int m = 0; m < NM; ++m) _Pragma("unroll") for (int n = 0; n < 2; ++n) _Pragma("unroll") for (int k = 0; k < 2; ++k) \
        acc[ai][bj][m][n] = __builtin_amdgcn_mfma_f32_16x16x32_bf16(Bt[n][k], At[m][k], acc[ai][bj][m][n], 0, 0, 0); __builtin_amdgcn_s_setprio(0); } while (0)
#define PG8_WAIT_V(n) asm volatile("s_waitcnt vmcnt(" #n ")" ::: "memory")
#define PG8_WAIT_L(n) asm volatile("s_waitcnt lgkmcnt(" #n ")" ::: "memory")
#define PG8_BAR __builtin_amdgcn_s_barrier()
#define PG8_SCHED __builtin_amdgcn_sched_barrier(0)
    Unit cur, nxt; int ui = 0;
    if (!S.next(0, cur)) return;
    cur.par = 0;
    f32x4 acc[2][2][NM][2];
#pragma unroll
    for (int a = 0; a < 2; ++a)
#pragma unroll
        for (int b = 0; b < 2; ++b)
#pragma unroll
            for (int m = 0; m < NM; ++m)
#pragma unroll
                for (int n = 0; n < 2; ++n) acc[a][b][m][n] = (f32x4){0.f, 0.f, 0.f, 0.f};
    bf16x8 At[NM][2], B0[2][2], B1[2][2];
    const char* cA = (const char*)g.A + S.aoff(cur); const char* cB = (const char*)g.Bt + S.boff(cur);
    if constexpr (SP2) {
        PG8_STAGE(PG8_SB(0, 0), cB, voffB); PG8_STAGE(PG8_SB(0, 1), cB + hstepB, voffB); PG8_STAGE(PG8_SA(0, 0), cA, voffA); PG8_STAGE(PG8_SA(0, 1), cA + hstepA, voffA);
        if (wr == 1) PG8_BAR;
        PG8_WAIT_V(2); PG8_BAR;
        PG8_STAGE(PG8_SB(1, 0), cB + kstep, voffB); PG8_STAGE(PG8_SA(1, 0), cA + kstep, voffA); PG8_STAGE(PG8_SB(1, 1), cB + hstepB + kstep, voffB);
        PG8_WAIT_V(6); PG8_BAR;
    } else {
        PG8_STAGE(PG8_SB(0, 0), cB, voffB); PG8_STAGE(PG8_SA(0, 0), cA, voffA); PG8_STAGE(PG8_SB(0, 1), cB + hstepB, voffB); PG8_STAGE(PG8_SA(0, 1), cA + hstepA, voffA);
        if (wr == 1) PG8_BAR;
        PG8_WAIT_V(4); PG8_BAR;
        PG8_STAGE(PG8_SB(1, 0), cB + kstep, voffB); PG8_STAGE(PG8_SA(1, 0), cA + kstep, voffA); PG8_STAGE(PG8_SB(1, 1), cB + hstepB + kstep, voffB);
        PG8_WAIT_V(6); PG8_BAR;
    }
    for (;;) {
        const bool has_next = S.next(ui + 1, nxt);
        const char* nA = has_next ? (const char*)g.A + S.aoff(nxt) : cA; const char* nB = has_next ? (const char*)g.Bt + S.boff(nxt) : cB;
        if constexpr (Epi::PRE) E.pre(lds, cur, wid);
        for (int t = 0; t < nt; t += 2) {
            const bool last = (t == nt - 2);
            const char* a1 = cA + (size_t)(t + 1) * kstep;
            const char* a2 = last ? nA : cA + (size_t)(t + 2) * kstep; const char* b2 = last ? nB : cB + (size_t)(t + 2) * kstep;
            const char* a3 = a2 + kstep; const char* b3 = b2 + kstep;
            if constexpr (SP2) {
            PG8_LDB(B0, 0, 0); PG8_LDB(B1, 0, 1); PG8_SCHED; PG8_LDA(At, 0, 0); PG8_STAGE(PG8_SA(1, 1), a1 + hstepA, voffA);
            PG8_WAIT_V(8); PG8_WAIT_L(0); PG8_BAR; PG8_MMA(0, 0, At, B0); PG8_MMA(0, 1, At, B1); PG8_BAR; PG8_SCHED;
            PG8_LDA(At, 0, 1); PG8_STAGE(PG8_SB(0, 0), b2, voffB); PG8_STAGE(PG8_SB(0, 1), b2 + hstepB, voffB); PG8_STAGE(PG8_SA(0, 0), a2, voffA);
            PG8_WAIT_V(8); PG8_WAIT_L(0); PG8_BAR; PG8_MMA(1, 0, At, B0); PG8_MMA(1, 1, At, B1); PG8_BAR; PG8_SCHED;
            PG8_LDB(B0, 1, 0); PG8_LDB(B1, 1, 1); PG8_SCHED; PG8_LDA(At, 1, 0); PG8_STAGE(PG8_SA(0, 1), a2 + hstepA, voffA);
            PG8_WAIT_V(8); PG8_WAIT_L(0); PG8_BAR; PG8_MMA(0, 0, At, B0); PG8_MMA(0, 1, At, B1); PG8_BAR; PG8_SCHED;
            PG8_LDA(At, 1, 1); PG8_STAGE(PG8_SB(1, 0), b3, voffB); PG8_STAGE(PG8_SB(1, 1), b3 + hstepB, voffB); PG8_STAGE(PG8_SA(1, 0), a3, voffA);
            PG8_WAIT_V(8); PG8_WAIT_L(0); PG8_BAR; PG8_MMA(1, 0, At, B0); PG8_MMA(1, 1, At, B1); PG8_BAR; PG8_SCHED;
            } else {
            PG8_LDB(B0, 0, 0); PG8_SCHED; PG8_LDA(At, 0, 0); PG8_STAGE(PG8_SA(1, 1), a1 + hstepA, voffA);
            PG8_WAIT_L(8); PG8_BAR; PG8_WAIT_L(0); PG8_MMA(0, 0, At, B0); PG8_BAR; PG8_SCHED;
            PG8_LDB(B1, 0, 1); PG8_STAGE(PG8_SB(0, 0), b2, voffB);
            PG8_BAR; PG8_WAIT_L(0); PG8_MMA(0, 1, At, B1); PG8_BAR;
            PG8_LDA(At, 0, 1); PG8_STAGE(PG8_SA(0, 0), a2, voffA);
            PG8_BAR; PG8_WAIT_L(0); PG8_MMA(1, 0, At, B0); PG8_BAR; PG8_SCHED;
            PG8_STAGE(PG8_SB(0, 1), b2 + hstepB, voffB);
            PG8_WAIT_V(6); PG8_BAR; PG8_MMA(1, 1, At, B1); PG8_BAR;
            PG8_LDB(B0, 1, 0); PG8_SCHED; PG8_LDA(At, 1, 0); PG8_STAGE(PG8_SA(0, 1), a2 + hstepA, voffA);
            PG8_WAIT_L(8); PG8_BAR; PG8_WAIT_L(0); PG8_MMA(0, 0, At, B0); PG8_BAR; PG8_SCHED;
            PG8_LDB(B1, 1, 1); PG8_STAGE(PG8_SB(1, 0), b3, voffB);
            PG8_BAR; PG8_WAIT_L(0); PG8_MMA(0, 1, At, B1); PG8_BAR;
            PG8_LDA(At, 1, 1); PG8_STAGE(PG8_SA(1, 0), a3, voffA);
            PG8_BAR; PG8_WAIT_L(0); PG8_MMA(1, 0, At, B0); PG8_BAR; PG8_SCHED;
            PG8_STAGE(PG8_SB(1, 1), b3 + hstepB, voffB);
            PG8_WAIT_V(6); PG8_BAR; PG8_MMA(1, 1, At, B1); PG8_BAR;
            }
        }
        if constexpr (ALIGN_EPI) { if (wr == 0) PG8_BAR; }
        E(acc, cur, wr, wc, fr, fq);
        if (!has_next) break;
#pragma unroll
        for (int a = 0; a < 2; ++a)
#pragma unroll
            for (int b = 0; b < 2; ++b)
#pragma unroll
                for (int m = 0; m < NM; ++m)
#pragma unroll
                    for (int n = 0; n < 2; ++n) acc[a][b][m][n] = (f32x4){0.f, 0.f, 0.f, 0.f};
        cur = nxt; cA = nA; cB = nB; ++ui; cur.par = ui & 1;
        if constexpr (ALIGN_EPI) { if (wr == 1) PG8_BAR; }
    }
    PG8_WAIT_V(0);
    if constexpr (!ALIGN_EPI) { if (wr == 0) PG8_BAR; }
    PG8_BAR;
#undef PG8_SA
#undef PG8_SB
#undef PG8_STAGE
#undef PG8_LDA
#undef PG8_LDB
#undef PG8_MMA
#undef PG8_WAIT_V
#undef PG8_WAIT_L
#undef PG8_BAR
#undef PG8_SCHED
}
}
struct Frame {
    LAS unsigned char* lds;
    volatile LAS unsigned* MISC;
    unsigned* ctl;
    float* ctlf;
    int wave;
    int vcu, G;
};
struct Args { const float* in[N_IN]; float* out; unsigned char* ws; int ph_lo, ph_hi; };
typedef const Args __attribute__((address_space(4))) KArgs;
__device__ __forceinline__ KArgs* kargs() { KArgs* p = (KArgs*)__builtin_amdgcn_kernarg_segment_ptr(); asm volatile("" : "+s"(p)); return p; }
__device__ __forceinline__ int rope_row(int r) { return r < MP ? (r & (SEQ - 1)) : SEQ + ((r - MP) & (DECS - 1)); }

__device__ __forceinline__ void tr_item(const float* W, int ldn, int k0, int n0, const float* ks, const float* ns, bf16_t* WT, size_t dld, int rbase, int rstride, int dcol0, LAS float* scr, int lane) {
    f32x4 v[8];
#pragma unroll
    for (int i = 0; i < 8; ++i) v[i] = *(const f32x4*)(W + (size_t)(k0 + 8 * i + (lane >> 3)) * ldn + n0 + 4 * (lane & 7));
#pragma unroll
    for (int i = 0; i < 8; ++i) { const int kk = 8 * i + (lane >> 3); const float s = ks ? ks[k0 + kk] : 1.0f; LAS float* d = scr + kk * 33 + 4 * (lane & 7);
        d[0] = v[i][0] * s; d[1] = v[i][1] * s; d[2] = v[i][2] * s; d[3] = v[i][3] * s; }
    LDS_WAIT(); asm volatile("" ::: "memory");
    const int c = lane & 7;
#pragma unroll
    for (int j = 0; j < 4; ++j) { const int n = (lane >> 3) + 8 * j; const LAS float* s = scr + (8 * c) * 33 + n; const float sc = ns ? ns[n] : 1.0f;
        u32x4 o; o.x = cvt_pk_bf16(s[0 * 33] * sc, s[1 * 33] * sc); o.y = cvt_pk_bf16(s[2 * 33] * sc, s[3 * 33] * sc); o.z = cvt_pk_bf16(s[4 * 33] * sc, s[5 * 33] * sc); o.w = cvt_pk_bf16(s[6 * 33] * sc, s[7 * 33] * sc);
        *(u32x4*)(WT + (size_t)(rbase + rstride * n) * dld + dcol0 + k0 + 8 * c) = o; }
    LDS_WAIT(); asm volatile("" ::: "memory");
}
struct TrMat { const float* W; int K, N; const float* ks; bf16_t* WT; size_t dld; int mode; const float* ns; };
__device__ __forceinline__ void tr_mat_item(const TrMat& t, int it, LAS float* scr, int lane) {
    const int nblk = t.N / 32, kb = it / nblk, nb = it % nblk, k0 = 64 * kb, n0 = 32 * nb;
    int rbase = n0, rstride = 1, dcol0 = 0;
    if (t.mode == 1) { rbase = n0 < 1024 ? n0 : (n0 < 1088 ? 2048 + (n0 - 1024) : 1024 + (n0 - 1088)); }
    else if (t.mode == 2) { const int h = n0 / 192, c = n0 % 192; if (c >= 128) { const int j0 = c - 128; rbase = h * 192 + 128 + (j0 >= 32 ? 1 : 0); rstride = 2; } }
    else if (t.mode == 3) { dcol0 = (n0 / 128) * 512; }
    else if (t.mode == 5) { const int isb = n0 >= DFF ? 1 : 0, j0 = n0 - isb * DFF; rbase = (j0 / 128) * 256 + isb * 128 + (j0 % 128); }
    tr_item(t.W, t.N, k0, n0, t.ks, t.ns ? t.ns + n0 : nullptr, t.WT, t.dld, rbase, rstride, dcol0, scr, lane);
}
__device__ __forceinline__ void sincos_red(float ang, float& sn, float& cs) {
    const double a = (double)ang, k = rint(a * 0.63661977236758134308), r = a - k * 1.57079632679489661923;
    const float x = (float)r, x2 = x * x;
    const float s = x + x * x2 * (-1.6666667e-1f + x2 * (8.3333333e-3f + x2 * (-1.9841270e-4f + x2 * 2.7557319e-6f)));
    const float c = 1.0f + x2 * (-0.5f + x2 * (4.1666667e-2f + x2 * (-1.3888889e-3f + x2 * (2.4801587e-5f + x2 * -2.7557319e-7f))));
    const int q = ((int)k) & 3;
    sn = (q == 0) ? s : (q == 1) ? c : (q == 2) ? -s : -c;
    cs = (q == 0) ? c : (q == 1) ? -s : (q == 2) ? -c : s;
}
enum { CM_WINA = 0, CM_WQB = 2, CM_WUK = 4, CM_WUV = 6, CM_WPOOL = 8, CM_WOUTA = 16, CM_WINC = 18, CM_WOUTC = 20, CM_WUP = 22, CM_WDOWN = 26, CM_FILL = 30 };
constexpr unsigned cm_attn(int i) { return (1u << (CM_WINA + i)) | (1u << (CM_WQB + i)) | (1u << (CM_WUK + i)) | (1u << (CM_WUV + i)) | (0xFu << (CM_WPOOL + 4 * i)) | (1u << (CM_WOUTA + i)) | (1u << (CM_FILL + i)); }
__device__ __forceinline__ TrMat conv_mat(KArgs* A_k, unsigned char* ws, int id) {
    TrMat t{};
    if (id < CM_WQB) { const int i = id - CM_WINA; t = TrMat{as_global(A_k->in[I_WINA]) + (size_t)i * DM * INA, DM, INA, as_global(A_k->in[I_GMIX]) + (size_t)(2 * i) * DM, (bf16_t*)(ws + WS_WINA) + (size_t)i * INA_PAD * DM, (size_t)DM, 1, nullptr}; }
    else if (id < CM_WUK) { const int i = id - CM_WQB; t = TrMat{as_global(A_k->in[I_WQB]) + (size_t)i * QR * 1536, QR, 1536, as_global(A_k->in[I_GQA]) + (size_t)i * QR, (bf16_t*)(ws + WS_WQB) + (size_t)i * 1536 * QR, (size_t)QR, 2, nullptr}; }
    else if (id < CM_WUV) { const int i = id - CM_WUK; t = TrMat{as_global(A_k->in[I_WUK]) + (size_t)i * KVR * 1024, KVR, 1024, nullptr, (bf16_t*)(ws + WS_WKV) + (size_t)i * 2048 * KVR, (size_t)KVR, 0, nullptr}; }
    else if (id < CM_WPOOL) { const int i = id - CM_WUV; t = TrMat{as_global(A_k->in[I_WUV]) + (size_t)i * KVR * 1024, KVR, 1024, nullptr, (bf16_t*)(ws + WS_WKV) + (size_t)i * 2048 * KVR + (size_t)1024 * KVR, (size_t)KVR, 0, nullptr}; }
    else if (id < CM_WOUTA) { const int ig = id - CM_WPOOL; t = TrMat{as_global(A_k->in[I_WPOOL]) + (size_t)ig * 256 * 256, 256, 256, nullptr, (bf16_t*)(ws + WS_WPOOL) + (size_t)ig * 256 * 256, (size_t)256, 0, as_global(A_k->in[I_PSCALE]) + (size_t)ig * 256}; }
    else if (id < CM_WINC) { const int i = id - CM_WOUTA; t = TrMat{as_global(A_k->in[I_WOUTA]) + (size_t)i * DM * DM, DM, DM, nullptr, (bf16_t*)(ws + WS_WOUTA) + (size_t)i * DM * DM, (size_t)DM, 0, nullptr}; }
    else if (id < CM_WOUTC) { const int i = id - CM_WINC; t = TrMat{as_global(A_k->in[I_WINC]) + (size_t)i * DM * INC, DM, INC, as_global(A_k->in[I_GMIX]) + (size_t)(2 * i + 1) * DM, (bf16_t*)(ws + WS_WINC) + (size_t)i * INC * DM, (size_t)DM, 0, nullptr}; }
    else if (id < CM_WUP) { const int i = id - CM_WOUTC; t = TrMat{as_global(A_k->in[I_WOUTC]) + (size_t)i * DM * DM, DM, DM, nullptr, (bf16_t*)(ws + WS_WOUTC) + (size_t)i * DM * DM, (size_t)DM, 0, nullptr}; }
    else if (id < CM_WDOWN) { const int l = id - CM_WUP; t = TrMat{as_global(A_k->in[I_WUP]) + (size_t)l * DM * DFF2, DM, DFF2, as_global(A_k->in[I_GFFN]) + (size_t)l * DM, (bf16_t*)(ws + WS_WUP) + (size_t)l * DFF2 * DM, (size_t)DM, 5, nullptr}; }
    else { const int l = id - CM_WDOWN; t = TrMat{as_global(A_k->in[I_WDOWN]) + (size_t)l * DFF * DM, DFF, DM, nullptr, (bf16_t*)(ws + WS_WDOWN) + (size_t)l * DM * DFF, (size_t)DFF, 0, nullptr}; }
    return t;
}
__device__ __forceinline__ void conv_run(const Frame& F, KArgs* A_k, unsigned mask, int widx, int nw) {
    LAS float* scr = (LAS float*)(F.lds + F.wave * 16384);
    const int lane = lau_v(lane_id()); unsigned char* ws = lau_s(A_k->ws);
    int first = widx;
#pragma unroll 1
    for (int id = 0; id < CM_FILL; ++id) {
        if (!((mask >> id) & 1u)) continue;
        const TrMat t = conv_mat(A_k, ws, id); const int n = (t.K / 64) * (t.N / 32);
        int it = first;
#pragma unroll 1
        for (; it < n; it += nw) tr_mat_item(t, it, scr, lane);
        first = it - n;
    }
#pragma unroll 1
    for (int i = 0; i < NEVEN; ++i) {
        if (!((mask >> (CM_FILL + i)) & 1u)) continue;
        const unsigned tix = (unsigned)(widx * 64 + lau_v(lane)), nthr = (unsigned)nw * 64u; const unsigned z_ = (unsigned)lau_v(0); const u32x4 z4 = {z_, z_, z_, z_};
        for (unsigned c = tix; c < (unsigned)((INA_PAD - INA) * DM / 8); c += nthr) *(u32x4*)((bf16_t*)(ws + WS_WINA) + ((size_t)i * INA_PAD + INA) * DM + (size_t)c * 8) = z4;
        for (unsigned c = tix; c < 4096u * 16u; c += nthr) {
            const int row = (int)(c / 16), d0 = (int)(c % 16) * 8, h = row / 512, r = row % 512;
            const float* s = as_global(A_k->in[I_WUK]) + (((size_t)i * KVR + r) * HEADS + h) * NOPE + d0; const f32x4 a = *(const f32x4*)s, b = *(const f32x4*)(s + 4);
            u32x4 o; o.x = cvt_pk_bf16(a[0], a[1]); o.y = cvt_pk_bf16(a[2], a[3]); o.z = cvt_pk_bf16(b[0], b[1]); o.w = cvt_pk_bf16(b[2], b[3]);
            *(u32x4*)((bf16_t*)(ws + WS_WUKBD) + (size_t)i * 4096 * 128 + (size_t)row * 128 + d0) = o; }
    }
}
constexpr unsigned CJ_PROLOGUE = cm_attn(0) | (1u << (CM_WUP + 0)) | (1u << (CM_WINC + 0)) | (1u << (CM_WINC + 1)) | (1u << (CM_WUP + 2));
constexpr unsigned CJ_INA0 = (1u << (CM_WOUTC + 0)), CJ_INA2 = (1u << (CM_WOUTC + 1));
constexpr unsigned CJ_UP0 = (1u << (CM_WDOWN + 0)), CJ_UP1 = (1u << (CM_WDOWN + 1)), CJ_UP2 = (1u << (CM_WDOWN + 2));
constexpr unsigned CJ_GLA1 = (1u << (CM_WUP + 1)) | cm_attn(1), CJ_GLA3 = (1u << (CM_WUP + 3)) | (1u << (CM_WDOWN + 3));
static_assert((CJ_PROLOGUE | CJ_INA0 | CJ_INA2 | CJ_UP0 | CJ_UP1 | CJ_UP2 | CJ_GLA1 | CJ_GLA3) == 0xFFFFFFFFu, "every matrix is converted exactly once");
static_assert((CJ_PROLOGUE ^ CJ_INA0 ^ CJ_INA2 ^ CJ_UP0 ^ CJ_UP1 ^ CJ_UP2 ^ CJ_GLA1 ^ CJ_GLA3) == 0xFFFFFFFFu, "every matrix is converted exactly once");
__device__ __forceinline__ void p0_prologue(const Frame& F, KArgs* A_k) {
    LAS float* scr = (LAS float*)(F.lds + F.wave * 16384);
    const int lane = lau_v(lane_id());
    const int gw = lau_si(F.vcu * NWAVES + F.wave), NGW = F.G * NWAVES;
    const size_t gt = (size_t)gw * 64 + lane, NGT = (size_t)NGW * 64;
    unsigned char* ws = lau_s(A_k->ws);
    conv_run(F, A_k, CJ_PROLOGUE, gw, NGW);
    for (size_t c = gt; c < (size_t)NPOS * 32; c += NGT) {
        const int pr = (int)(c / 32), j = (int)(c % 32); const float pos = (float)(pr < SEQ ? pr : PAST + (pr - SEQ));
        const float inv = exp2f(-((float)(2 * j) / 64.0f) * 13.287712379549449f); const float ang = pos * inv; float sn, cs; sincos_red(ang, sn, cs);
        ((f32x2*)(ws + WS_ROPE))[c] = (f32x2){cs, sn}; }
    for (size_t c = gt; c < (size_t)2048; c += NGT) {
        const float p0 = as_global(A_k->in[I_LB])[c], p1 = as_global(A_k->in[I_LB])[2048 + c], mx = fmaxf(p0, p1), e0 = expf(p0 - mx), e1 = expf(p1 - mx), s0 = e0 / (e0 + e1), s1 = e1 / (e0 + e1);
        float* lb = (float*)(ws + WS_LBS); lb[c] = fminf(fmaxf(s0 - s0, 0.f), 1.f); lb[2048 + c] = fminf(fmaxf((s0 + s1) - s0, 0.f), 1.f); }
    for (int r0 = gw; r0 < MT; r0 += 3 * NGW) {
        f32x4 v[3][8];
#pragma unroll
        for (int k = 0; k < 3; ++k) { const int r = r0 + k * NGW; if (r < MT) {
            const float* xr = r < MP ? as_global(A_k->in[I_XP]) + (size_t)r * DM : as_global(A_k->in[I_XS]) + (size_t)(r - MP) * DM;
#pragma unroll
            for (int j = 0; j < 8; ++j) v[k][j] = *(const f32x4*)(xr + (64 * j + lane) * 4); } }
        asm volatile("" ::: "memory");
#pragma unroll
        for (int k = 0; k < 3; ++k) { const int r = r0 + k * NGW; if (r < MT) {
            bf16_t* xb = (bf16_t*)(ws + WS_XB) + (size_t)r * DM; float s = 0.f;
#pragma unroll
            for (int j = 0; j < 8; ++j) { const f32x4 w = v[k][j]; s += (w[0] * w[0] + w[1] * w[1]) + (w[2] * w[2] + w[3] * w[3]);
                u32x2 o; o.x = cvt_pk_bf16(w[0], w[1]); o.y = cvt_pk_bf16(w[2], w[3]); *(u32x2*)(xb + (64 * j + lane) * 4) = o; }
            s = wave_sum(s); if (lane == 0) ((float*)(ws + WS_RSTD))[r] = rsqrtf(s * (1.0f / DM) + EPS); } }
    }
}
#define EPI_ROWS(u) { const int _l = lane_id(); fr = _l & 15; fq = _l >> 4; } const int row0 = (u).pm * 256 + wr * 64 + fr
#define EPI_ROW(ai, m) (row0 + (ai) * 128 + (m) * 16)

struct EpiInA {
    static constexpr bool PERM = false, PRE = true;
    unsigned char* ws; float* out; int li; LAS unsigned char* lds;
    __device__ __forceinline__ void pre(LAS unsigned char* l, const pg8::Unit& u, int wid) const {
        if (wid == 4) { const float* src = (const float*)(ws + WS_RSTD) + (size_t)(4 * li) * MT + u.pm * 256 + lane_id() * 4;
            __builtin_amdgcn_global_load_lds((const unsigned*)src, (LAS unsigned*)(l + EPI_RS + u.par * 1024), 16, 0, 0); }
    }
    __device__ __forceinline__ void operator()(const f32x4 (&acc)[2][2][4][2], const pg8::Unit& u, int wr, int wc, int fr, int fq) const {
        EPI_ROWS(u); const int pn = u.pn, cb = wc * 32 + 4 * fq;
        const LAS float* rsl = (const LAS float*)(lds + EPI_RS + u.par * 1024) + wr * 64 + fr; float* ssqq = (float*)(ws + WS_SSQQ) + (size_t)(li * 8 + (pn & 1) * 4 + wc) * MT; float* ssqkv = (float*)(ws + WS_SSQKV) + (size_t)(li * 8 + (pn & 1) * 4 + wc) * MT;
        bf16_t* cqb = (bf16_t*)(ws + WS_CQB); bf16_t* zb = (bf16_t*)(ws + WS_ZB);
#pragma unroll
        for (int ai = 0; ai < 2; ++ai)
#pragma unroll
            for (int m = 0; m < 4; ++m) {
                const int r = EPI_ROW(ai, m); const float rs = rsl[ai * 128 + m * 16];
                f32x4 v[2][2]; float sq = 0.f;
#pragma unroll
                for (int bj = 0; bj < 2; ++bj)
#pragma unroll
                    for (int n = 0; n < 2; ++n) { v[bj][n] = acc[ai][bj][m][n] * rs; sq += (v[bj][n][0] * v[bj][n][0] + v[bj][n][1] * v[bj][n][1]) + (v[bj][n][2] * v[bj][n][2] + v[bj][n][3] * v[bj][n][3]); }
                if (pn < 2) {
                    bf16_t* o = cqb + (size_t)r * QR + pn * 256 + cb;
#pragma unroll
                    for (int bj = 0; bj < 2; ++bj)
#pragma unroll
                        for (int n = 0; n < 2; ++n) { u32x2 w; w.x = cvt_pk_bf16(v[bj][n][0], v[bj][n][1]); w.y = cvt_pk_bf16(v[bj][n][2], v[bj][n][3]); *(u32x2*)(o + bj * 128 + n * 16) = w; }
                    sq = row4_sum(sq); if (fq == 0) ssqq[r] = sq;
                } else if (pn < 4) {
                    float* o = (r < MP ? out + O_LATP + ((size_t)li * MP + r) * KVR : out + O_LATS + ((size_t)li * MS + (r - MP)) * KVR) + (pn - 2) * 256 + cb;
#pragma unroll
                    for (int bj = 0; bj < 2; ++bj)
#pragma unroll
                        for (int n = 0; n < 2; ++n) *(f32x4*)(o + bj * 128 + n * 16) = v[bj][n];
                    sq = row4_sum(sq); if (fq == 0) ssqkv[r] = sq;
                } else if (pn < 8) {
                    bf16_t* o = zb + (size_t)r * POOLW + (pn - 4) * 256 + cb;
#pragma unroll
                    for (int bj = 0; bj < 2; ++bj)
#pragma unroll
                        for (int n = 0; n < 2; ++n) { u32x2 w; w.x = cvt_pk_bf16(v[bj][n][0], v[bj][n][1]); w.y = cvt_pk_bf16(v[bj][n][2], v[bj][n][3]); *(u32x2*)(o + bj * 128 + n * 16) = w; }
                    float* po = nullptr;
                    if (r < MP) { const int t = r & (SEQ - 1); if (t >= SEQ - POOLKEEP) po = out + O_POOLP + (((size_t)li * BATCH + (r >> 11)) * POOLKEEP + (t - (SEQ - POOLKEEP))) * POOLW; }
                    else { const int rr = r - MP, t = rr & (DECS - 1); if (t >= DECS - POOLKEEP) po = out + O_POOLS + (((size_t)li * DECB + (rr >> 6)) * POOLKEEP + (t - (DECS - POOLKEEP))) * POOLW; }
                    if (po) { po += (pn - 4) * 256 + cb;
#pragma unroll
                        for (int bj = 0; bj < 2; ++bj)
#pragma unroll
                            for (int n = 0; n < 2; ++n) *(f32x4*)(po + bj * 128 + n * 16) = v[bj][n]; }
                } else {
                    float* o = (r < MP ? out + O_KPEP + ((size_t)li * MP + r) * ROPE : out + O_KPES + ((size_t)li * MS + (r - MP)) * ROPE) + cb;
                    if (cb < 64) {
#pragma unroll
                        for (int n = 0; n < 2; ++n) *(f32x4*)(o + n * 16) = v[0][n]; }
                }
            }
    }
};

__device__ __forceinline__ void post_a_phase(const Frame& F, KArgs* A_, int li) {
    const int lane = lau_v(lane_id()); struct { unsigned char* ws; float* out; } A{lau_s(A_->ws), lau_s(A_->out)};
    const int gw = lau_si(F.vcu * NWAVES + F.wave), NGW = F.G * NWAVES;
    const float* ssqkv = (const float*)(A.ws + WS_SSQKV) + (size_t)li * 8 * MT; const float* gk = as_global(A_->in[I_GKVA]) + (size_t)li * KVR;
    bf16_t* kvn = (bf16_t*)(A.ws + WS_KVN); bf16_t* kp = (bf16_t*)(A.ws + WS_KP); const f32x2* rope = (const f32x2*)(A.ws + WS_ROPE);
    const f32x4 g0 = *(const f32x4*)(gk + lane * 8), g1 = *(const f32x4*)(gk + lane * 8 + 4);
    for (int r0 = gw; r0 < MT; r0 += 3 * NGW) {
        float pq[3][8]; f32x4 av[3], bv[3]; float x1[3] = {}, x2[3] = {}; f32x2 cs[3] = {};
#pragma unroll
        for (int k = 0; k < 3; ++k) { const int r = r0 + k * NGW; if (r < MT) {
#pragma unroll
            for (int s = 0; s < 8; ++s) pq[k][s] = ssqkv[(size_t)s * MT + r];
            const float* lp = (r < MP ? A.out + O_LATP + ((size_t)li * MP + r) * KVR : A.out + O_LATS + ((size_t)li * MS + (r - MP)) * KVR) + lane * 8;
            av[k] = *(const f32x4*)lp; bv[k] = *(const f32x4*)(lp + 4);
            const float* kq = (r < MP ? A.out + O_KPEP + ((size_t)li * MP + r) * ROPE : A.out + O_KPES + ((size_t)li * MS + (r - MP)) * ROPE);
            if (lane < 32) { x1[k] = kq[lane]; x2[k] = kq[32 + lane]; cs[k] = rope[(size_t)rope_row(r) * 32 + lane]; } } }
        asm volatile("" ::: "memory");
#pragma unroll
        for (int k = 0; k < 3; ++k) { const int r = r0 + k * NGW; if (r < MT) {
            float sk = 0.f;
#pragma unroll
            for (int s = 0; s < 8; ++s) sk += pq[k][s];
            const float rs = rsqrtf(sk * (1.0f / KVR) + EPS);
            float* lp = (r < MP ? A.out + O_LATP + ((size_t)li * MP + r) * KVR : A.out + O_LATS + ((size_t)li * MS + (r - MP)) * KVR) + lane * 8;
            const f32x4 a = av[k] * rs * g0, b = bv[k] * rs * g1;
            *(f32x4*)lp = a; *(f32x4*)(lp + 4) = b;
            u32x4 o; o.x = cvt_pk_bf16(a[0], a[1]); o.y = cvt_pk_bf16(a[2], a[3]); o.z = cvt_pk_bf16(b[0], b[1]); o.w = cvt_pk_bf16(b[2], b[3]);
            *(u32x4*)(kvn + (size_t)r * KVW + lane * 8) = o;
            float* kq = (r < MP ? A.out + O_KPEP + ((size_t)li * MP + r) * ROPE : A.out + O_KPES + ((size_t)li * MS + (r - MP)) * ROPE);
            if (lane < 32) {
                const float o1 = x1[k] * cs[k].x - x2[k] * cs[k].y, o2 = x1[k] * cs[k].y + x2[k] * cs[k].x;
                kq[lane] = o1; kq[32 + lane] = o2;
                const unsigned pk = cvt_pk_bf16(o1, o2);
                *(unsigned*)(kvn + (size_t)r * KVW + KVR + 2 * lane) = pk;
                if (r < MP) {
#pragma unroll
                    for (int h = 0; h < HEADS; ++h) *(unsigned*)(kp + ((size_t)r * HEADS + h) * QKD + NOPE + 2 * lane) = pk; }
            } } }
    }
}

__device__ __forceinline__ void unpk8(const u32x4 q, float (&z)[8]) { z[0] = bf_lo(q.x); z[1] = bf_hi(q.x); z[2] = bf_lo(q.y); z[3] = bf_hi(q.y); z[4] = bf_lo(q.z); z[5] = bf_hi(q.z); z[6] = bf_lo(q.w); z[7] = bf_hi(q.w); }
template <int W, int KIND> __device__ __forceinline__ void pool_item(const bf16_t* zrow0  , const float* st  , bf16_t* prow0, int t0, bool prompt) {
    u32x4 zc[16]; u32x4 pp[KIND == 0 ? W - 1 : 1]; f32x4 sa[KIND == 2 ? W - 1 : 1], sb[KIND == 2 ? W - 1 : 1];
#pragma unroll
    for (int tt = 0; tt < 16; ++tt) zc[tt] = *(const u32x4*)(zrow0 + (size_t)tt * POOLW);
#pragma unroll
    for (int j = 1; j < W; ++j) {
        if (KIND == 0) pp[j - 1] = *(const u32x4*)(zrow0 - (size_t)j * POOLW);
        if (KIND == 2) { sa[j - 1] = *(const f32x4*)(st - (size_t)(j - 1) * POOLW); sb[j - 1] = *(const f32x4*)(st - (size_t)(j - 1) * POOLW + 4); } }
    asm volatile("" ::: "memory");
    float pz[W - 1][8];
#pragma unroll
    for (int j = 1; j < W; ++j) {
        if (KIND == 0) unpk8(pp[j - 1], pz[j - 1]);
        else if (KIND == 2) { pz[j - 1][0] = sa[j - 1][0]; pz[j - 1][1] = sa[j - 1][1]; pz[j - 1][2] = sa[j - 1][2]; pz[j - 1][3] = sa[j - 1][3]; pz[j - 1][4] = sb[j - 1][0]; pz[j - 1][5] = sb[j - 1][1]; pz[j - 1][6] = sb[j - 1][2]; pz[j - 1][7] = sb[j - 1][3]; }
        else {
#pragma unroll
            for (int e = 0; e < 8; ++e) pz[j - 1][e] = 0.f; } }
    float sum[8];
#pragma unroll
    for (int e = 0; e < 8; ++e) sum[e] = 0.f;
#pragma unroll
    for (int j = 1; j < W; ++j)
#pragma unroll
        for (int e = 0; e < 8; ++e) sum[e] += pz[j - 1][e];
#pragma unroll
    for (int tt = 0; tt < 16; ++tt) {
        float z[8], zo[8]; unpk8(zc[tt], z);
        if (tt - W + 1 >= 0) unpk8(zc[tt - W + 1 >= 0 ? tt - W + 1 : 0], zo);
        else {
#pragma unroll
            for (int e = 0; e < 8; ++e) zo[e] = pz[(W - 1 - tt >= 1 ? W - 1 - tt : 1) - 1][e]; }
        const int t = t0 + tt; const float cnt = prompt ? (float)((t + 1) < W ? (t + 1) : W) : (float)W; const float ic = 1.0f / cnt;
        float p[8];
#pragma unroll
        for (int e = 0; e < 8; ++e) { sum[e] += z[e]; p[e] = sum[e] * ic - z[e]; sum[e] -= zo[e]; }
        u32x4 o; o.x = cvt_pk_bf16(p[0], p[1]); o.y = cvt_pk_bf16(p[2], p[3]); o.z = cvt_pk_bf16(p[4], p[5]); o.w = cvt_pk_bf16(p[6], p[7]);
        *(u32x4*)(prow0 + (size_t)tt * POOLW) = o;
    }
}
template <int W> __device__ __forceinline__ void pool_item_w(const bf16_t* zrow0, const float* st, bf16_t* prow0, int t0, bool prompt) {
    if (t0 > 0) pool_item<W, 0>(zrow0, st, prow0, t0, prompt);
    else if (prompt) pool_item<W, 1>(zrow0, st, prow0, t0, prompt);
    else pool_item<W, 2>(zrow0, st, prow0, t0, prompt);
}
__device__ __forceinline__ void pool_prep_phase(const Frame& F, KArgs* A_, int li) {
    const int lane = lau_v(lane_id()); struct { unsigned char* ws; } A{lau_s(A_->ws)};
    const int gw = lau_si(F.vcu * NWAVES + F.wave), NGW = F.G * NWAVES;
    const size_t gt = (size_t)gw * 64 + lane, NGT = (size_t)NGW * 64;
    const bf16_t* zb = (const bf16_t*)(A.ws + WS_ZB); bf16_t* pb = (bf16_t*)(A.ws + WS_PB);
    const float* sp = as_global(A_->in[I_SPOOL]) + (size_t)li * DECB * POOLKEEP * POOLW;
    for (size_t it = gt; it < (size_t)(MT / 16) * 128; it += NGT) {
        const int rb = (int)(it / 128), cg = (int)(it % 128), col = cg * 8, wsel = cg >> 5;
        const int r0 = rb * 16; const bool prompt = r0 < MP;
        const int t0 = prompt ? (r0 & (SEQ - 1)) : ((r0 - MP) & (DECS - 1));
        const int bs = prompt ? 0 : (r0 - MP) >> 6;
        const bf16_t* zrow0 = zb + (size_t)r0 * POOLW + col; bf16_t* prow0 = pb + (size_t)r0 * POOLW + col;
        const float* st = sp + ((size_t)bs * POOLKEEP + (POOLKEEP - 1)) * POOLW + col;
        if (wsel == 0) pool_item_w<2>(zrow0, st, prow0, t0, prompt);
        else if (wsel == 1) pool_item_w<4>(zrow0, st, prow0, t0, prompt);
        else if (wsel == 2) pool_item_w<8>(zrow0, st, prow0, t0, prompt);
        else pool_item_w<16>(zrow0, st, prow0, t0, prompt);
    }
}
__device__ __forceinline__ u32x4 pack8(const f32x4 a, const f32x4 b) { u32x4 w; w.x = cvt_pk_bf16(a[0], a[1]); w.y = cvt_pk_bf16(a[2], a[3]); w.z = cvt_pk_bf16(b[0], b[1]); w.w = cvt_pk_bf16(b[2], b[3]); return w; }

template <int MODE> struct EpiStore {
    static constexpr bool PERM = true, PRE = false;
    unsigned char* ws;
    __device__ __forceinline__ void operator()(const f32x4 (&acc)[2][2][4][2], const pg8::Unit& u, int wr, int wc, int fr, int fq) const {
        EPI_ROWS(u); const int cl = wc * 32 + 8 * fq;
#pragma unroll
        for (int bj = 0; bj < 2; ++bj) {
            bf16_t* base; size_t ldc;
            if (MODE == 0) { if (u.pn < 4) { base = (bf16_t*)(ws + WS_KP) + (2 * u.pn + bj) * QKD; ldc = HEADS * QKD; } else { base = (bf16_t*)(ws + WS_VP) + (u.pn - 4) * 256 + bj * 128; ldc = HEADS * VD; } }
            else if (MODE == 1) { base = (bf16_t*)(ws + WS_QS) + (u.pn >> 1) * KVW + (u.pn & 1) * 256 + bj * 128; ldc = HEADS * KVW; }
            else if (MODE == 2) { base = (bf16_t*)(ws + WS_YCAT) + 1024 + u.pn * 256 + bj * 128; ldc = DM; }
            else { base = (bf16_t*)(ws + WS_YCAT) + (size_t)MP * DM + u.pn * 256 + bj * 128; ldc = DM; }
#pragma unroll
            for (int ai = 0; ai < 2; ++ai)
#pragma unroll
                for (int m = 0; m < 4; ++m) *(u32x4*)(base + (size_t)EPI_ROW(ai, m) * ldc + cl) = pack8(acc[ai][bj][m][0], acc[ai][bj][m][1]);
        }
    }
};

struct EpiQ {
    static constexpr bool PERM = true, PRE = true;
    unsigned char* ws; int li; LAS unsigned char* lds;
    __device__ __forceinline__ void pre(LAS unsigned char* l, const pg8::Unit& u, int wid) const {
        const float* src = (const float*)(ws + WS_SSQQ) + ((size_t)li * 8 + wid) * MT + u.pm * 256 + lane_id() * 4;
        __builtin_amdgcn_global_load_lds((const unsigned*)src, (LAS unsigned*)(l + EPI_LDS + u.par * 8192 + wid * 1024), 16, 0, 0);
    }
    __device__ __forceinline__ void operator()(const f32x4 (&acc)[2][2][4][2], const pg8::Unit& u, int wr, int wc, int fr, int fq) const {
        EPI_ROWS(u); const LAS float* sql = (const LAS float*)(lds + EPI_LDS + u.par * 8192) + wr * 64 + fr; const f32x4* rope = (const f32x4*)(ws + WS_ROPE);
        bf16_t* qp = (bf16_t*)(ws + WS_QP); bf16_t* qns = (bf16_t*)(ws + WS_QNS); bf16_t* qs = (bf16_t*)(ws + WS_QS);
        int hh[2], cc[2];
#pragma unroll
        for (int bj = 0; bj < 2; ++bj) { const int c = u.pn * 256 + bj * 128 + wc * 32 + 8 * fq; hh[bj] = c / QKD; cc[bj] = c - hh[bj] * QKD; }
        f32x4 T[2][2] = {}, Tn[2][2] = {};
#define EPIQ_ROPE(dst, ai_, m_) do { const int rr_ = rope_row(EPI_ROW(ai_, m_)); _Pragma("unroll") for (int bj = 0; bj < 2; ++bj) if (cc[bj] >= NOPE) { \
            const size_t ix_ = ((size_t)rr_ * 32 + ((cc[bj] - NOPE) >> 1)) >> 1; dst[bj][0] = rope[ix_]; dst[bj][1] = rope[ix_ + 1]; } } while (0)
        EPIQ_ROPE(T, 0, 0);
#pragma unroll
        for (int k = 0; k < 8; ++k) {
            const int ai = k >> 2, m = k & 3;
            if (k < 7) EPIQ_ROPE(Tn, (k + 1) >> 2, (k + 1) & 3);
            asm volatile("" ::: "memory");
            const int r = EPI_ROW(ai, m); float sk = 0.f;
#pragma unroll
            for (int s = 0; s < 8; ++s) sk += sql[s * 256 + ai * 128 + m * 16];
            const float rs = rsqrtf(sk * (1.0f / QR) + EPS);
#pragma unroll
            for (int bj = 0; bj < 2; ++bj) {
                const int h = hh[bj], c2 = cc[bj];
                f32x4 a = acc[ai][bj][m][0] * rs, b = acc[ai][bj][m][1] * rs;
                if (c2 >= NOPE) {
                    const f32x4 t0 = T[bj][0], t1 = T[bj][1];
                    f32x4 ra, rb;
                    ra[0] = a[0] * t0[0] - a[1] * t0[1]; ra[1] = a[0] * t0[1] + a[1] * t0[0]; ra[2] = a[2] * t0[2] - a[3] * t0[3]; ra[3] = a[2] * t0[3] + a[3] * t0[2];
                    rb[0] = b[0] * t1[0] - b[1] * t1[1]; rb[1] = b[0] * t1[1] + b[1] * t1[0]; rb[2] = b[2] * t1[2] - b[3] * t1[3]; rb[3] = b[2] * t1[3] + b[3] * t1[2];
                    a = ra; b = rb;
                }
                const u32x4 w = pack8(a, b);
                if (r < MP) *(u32x4*)(qp + ((size_t)r * HEADS + h) * QKD + c2) = w;
                else if (c2 < NOPE) *(u32x4*)(qns + (size_t)(r - MP) * 1024 + h * NOPE + c2) = w;
                else *(u32x4*)(qs + ((size_t)(r - MP) * HEADS + h) * KVW + KVR + (c2 - NOPE)) = w;
            }
#pragma unroll
            for (int bj = 0; bj < 2; ++bj) { T[bj][0] = Tn[bj][0]; T[bj][1] = Tn[bj][1]; }
        }
#undef EPIQ_ROPE
    }
};

template <int NM> struct EpiRes {
    static constexpr bool PERM = true, PRE = false;
    unsigned char* ws; const float* xp; const float* xs; int first; int nidx;
    __device__ __forceinline__ void operator()(const f32x4 (&acc)[2][2][NM][2], const pg8::Unit& u, int wr, int wc, int fr, int fq) const {
        { const int _l = lane_id(); fr = _l & 15; fq = _l >> 4; } const int row0 = u.pm * (64 * NM) + wr * (16 * NM) + fr;
        const int c0 = u.pn * 256 + wc * 32 + 8 * fq; bf16_t* XB = (bf16_t*)(ws + WS_XB); float* ssq = (float*)(ws + WS_SSQP) + (size_t)(nidx * 32 + u.pn * 4 + wc) * MT;
        u32x4 q[2][NM][2];
        if (!first) {
#pragma unroll
            for (int ai = 0; ai < 2; ++ai)
#pragma unroll
                for (int m = 0; m < NM; ++m)
#pragma unroll
                    for (int bj = 0; bj < 2; ++bj) q[ai][m][bj] = *(const u32x4*)(XB + (size_t)(row0 + ai * (32 * NM) + m * 16) * DM + c0 + bj * 128);
            asm volatile("" ::: "memory");
        }
        float sqv[2][NM];
#pragma unroll
        for (int ai = 0; ai < 2; ++ai)
#pragma unroll
            for (int m = 0; m < NM; ++m) {
                const int r = row0 + ai * (32 * NM) + m * 16; float sq = 0.f;
#pragma unroll
                for (int bj = 0; bj < 2; ++bj) { const int c = c0 + bj * 128; f32x4 a, b;
                    if (first) { const float* xo = (r < MP ? xp + (size_t)r * DM : xs + (size_t)(r - MP) * DM) + c; a = *(const f32x4*)xo; b = *(const f32x4*)(xo + 4); }
                    else { const u32x4 w = q[ai][m][bj]; a = (f32x4){bf_lo(w.x), bf_hi(w.x), bf_lo(w.y), bf_hi(w.y)}; b = (f32x4){bf_lo(w.z), bf_hi(w.z), bf_lo(w.w), bf_hi(w.w)}; }
                    a = a + acc[ai][bj][m][0]; b = b + acc[ai][bj][m][1];
                    *(u32x4*)(XB + (size_t)r * DM + c) = pack8(a, b);
                    sq += ((a[0] * a[0] + a[1] * a[1]) + (a[2] * a[2] + a[3] * a[3])) + ((b[0] * b[0] + b[1] * b[1]) + (b[2] * b[2] + b[3] * b[3])); }
                sqv[ai][m] = sq;
            }
#pragma unroll
        for (int ai = 0; ai < 2; ++ai)
#pragma unroll
            for (int m = 0; m < NM; ++m) { const float sq = row4_sum(sqv[ai][m]); if (fq == 0) ssq[row0 + ai * (32 * NM) + m * 16] = sq; }
    }
};

__device__ __forceinline__ float dpp_ror1(float x) { return __builtin_bit_cast(float, __builtin_amdgcn_update_dpp(0, __builtin_bit_cast(int, x), 0x121, 0xf, 0xf, true)); }
__device__ __forceinline__ float dpp_ror2(float x) { return __builtin_bit_cast(float, __builtin_amdgcn_update_dpp(0, __builtin_bit_cast(int, x), 0x122, 0xf, 0xf, true)); }
struct EpiUp {
    static constexpr bool PERM = true, PRE = true;
    unsigned char* ws; float* out; const float* cw; const float* cb; const float* past; LAS unsigned char* lds; int layer;
    __device__ __forceinline__ void pre(LAS unsigned char* l, const pg8::Unit& u, int wid) const {
        const int lane = lane_id();
        if (wid < 4) { const int seg = 2 * wid + (lane >> 5), bj = seg & 1; const float* src = (seg < 6 ? cw + (size_t)(seg >> 1) * DFF2 : cb) + bj * DFF + u.pn * 128 + (lane & 31) * 4;
            __builtin_amdgcn_global_load_lds((const unsigned*)src, (LAS unsigned*)(l + EPI_CW + u.par * 4096 + wid * 1024), 16, 0, 0); }
        else if (wid == 4) { const float* src = (const float*)(ws + WS_RSTD) + (size_t)(2 * layer + 1) * MT + u.pm * 256 + lane * 4;
            __builtin_amdgcn_global_load_lds((const unsigned*)src, (LAS unsigned*)(l + EPI_RS + u.par * 1024), 16, 0, 0); }
    }
    __device__ __forceinline__ void operator()(const f32x4 (&acc_)[2][2][4][2], const pg8::Unit& u, int wr, int wc, int fr, int fq) const {
        f32x4 (&acc)[2][2][4][2] = const_cast<f32x4 (&)[2][2][4][2]>(acc_);
        EPI_ROWS(u); const LAS float* rsl = (const LAS float*)(lds + EPI_RS + u.par * 1024) + wr * 64 + fr; const LAS float* cwl = (const LAS float*)(lds + EPI_CW + u.par * 4096) + wc * 32 + 8 * fq; bf16_t* act = (bf16_t*)(ws + WS_ACT); float* halo = (float*)(ws + WS_HALO) + (size_t)u.pm * 4 * DFF2;
        const int ch = u.pn * 128 + wc * 32 + 8 * fq;
        const bool prompt = u.pm < MP / 256;
        LAS float* hl = (LAS float*)(lds + EPI_LDS);
#pragma unroll
        for (int ai = 0; ai < 2; ++ai)
#pragma unroll
            for (int m = 0; m < 4; ++m) {
                const int r = EPI_ROW(ai, m); const float rs = rsl[ai * 128 + m * 16];
#pragma unroll
                for (int bj = 0; bj < 2; ++bj) { acc[ai][bj][m][0] = acc[ai][bj][m][0] * rs; acc[ai][bj][m][1] = acc[ai][bj][m][1] * rs; }
                float* so = nullptr;
                if (prompt) { const int t = r & (SEQ - 1); if (t >= SEQ - 2) so = out + O_CVP + (((size_t)layer * BATCH + (r >> 11)) * 2 + (t - (SEQ - 2))) * DFF2; }
                else { const int rr = r - MP, t = rr & (DECS - 1); if (t >= DECS - 2) so = out + O_CVS + (((size_t)layer * DECB + (rr >> 6)) * 2 + (t - (DECS - 2))) * DFF2; }
                if (so) {
#pragma unroll
                    for (int bj = 0; bj < 2; ++bj) { *(f32x4*)(so + bj * DFF + ch) = acc[ai][bj][m][0]; *(f32x4*)(so + bj * DFF + ch + 4) = acc[ai][bj][m][1]; } }
                if (m == 3 && fr >= 14) {
#pragma unroll
                    for (int bj = 0; bj < 2; ++bj) { LAS float* d = hl + ((((ai * 2 + wr) * 4 + wc) * 2 + (fr - 14)) * 4 + fq) * 16 + bj * 8; *(LAS f32x4*)d = acc[ai][bj][m][0]; *(LAS f32x4*)(d + 4) = acc[ai][bj][m][1]; } }
                if (prompt) { int sel = -1; if (ai == 0 && wr == 0 && m == 0 && fr < 2) sel = fr; if (ai == 1 && wr == 1 && m == 3 && fr >= 14) sel = fr - 12;
                    if (sel >= 0) {
#pragma unroll
                        for (int bj = 0; bj < 2; ++bj) { float* d = halo + (size_t)sel * DFF2 + bj * DFF + ch; *(f32x4*)d = acc[ai][bj][m][0]; *(f32x4*)(d + 4) = acc[ai][bj][m][1]; } } }
            }
        asm volatile("s_waitcnt lgkmcnt(0)" ::: "memory"); __builtin_amdgcn_s_barrier(); asm volatile("" ::: "memory");
#pragma unroll
        for (int ai = 0; ai < 2; ++ai) {
            const int blk0 = u.pm * 256 + ai * 128 + wr * 64;
#pragma unroll
            for (int eh = 0; eh < 2; ++eh) {
                f32x4 w[2][3], bia[2], hm1[2], hm2[2];
#pragma unroll
                for (int bj = 0; bj < 2; ++bj) {
                    const int cc = bj * DFF + ch + 4 * eh;
#pragma unroll
                    for (int j = 0; j < 3; ++j) w[bj][j] = *(const LAS f32x4*)(cwl + (2 * j + bj) * 128 + 4 * eh);
                    bia[bj] = *(const LAS f32x4*)(cwl + (6 + bj) * 128 + 4 * eh);
                    if (!prompt) { const float* ps = past + (size_t)((blk0 - MP) >> 6) * 2 * DFF2 + cc; hm2[bj] = *(const f32x4*)ps; hm1[bj] = *(const f32x4*)(ps + DFF2); }
                    else if (ai == 0 && wr == 0) { hm1[bj] = (f32x4){0.f, 0.f, 0.f, 0.f}; hm2[bj] = hm1[bj]; }
                    else { const int pb = ai * 2 + wr - 1; const LAS float* s = hl + (((pb * 4 + wc) * 2 + 0) * 4 + fq) * 16 + bj * 8 + 4 * eh; hm2[bj] = *(const LAS f32x4*)s; hm1[bj] = *(const LAS f32x4*)(s + 64); }
                }
                u32x2 pk[4]; f32x4 pr1[2], pr2[2];
#pragma unroll
                for (int bj = 0; bj < 2; ++bj)
#pragma unroll
                    for (int e = 0; e < 4; ++e) { pr1[bj][e] = hm1[bj][e]; pr2[bj][e] = (fr == 0) ? hm2[bj][e] : hm1[bj][e]; }
#pragma unroll
                for (int m = 0; m < 4; ++m) {
                    f32x4 c[2];
#pragma unroll
                    for (int bj = 0; bj < 2; ++bj) {
                        const f32x4 h0 = acc[ai][bj][m][eh]; f32x4 p1, p2;
#pragma unroll
                        for (int e = 0; e < 4; ++e) {
                            const float r1 = dpp_ror1(h0[e]), r2 = dpp_ror2(h0[e]);
                            p1[e] = (fr >= 1) ? r1 : pr1[bj][e]; p2[e] = (fr >= 2) ? r2 : pr2[bj][e];
                            pr1[bj][e] = r1; pr2[bj][e] = r2;
                        }
                        c[bj] = bia[bj] + w[bj][0] * p2 + w[bj][1] * p1 + w[bj][2] * h0;
                    }
                    f32x4 o;
#pragma unroll
                    for (int e = 0; e < 4; ++e) o[e] = silu_f(c[0][e]) * c[1][e];
                    pk[m].x = cvt_pk_bf16(o[0], o[1]); pk[m].y = cvt_pk_bf16(o[2], o[3]);
                }
#pragma unroll
                for (int m = 0; m < 4; ++m) *(u32x2*)(act + (size_t)(blk0 + 16 * m + fr) * DFF + ch + 4 * eh) = pk[m];
            }
        }
    }
};

struct EpiInC {
    static constexpr bool PERM = true, PRE = true;
    unsigned char* ws; int layer; LAS unsigned char* lds;
    __device__ __forceinline__ void pre(LAS unsigned char* l, const pg8::Unit& u, int wid) const {
        if (wid == 4) { const float* src = (const float*)(ws + WS_RSTD) + (size_t)(2 * layer) * MT + u.pm * 256 + lane_id() * 4;
            __builtin_amdgcn_global_load_lds((const unsigned*)src, (LAS unsigned*)(l + EPI_RS + u.par * 1024), 16, 0, 0); }
    }
    __device__ __forceinline__ void operator()(const f32x4 (&acc)[2][2][4][2], const pg8::Unit& u, int wr, int wc, int fr, int fq) const {
        EPI_ROWS(u); const LAS float* rsl = (const LAS float*)(lds + EPI_RS + u.par * 1024) + wr * 64 + fr; const int sec = u.pn >> 3, c0 = (u.pn & 7) * 256 + wc * 32 + 8 * fq;
        const float* lbs = (const float*)(ws + WS_LBS) + (layer >> 1) * 2048;
        f32x4 lb[2][2] = {};
        if (sec == 1) {
#pragma unroll
            for (int bj = 0; bj < 2; ++bj) { lb[bj][0] = *(const f32x4*)(lbs + c0 + bj * 128); lb[bj][1] = *(const f32x4*)(lbs + c0 + bj * 128 + 4); }
            asm volatile("" ::: "memory"); }
#pragma unroll
        for (int ai = 0; ai < 2; ++ai)
#pragma unroll
            for (int m = 0; m < 4; ++m) {
                const int r = EPI_ROW(ai, m); const float rs = rsl[ai * 128 + m * 16];
#pragma unroll
                for (int bj = 0; bj < 2; ++bj) { f32x4 a = acc[ai][bj][m][0] * rs, b = acc[ai][bj][m][1] * rs; const int c = c0 + bj * 128;
                    if (sec == 1) { const f32x4 l0 = lb[bj][0], l1 = lb[bj][1];
#pragma unroll
                        for (int e = 0; e < 4; ++e) { a[e] = (1.0f - l0[e]) * sigmoid_f(-a[e]); b[e] = (1.0f - l1[e]) * sigmoid_f(-b[e]); }
                        bf16_t* o = (bf16_t*)(ws + WS_FG) + (size_t)r * 2048 + c; *(u32x4*)o = pack8(a, b); }
                    else { if (sec != 2) {
#pragma unroll
                            for (int e = 0; e < 4; ++e) { a[e] = silu_f(a[e]); b[e] = silu_f(b[e]); } }
                        bf16_t* o = (bf16_t*)(ws + (sec == 0 ? WS_QSIL : sec == 2 ? WS_VB : WS_GS)) + (size_t)r * 2048 + c; *(u32x4*)o = pack8(a, b); }
                }
            }
    }
};

__device__ __forceinline__ void act_fix_phase(const Frame& F, KArgs* A_, int layer) {
    const int lane = lau_v(lane_id()); unsigned char* ws = lau_s(A_->ws);
    const int gw = lau_si(F.vcu * NWAVES + F.wave), NGW = F.G * NWAVES;
    const size_t gt = (size_t)gw * 64 + lane, NGT = (size_t)NGW * 64;
    const float* halo = (const float*)(ws + WS_HALO); bf16_t* act = (bf16_t*)(ws + WS_ACT);
    const float* cw = as_global(A_->in[I_CONVW]) + (size_t)layer * 3 * DFF2; const float* cbias = as_global(A_->in[I_CONVB]) + (size_t)layer * DFF2;
    constexpr int NT = MP / 256, CG = DFF / 4;
    for (size_t it = gt; it < (size_t)NT * 2 * CG; it += NGT) {
        const int pm = (int)(it / (2 * CG)), rem = (int)(it % (2 * CG)), i = rem / CG, col = (rem % CG) * 4;
        if ((pm & 7) == 0) continue;
        const float* H = halo + (size_t)pm * 4 * DFF2; const float* Hp = H - (size_t)4 * DFF2;
        const float* h0p = H + (size_t)i * DFF2; const float* h1p = i == 0 ? Hp + (size_t)3 * DFF2 : H; const float* h2p = i == 0 ? Hp + (size_t)2 * DFF2 : Hp + (size_t)3 * DFF2;
        f32x4 c[2];
#pragma unroll
        for (int s = 0; s < 2; ++s) { const int cc = s * DFF + col;
            c[s] = *(const f32x4*)(cbias + cc) + *(const f32x4*)(cw + cc) * *(const f32x4*)(h2p + cc) + *(const f32x4*)(cw + DFF2 + cc) * *(const f32x4*)(h1p + cc) + *(const f32x4*)(cw + 2 * DFF2 + cc) * *(const f32x4*)(h0p + cc); }
        u32x2 pk; pk.x = cvt_pk_bf16(silu_f(c[0][0]) * c[1][0], silu_f(c[0][1]) * c[1][1]); pk.y = cvt_pk_bf16(silu_f(c[0][2]) * c[1][2], silu_f(c[0][3]) * c[1][3]);
        *(u32x2*)(act + (size_t)(pm * 256 + i) * DFF + col) = pk;
    }
}

__device__ __forceinline__ void final_phase(const Frame& F, KArgs* A_) {
    const int lane = lau_v(lane_id()); unsigned char* ws = lau_s(A_->ws); float* out = lau_s(A_->out);
    const int gw = lau_si(F.vcu * NWAVES + F.wave), NGW = F.G * NWAVES;
    const float* part = (const float*)(ws + WS_SSQP) + (size_t)8 * 32 * MT; const bf16_t* XB = (const bf16_t*)(ws + WS_XB); const float* g = as_global(A_->in[I_GFINAL]);
    f32x4 gg[4][2];
#pragma unroll
    for (int j = 0; j < 4; ++j) { const int c = (64 * j + lane) * 8; gg[j][0] = *(const f32x4*)(g + c); gg[j][1] = *(const f32x4*)(g + c + 4); }
    for (int r0 = gw; r0 < MT; r0 += 3 * NGW) {
        u32x4 q[3][4]; float rs[3] = {};
#pragma unroll
        for (int k = 0; k < 3; ++k) { const int r = r0 + k * NGW; if (r < MT) { rs[k] = lane < 32 ? part[(size_t)lane * MT + r] : 0.f;
#pragma unroll
            for (int j = 0; j < 4; ++j) q[k][j] = *(const u32x4*)(XB + (size_t)r * DM + (64 * j + lane) * 8); } }
        asm volatile("" ::: "memory");
#pragma unroll
        for (int k = 0; k < 3; ++k) rs[k] = rsqrtf(wave_sum(rs[k]) * (1.0f / DM) + EPS);
#pragma unroll
        for (int k = 0; k < 3; ++k) { const int r = r0 + k * NGW; if (r < MT) {
#pragma unroll
            for (int j = 0; j < 4; ++j) { const int c = (64 * j + lane) * 8; const u32x4 w = q[k][j];
                const f32x4 a = (f32x4){bf_lo(w.x), bf_hi(w.x), bf_lo(w.y), bf_hi(w.y)} * rs[k] * gg[j][0], b = (f32x4){bf_lo(w.z), bf_hi(w.z), bf_lo(w.w), bf_hi(w.w)} * rs[k] * gg[j][1];
                *(f32x4*)(out + (size_t)r * DM + c) = a; *(f32x4*)(out + (size_t)r * DM + c + 4) = b; } } }
    }
}

__device__ __forceinline__ void rstd_phase(const Frame& F, KArgs* A_, int nidx) {
    const int lane = lau_v(lane_id()); unsigned char* ws = lau_s(A_->ws);
    const int gw = lau_si(F.vcu * NWAVES + F.wave), NGW = F.G * NWAVES;
    const float* part = (const float*)(ws + WS_SSQP) + (size_t)nidx * 32 * MT; float* rstd = (float*)(ws + WS_RSTD) + (size_t)nidx * MT;
    for (int r = gw * 64 + lane; r < MT; r += NGW * 64) { float s = 0.f;
#pragma unroll 8
        for (int k = 0; k < 32; ++k) s += part[(size_t)k * MT + r];
        rstd[r] = rsqrtf(s * (1.0f / DM) + EPS); }
}
constexpr float MLA_SCALE = 0.07216878364870322f;

template <bool SAMPLE>
__device__ __forceinline__ void naive_attn_phase(const Frame& F, KArgs* A_, int li) {
    constexpr int DQ = SAMPLE ? KVW : QKD, DV = SAMPLE ? KVR : VD, NKMAX = SAMPLE ? PAST + DECS : SEQ, EV = DV / 64;
    const int lane = lau_v(lane_id()); unsigned char* ws = lau_s(A_->ws);
    const int gw = lau_si(F.vcu * NWAVES + F.wave), NGW = F.G * NWAVES;
    LAS float* qf = (LAS float*)(F.lds + F.wave * ((DQ + NKMAX) * 4)); LAS float* sc = qf + DQ;
    const int nitems = (SAMPLE ? MS : MP) * HEADS;
    for (int it = gw; it < nitems; it += NGW) {
        const int r = it >> 3, h = it & 7;
        const bf16_t* qrow; int nk, b;
        if (SAMPLE) { qrow = (const bf16_t*)(ws + WS_QS) + ((size_t)r * HEADS + h) * KVW; nk = PAST + DECS; b = r >> 6; }
        else { qrow = (const bf16_t*)(ws + WS_QP) + ((size_t)r * HEADS + h) * QKD; const int t = r & (SEQ - 1); nk = ((t >> 6) + 1) * 64; b = r >> 11; }
        for (int d = lane; d < DQ; d += 64) qf[d] = __uint_as_float(((unsigned)qrow[d]) << 16);
        LDS_WAIT(); asm volatile("" ::: "memory");
        auto krow = [&](int k) -> const bf16_t* {
            if (SAMPLE) return k < PAST ? (const bf16_t*)(ws + WS_KVC) + (((size_t)li * DECB + b) * PAST + k) * KVW : (const bf16_t*)(ws + WS_KVN) + ((size_t)MP + (size_t)b * DECS + (k - PAST)) * KVW;
            return (const bf16_t*)(ws + WS_KP) + (((size_t)b * SEQ + k) * HEADS + h) * QKD; };
        float mx = -3.0e38f;
        for (int k = lane; k < nk; k += 64) {
            const bf16_t* kr = krow(k); float dot = 0.f;
#pragma unroll 4
            for (int c = 0; c < DQ / 8; ++c) { const u32x4 w = *(const u32x4*)(kr + c * 8); const f32x4 q0 = *(const LAS f32x4*)(qf + c * 8), q1 = *(const LAS f32x4*)(qf + c * 8 + 4);
                dot += bf_lo(w.x) * q0[0] + bf_hi(w.x) * q0[1] + bf_lo(w.y) * q0[2] + bf_hi(w.y) * q0[3] + bf_lo(w.z) * q1[0] + bf_hi(w.z) * q1[1] + bf_lo(w.w) * q1[2] + bf_hi(w.w) * q1[3]; }
            dot *= MLA_SCALE; sc[k] = dot; mx = fmaxf(mx, dot);
        }
#pragma unroll
        for (int o = 1; o < 64; o <<= 1) mx = fmaxf(mx, __shfl_xor(mx, o));
        float sum = 0.f;
        for (int k = lane; k < nk; k += 64) { const float p = __expf(sc[k] - mx); sc[k] = p; sum += p; }
        sum = wave_sum(sum);
        LDS_WAIT(); asm volatile("" ::: "memory");
        float o[EV];
#pragma unroll
        for (int e = 0; e < EV; ++e) o[e] = 0.f;
        for (int k = 0; k < nk; ++k) {
            const float p = sc[k];
            const bf16_t* vr = SAMPLE ? krow(k) : (const bf16_t*)(ws + WS_VP) + (((size_t)b * SEQ + k) * HEADS + h) * VD;
            if constexpr (!SAMPLE) { const unsigned w = *(const unsigned*)(vr + lane * 2); o[0] += p * bf_lo(w); o[1] += p * bf_hi(w); }
            else { const u32x4 w = *(const u32x4*)(vr + lane * 8); o[0] += p * bf_lo(w.x); o[1] += p * bf_hi(w.x); o[2] += p * bf_lo(w.y); o[3] += p * bf_hi(w.y);
                o[4] += p * bf_lo(w.z); o[5] += p * bf_hi(w.z); o[6] += p * bf_lo(w.w); o[7] += p * bf_hi(w.w); }
        }
        const float inv = 1.0f / sum;
        if constexpr (!SAMPLE) *(unsigned*)((bf16_t*)(ws + WS_YCAT) + (size_t)r * DM + h * VD + lane * 2) = cvt_pk_bf16(o[0] * inv, o[1] * inv);
        else { u32x4 w; w.x = cvt_pk_bf16(o[0] * inv, o[1] * inv); w.y = cvt_pk_bf16(o[2] * inv, o[3] * inv); w.z = cvt_pk_bf16(o[4] * inv, o[5] * inv); w.w = cvt_pk_bf16(o[6] * inv, o[7] * inv);
            *(u32x4*)((bf16_t*)(ws + WS_OLAT) + ((size_t)r * HEADS + h) * KVR + lane * 8) = w; }
        LDS_WAIT(); asm volatile("" ::: "memory");
    }
}

__device__ __forceinline__ void naive_gla_phase(const Frame& F, KArgs* A_, int li) {
    const int lane = lau_v(lane_id()), wave = F.wave, tid = wave * 64 + lane; unsigned char* ws = lau_s(A_->ws); float* out = lau_s(A_->out);
    LAS float* fL = (LAS float*)F.lds;
    LAS float* qL = fL + 16 * 128;
    LAS float* vL = qL + 16 * 128;
    LAS float* oL = vL + 16 * 128;
    const float* FG = (const float*)(ws + WS_FG); const bf16_t* QS = (const bf16_t*)(ws + WS_QSIL); const bf16_t* VB = (const bf16_t*)(ws + WS_VB); const bf16_t* GS = (const bf16_t*)(ws + WS_GS);
    bf16_t* yc = (bf16_t*)(ws + WS_YCAT); const float* gon = as_global(A_->in[I_GONORM]) + (size_t)li * HI;
    const int col = tid & 127, kg = tid >> 7;
    const int nitems = (BATCH + DECB) * CHD;
    for (int it = F.vcu; it < nitems; it += F.G) {
        const bool prompt = it < BATCH * CHD; const int sq = prompt ? it / CHD : (it - BATCH * CHD) / CHD, h = it % CHD;
        const int row0 = prompt ? sq * SEQ : MP + sq * DECS, L = prompt ? SEQ : DECS;
        float S[32];
        float* so = prompt ? out + O_HGP + ((((size_t)li * BATCH + sq) * CHD + h) * HF) * HI : out + O_HGS + ((((size_t)li * DECB + sq) * CHD + h) * HF) * HI;
        if (prompt) {
#pragma unroll
            for (int i = 0; i < 32; ++i) S[i] = 0.f; }
        else { const float* s0 = as_global(A_->in[I_SHGRN]) + ((((size_t)li * DECB + sq) * CHD + h) * HF) * HI;
#pragma unroll
            for (int i = 0; i < 32; ++i) S[i] = s0[(size_t)(kg * 32 + i) * HI + col]; }
        for (int c0 = 0; c0 < L; c0 += 16) {
            __syncthreads();
            for (int e = tid; e < 16 * 128; e += 512) { const int tt = e >> 7, k = e & 127; const size_t g = (size_t)(row0 + c0 + tt) * 2048 + h * 128 + k;
                fL[e] = FG[g]; qL[e] = __uint_as_float(((unsigned)QS[g]) << 16); vL[e] = __uint_as_float(((unsigned)VB[g]) << 16); }
            __syncthreads();
            for (int tt = 0; tt < 16; ++tt) {
                const float v = vL[tt * 128 + col]; float acc = 0.f;
#pragma unroll
                for (int i4 = 0; i4 < 8; ++i4) { const f32x4 f4 = *(const LAS f32x4*)(fL + tt * 128 + kg * 32 + i4 * 4), q4 = *(const LAS f32x4*)(qL + tt * 128 + kg * 32 + i4 * 4);
#pragma unroll
                    for (int e = 0; e < 4; ++e) { const float f = f4[e]; S[i4 * 4 + e] = fmaxf(f, 1e-30f) * S[i4 * 4 + e] + (1.0f - f) * v; acc += q4[e] * S[i4 * 4 + e]; } }
                oL[(tt * 4 + kg) * 128 + col] = acc;
            }
            __syncthreads();
            for (int tt = wave; tt < 16; tt += 8) {
                const int r = row0 + c0 + tt; float o0 = 0.f, o1 = 0.f;
#pragma unroll
                for (int g = 0; g < 4; ++g) { const f32x2 p = *(const LAS f32x2*)(oL + (tt * 4 + g) * 128 + lane * 2); o0 += p.x; o1 += p.y; }
                const float ms = wave_sum(o0 * o0 + o1 * o1) * (1.0f / HI), rs = rsqrtf(ms + EPS);
                const unsigned gw2 = *(const unsigned*)(GS + (size_t)r * 2048 + h * 128 + lane * 2); const f32x2 gn = *(const f32x2*)(gon + lane * 2);
                *(unsigned*)(yc + (size_t)r * DM + h * 128 + lane * 2) = cvt_pk_bf16(o0 * rs * gn.x * bf_lo(gw2), o1 * rs * gn.y * bf_hi(gw2));
            }
        }
#pragma unroll
        for (int i = 0; i < 32; ++i) so[(size_t)(kg * 32 + i) * HI + col] = S[i];
    }
}
namespace attnp {
constexpr int NW = 8, QBLK = 32, KVBLK = 64, DQK = QKD, DVV = VD, ND0 = DQK / 16;
constexpr int LDQ = HEADS * QKD, LDKK = HEADS * QKD, LDV = HEADS * VD, LDO = DM;
constexpr size_t SHM_V = KVBLK * DVV * 2, SHM_K = KVBLK * DQK * 2;
constexpr size_t SHM_ATTN = 2 * SHM_V + 2 * SHM_K + NW * 64 * 4;
constexpr float C_EXP = MLA_SCALE * 1.4426950408889634f;
constexpr float THR = 8.f;
#define AP_KSWZ(row, colB) ((row) * 384 + ((colB) ^ ((((row) >> 1) & 7) << 4)))
#define AP_SBAR() __builtin_amdgcn_sched_barrier(0)
__device__ __forceinline__ int crow(int r, int hi) { return (r & 3) + 8 * (r >> 2) + 4 * hi; }

__device__ __forceinline__ void partialSM(f32x16& p0, f32x16& p1, float& m_reg, float& mn, float& alpha) {
  float pmax = p0[0];
#pragma unroll
  for (int r = 1; r < 16; ++r) pmax = fmaxf(pmax, p0[r]);
#pragma unroll
  for (int r = 0; r < 16; ++r) pmax = fmaxf(pmax, p1[r]);
  { auto rr = __builtin_amdgcn_permlane32_swap(__float_as_uint(pmax), __float_as_uint(pmax), false, false);
    pmax = fmaxf(__uint_as_float(rr[0]), __uint_as_float(rr[1])); }
  if (__builtin_expect(__all(pmax - m_reg <= THR / MLA_SCALE), 1)) { mn = m_reg; alpha = 1.f; }
  else { mn = fmaxf(m_reg, pmax); alpha = __builtin_amdgcn_exp2f((m_reg - mn) * C_EXP); m_reg = mn; }
  const float mnC = -mn * C_EXP;
#pragma unroll
  for (int r = 0; r < 16; ++r) p0[r] = fmaf(p0[r], C_EXP, mnC);
#pragma unroll
  for (int r = 0; r < 16; ++r) p1[r] = fmaf(p1[r], C_EXP, mnC);
#pragma unroll
  for (int r = 0; r < 16; ++r) p0[r] = __builtin_amdgcn_exp2f(p0[r]);
}
__device__ __forceinline__ void finishSM(f32x16& p0, f32x16& p1, float alpha, float& l_reg, bf16x8& pa0, bf16x8& pa1, bf16x8& pa2, bf16x8& pa3) {
#pragma unroll
  for (int r = 0; r < 16; ++r) p1[r] = __builtin_amdgcn_exp2f(p1[r]);
  float ps = 0;
#pragma unroll
  for (int r = 0; r < 16; ++r) ps += p0[r];
#pragma unroll
  for (int r = 0; r < 16; ++r) ps += p1[r];
  { auto rr = __builtin_amdgcn_permlane32_swap(__float_as_uint(ps), __float_as_uint(ps), false, false);
    ps = __uint_as_float(rr[0]) + __uint_as_float(rr[1]); }
  l_reg = l_reg * alpha + ps;
#define AP_PK4(P, BASE, OUT) do { unsigned a0 = cvt_pk_bf16(P[BASE + 0], P[BASE + 1]), a1 = cvt_pk_bf16(P[BASE + 2], P[BASE + 3]);   \
    unsigned b0 = cvt_pk_bf16(P[BASE + 4], P[BASE + 5]), b1 = cvt_pk_bf16(P[BASE + 6], P[BASE + 7]);                              \
    auto r0 = __builtin_amdgcn_permlane32_swap(a0, b0, false, false); auto r1 = __builtin_amdgcn_permlane32_swap(a1, b1, false, false); \
    u32x4 w = {r0[0], r1[0], r0[1], r1[1]}; OUT = *reinterpret_cast<bf16x8*>(&w); } while (0)
  AP_PK4(p0, 0, pa0); AP_PK4(p0, 8, pa1); AP_PK4(p1, 0, pa2); AP_PK4(p1, 8, pa3);
#undef AP_PK4
}
__device__ __forceinline__ void qkt(f32x16& p0, f32x16& p1, const char* Ks, const bf16x8* qr, const int (&kb)[4]) {
  p0 = f32x16{}; p1 = f32x16{};
  bf16x8 kf[3][2];
#define QK_LD(set_, d_) do { kf[set_][0] = *reinterpret_cast<const bf16x8*>(Ks + kb[(d_) & 3] + ((d_) >> 2) * 128); kf[set_][1] = *reinterpret_cast<const bf16x8*>(Ks + kb[(d_) & 3] + ((d_) >> 2) * 128 + 32 * 384); } while (0)
  QK_LD(0, 0); QK_LD(1, 1);
#pragma unroll
  for (int d0 = 0; d0 < ND0; ++d0) {
    if (d0 + 2 < ND0) QK_LD((d0 + 2) % 3, d0 + 2);
    __builtin_amdgcn_sched_barrier(0);
    p0 = __builtin_amdgcn_mfma_f32_32x32x16_bf16(kf[d0 % 3][0], qr[d0], p0, 0, 0, 0);
    p1 = __builtin_amdgcn_mfma_f32_32x32x16_bf16(kf[d0 % 3][1], qr[d0], p1, 0, 0, 0);
    __builtin_amdgcn_sched_barrier(0); }
#undef QK_LD
}
__device__ __forceinline__ int v_st(int k, int c) { const int kk = (k & ~0xC) | ((k & 4) << 1) | ((k & 8) >> 1); return ((kk >> 3) * 4 + (c >> 5)) * 512 + ((kk & 7) * 32 + (c & 31)) * 2; }
__device__ __forceinline__ int v_rd_base(int lane) { return ((lane & 3) << 3) | (((lane >> 2) & 3) << 6) | (((lane >> 4) & 1) << 5) | (((lane >> 5) & 1) << 8); }
constexpr int v_rd_off(int d0, int ks, int half) { return d0 * 512 + ks * 4096 + half * 2048; }
template <int OFF> __device__ __forceinline__ s16x4 tr_read(int vb) {
  s16x4 r; asm volatile("ds_read_b64_tr_b16 %0, %1 offset:%2" : "=&v"(r) : "v"(vb), "i"(OFF) : "memory"); return r;
}
template <int D0> __device__ __forceinline__ void pv_one(f32x16& od, int vb, bf16x8 pa0, bf16x8 pa1, bf16x8 pa2, bf16x8 pa3) {
  const s16x4 l0 = tr_read<v_rd_off(D0, 0, 0)>(vb), h0 = tr_read<v_rd_off(D0, 0, 1)>(vb), l1 = tr_read<v_rd_off(D0, 1, 0)>(vb), h1 = tr_read<v_rd_off(D0, 1, 1)>(vb);
  const s16x4 l2 = tr_read<v_rd_off(D0, 2, 0)>(vb), h2 = tr_read<v_rd_off(D0, 2, 1)>(vb), l3 = tr_read<v_rd_off(D0, 3, 0)>(vb), h3 = tr_read<v_rd_off(D0, 3, 1)>(vb);
  asm volatile("s_waitcnt lgkmcnt(0)" ::: "memory"); AP_SBAR();
#define AP_PK(L, H) (bf16x8){L[0], L[1], L[2], L[3], H[0], H[1], H[2], H[3]}
  od = __builtin_amdgcn_mfma_f32_32x32x16_bf16(pa0, AP_PK(l0, h0), od, 0, 0, 0);
  od = __builtin_amdgcn_mfma_f32_32x32x16_bf16(pa1, AP_PK(l1, h1), od, 0, 0, 0);
  od = __builtin_amdgcn_mfma_f32_32x32x16_bf16(pa2, AP_PK(l2, h2), od, 0, 0, 0);
  od = __builtin_amdgcn_mfma_f32_32x32x16_bf16(pa3, AP_PK(l3, h3), od, 0, 0, 0);
#undef AP_PK
}
__device__ __forceinline__ void pv_d0(f32x16* o, int vb, bf16x8 pa0, bf16x8 pa1, bf16x8 pa2, bf16x8 pa3) {
  pv_one<0>(o[0], vb, pa0, pa1, pa2, pa3); pv_one<1>(o[1], vb, pa0, pa1, pa2, pa3); pv_one<2>(o[2], vb, pa0, pa1, pa2, pa3); pv_one<3>(o[3], vb, pa0, pa1, pa2, pa3);
}

__device__ __forceinline__ void unit(const bf16_t* __restrict__ Qb, const bf16_t* __restrict__ Kh, const bf16_t* __restrict__ Vh, bf16_t* __restrict__ Ob, int qt, char* lds, int wid, int lane) {
  const int tid = wid * 64 + lane, r32 = lane & 31, hi = lane >> 5;
  char* V_lds = lds; char* K_lds = lds + 2 * SHM_V;
  float* wsf = (float*)(lds + 2 * SHM_V + 2 * SHM_K) + wid * 64; float* li_l = wsf; float* al_l = wsf + 32;
  float m_reg = -1e30f, l_reg = 0; f32x16 o[4] = {}; bf16x8 qr[ND0];
  const bf16_t* Qw = Qb + (long)(wid * QBLK + r32) * LDQ + hi * 8;
#pragma unroll
  for (int d0 = 0; d0 < ND0; ++d0) qr[d0] = *reinterpret_cast<const bf16x8*>(Qw + d0 * 16);
  const int cq = 4 * qt + (wid >> 1);
  int kb[4];
#pragma unroll
  for (int q = 0; q < 4; ++q) kb[q] = r32 * 384 + ((q * 32 + hi * 16) ^ (((r32 >> 1) & 7) << 4));
  const int NT = 4 * qt + 4;
  const int sr = tid >> 4, sc = (tid & 15) * 8, vst0 = v_st(sr, sc), vst1 = v_st(32 + sr, sc);
  const unsigned vo0 = (unsigned)(sr * LDV + sc) * 2u, vo1 = (unsigned)((32 + sr) * LDV + sc) * 2u;
  unsigned ko[3]; int kst[3];
#pragma unroll
  for (int j = 0; j < 3; ++j) { const int c = tid + 512 * j, kr = c / 24, kc = c % 24; ko[j] = (unsigned)(kr * LDKK + kc * 8) * 2u; kst[j] = AP_KSWZ(kr, kc * 16); }
  const int vb0 = (int)(uintptr_t)V_lds + v_rd_base(lane);
  bf16x8 vs0, vs1, ks0, ks1, ks2;
#define AP_SLOAD(k0) do { const char* vt_ = (const char*)Vh + (size_t)(k0) * (LDV * 2); const char* kt_ = (const char*)Kh + (size_t)(k0) * (LDKK * 2); \
    vs0 = *reinterpret_cast<const bf16x8*>(vt_ + vo0); vs1 = *reinterpret_cast<const bf16x8*>(vt_ + vo1); \
    ks0 = *reinterpret_cast<const bf16x8*>(kt_ + ko[0]); ks1 = *reinterpret_cast<const bf16x8*>(kt_ + ko[1]); ks2 = *reinterpret_cast<const bf16x8*>(kt_ + ko[2]); } while (0)
#define AP_SWRITE(b) do { *(bf16x8*)(V_lds + (b) * SHM_V + vst0) = vs0; *(bf16x8*)(V_lds + (b) * SHM_V + vst1) = vs1; \
    *(bf16x8*)(K_lds + (b) * SHM_K + kst[0]) = ks0; *(bf16x8*)(K_lds + (b) * SHM_K + kst[1]) = ks1; *(bf16x8*)(K_lds + (b) * SHM_K + kst[2]) = ks2; } while (0)
#define AP_RESC(a) do { if (__any((a) < 1.f)) { if (hi == 0) al_l[r32] = (a); asm volatile("s_waitcnt lgkmcnt(0)" ::: "memory"); \
    _Pragma("unroll") for (int d = 0; d < 4; ++d) _Pragma("unroll") for (int r = 0; r < 16; ++r) o[d][r] *= al_l[crow(r, hi)]; } } while (0)
#define AP_MASK(pa, pb, j) do { if ((j) > cq) { _Pragma("unroll") for (int r = 0; r < 16; ++r) { pa[r] = -1e30f; pb[r] = -1e30f; } } } while (0)
  f32x16 p0, p1; float mn, al; bf16x8 pa0, pa1, pa2, pa3;
  AP_SLOAD(0); asm volatile("s_waitcnt vmcnt(0)" ::: "memory"); AP_SWRITE(0); __syncthreads();
#pragma unroll 1
  for (int j = 0; j < NT; ++j) {
    const int bsel = j & 1;
    if (j + 1 < NT) AP_SLOAD((j + 1) * KVBLK);
    AP_SBAR(); qkt(p0, p1, K_lds + bsel * SHM_K, qr, kb); AP_MASK(p0, p1, j);
    partialSM(p0, p1, m_reg, mn, al); AP_RESC(al);
    finishSM(p0, p1, al, l_reg, pa0, pa1, pa2, pa3); AP_SBAR();
    pv_d0(o, vb0 + bsel * (int)SHM_V, pa0, pa1, pa2, pa3);
    if (j + 1 < NT) { asm volatile("s_waitcnt vmcnt(0)" ::: "memory"); AP_SWRITE(bsel ^ 1); }
    __syncthreads();
  }
  if (hi == 0) li_l[r32] = l_reg; asm volatile("s_waitcnt lgkmcnt(0)" ::: "memory");
  float rli[16];
#pragma unroll
  for (int r = 0; r < 16; ++r) rli[r] = __builtin_amdgcn_rcpf(li_l[crow(r, hi)]);
  char* Ow = (char*)(Ob + (size_t)(wid * QBLK) * LDO); const int le = lau_v(lane), r32e = le & 31, hie = le >> 5;
#pragma unroll
  for (int r = 0; r < 16; ++r) { const unsigned oo = (unsigned)(crow(r, hie) * LDO + r32e) * 2u;
#pragma unroll
    for (int d0 = 0; d0 < 4; ++d0) *(bf16_t*)(Ow + oo + d0 * 64) = (bf16_t)(cvt_pk_bf16(o[d0][r] * rli[r], 0.f) & 0xffffu); }
#undef AP_SLOAD
#undef AP_SWRITE
#undef AP_RESC
#undef AP_MASK
}
}

__device__ __forceinline__ void attn_prompt_phase(const Frame& F, KArgs* A_, int first_wg) {
  const int lane = lau_v(lane_id()); unsigned char* ws = lau_s(A_->ws);
  const int w = F.vcu - first_wg; if (w < 0 || w >= 256) return;
  const int bh = w >> 2, p = w & 3, b = bh >> 3, h = bh & 7;
  const bf16_t* Qp = (const bf16_t*)(ws + WS_QP); const bf16_t* Kp = (const bf16_t*)(ws + WS_KP); const bf16_t* Vp = (const bf16_t*)(ws + WS_VP); bf16_t* Y = (bf16_t*)(ws + WS_YCAT);
  const bf16_t* Kh = Kp + ((size_t)b * SEQ * HEADS + h) * QKD; const bf16_t* Vh = Vp + ((size_t)b * SEQ * HEADS + h) * VD;
#pragma unroll 1
  for (int s = 0; s < 2; ++s) { const int qt = s == 0 ? 7 - p : p; const size_t row0 = (size_t)b * SEQ + (size_t)qt * 256;
    attnp::unit(Qp + (row0 * HEADS + h) * QKD, Kh, Vh, Y + row0 * DM + h * VD, qt, (char*)F.lds, F.wave, lane); }
}
namespace attns {
constexpr int QIMG = 0, KIMG = 65536, KPE = KIMG + 65536, SX = KIMG + 73728, SXLD = 272, WSCR = SX + 64 * SXLD, LDS_END = WSCR + 8 * 256;
static_assert(LDS_END <= RING_BYTES, "sample attention LDS");
constexpr float C_EXP = MLA_SCALE * 1.4426950408889634f, THR = 8.f;
__device__ __forceinline__ unsigned off_b(unsigned row, unsigned ch) { return 256u * row + 16u * (ch ^ (((row & 3) << 2) | ((row >> 2) & 3))); }
__device__ __forceinline__ int crow(int r, int hi) { return (r & 3) + 8 * (r >> 2) + 4 * hi; }
template <int OFF> __device__ __forceinline__ s16x4 tr_read(int vb) { s16x4 r; asm volatile("ds_read_b64_tr_b16 %0, %1 offset:%2" : "=&v"(r) : "v"(vb), "i"(OFF) : "memory"); return r; }

__device__ __forceinline__ void unit(const bf16_t* __restrict__ Qs_bh  , const float* __restrict__ Clat  , const float* __restrict__ Ckpe  , const bf16_t* __restrict__ Kn  ,
                                     const bf16_t* __restrict__ Wv  , bf16_t* __restrict__ Yb  , char* lds, int wid, int lane) {
  const int tid = wid * 64 + lane, qh = wid >> 2, cq = wid & 3, l15 = lane & 15, g4 = lane >> 4, r32 = lane & 31, hi = lane >> 5;
  float* wsf = (float*)(lds + WSCR) + wid * 64; float* li_l = wsf; float* al_l = wsf + 32;
#pragma unroll
  for (int j = 0; j < 8; ++j) { const int c = lau_v(tid) + 512 * j, q = c >> 6, ch = c & 63;
    *(bf16x8*)(lds + QIMG + (ch >> 4) * 16384 + off_b(q, ch & 15)) = *reinterpret_cast<const bf16x8*>(Qs_bh + (size_t)q * (HEADS * KVW) + ch * 8); }
  bf16x8 qpe[2][2];
#pragma unroll
  for (int sb = 0; sb < 2; ++sb)
#pragma unroll
    for (int s2 = 0; s2 < 2; ++s2) { const int lq = lau_v(lane); qpe[sb][s2] = *reinterpret_cast<const bf16x8*>(Qs_bh + (unsigned)((32 * qh + 16 * sb + (lq & 15)) * (HEADS * KVW) + KVR + 32 * s2 + 8 * (lq >> 4))); }
  int kb0, qb0, xsh, kpb[2];
  { const int ln2 = lau_v(lane), l15b = ln2 & 15, g4b = ln2 >> 4; const int krow_ = 16 * cq + l15b, qrow_ = 32 * qh + l15b, clo = 16 * (g4b ^ ((l15b >> 2) & 3));
    kb0 = KIMG + 256 * krow_ + clo; qb0 = QIMG + 256 * qrow_ + clo; xsh = (l15b & 3) << 6;
#pragma unroll
    for (int s = 0; s < 2; ++s) kpb[s] = KPE + krow_ * 128 + 16 * ((4 * s + g4b) ^ (krow_ & 7)); }
  int vb[2], q4s;
  { const int blk = (lane >> 4) & 1, q4 = (lane & 15) >> 2, p4 = lane & 3, c0 = 2 * blk + (p4 >> 1);
    q4s = q4 << 6;
#pragma unroll
    for (int t = 0; t < 2; ++t) vb[t] = (int)(uintptr_t)lds + KIMG + cq * 16384 + 256 * (8 * hi + 4 * t + q4) + 16 * (c0 ^ ((2 * hi + t) & 3)) + 8 * (p4 & 1); }
  const int sxw = SX + (32 * qh + l15) * SXLD + (16 * cq + 4 * g4) * 4;
  const int sxr = SX + (32 * qh + r32) * SXLD + (8 * hi) * 4;
  constexpr int NT = (PAST + DECS) / 64;
  constexpr int N1 = 4, N2 = 8 - N1;
  bf16x8 cv[9]; f32x4 r1a[N1], r1b[N1], r2a[N2 + 1], r2b[N2 + 1];
#define AS_CVL(A, B) ({ u32x4 w_; w_.x = cvt_pk_bf16(A[0], A[1]); w_.y = cvt_pk_bf16(A[2], A[3]); w_.z = cvt_pk_bf16(B[0], B[1]); w_.w = cvt_pk_bf16(B[2], B[3]); *reinterpret_cast<bf16x8*>(&w_); })
#define AS_CVP(A, B) ({ u32x4 w_; w_.x = cvt_pk_bf16(A[0], B[0]); w_.y = cvt_pk_bf16(A[1], B[1]); w_.z = cvt_pk_bf16(A[2], B[2]); w_.w = cvt_pk_bf16(A[3], B[3]); *reinterpret_cast<bf16x8*>(&w_); })
#define AS_BC(x) (*reinterpret_cast<const bf16x8*>(&(x)))
#define AS_LD1(j_) do { if ((j_) < PAST / 64) { const unsigned tl_ = (unsigned)lau_v(tid) * 32u; const char* tb_ = (const char*)(Clat + (size_t)(j_) * (64 * KVR)); \
      _Pragma("unroll") for (int i_ = 0; i_ < N1; ++i_) { r1a[i_] = *(const f32x4*)(tb_ + (tl_ + 16384u * i_)); r1b[i_] = *(const f32x4*)(tb_ + (tl_ + 16384u * i_ + 16u)); } } \
    else { const int t2_ = lau_v(tid); _Pragma("unroll") for (int i_ = 0; i_ < N1; ++i_) { const int c_ = t2_ + 512 * i_; r1a[i_] = *reinterpret_cast<const f32x4*>(Kn + (unsigned)((c_ >> 6) * KVW + (c_ & 63) * 8)); } } } while (0)
#define AS_CV1(j_) do { if ((j_) < PAST / 64) { _Pragma("unroll") for (int i_ = 0; i_ < N1; ++i_) cv[i_] = AS_CVL(r1a[i_], r1b[i_]); } \
    else { _Pragma("unroll") for (int i_ = 0; i_ < N1; ++i_) cv[i_] = AS_BC(r1a[i_]); } } while (0)
#define AS_LD2(j_) do { const int t2_ = lau_v(tid); if ((j_) < PAST / 64) { const char* tb_ = (const char*)(Clat + (size_t)(j_) * (64 * KVR)); const float* tp_ = Ckpe + (size_t)(j_) * (64 * ROPE) + (unsigned)((t2_ >> 3) * ROPE + (t2_ & 7) * 4); \
      _Pragma("unroll") for (int i_ = 0; i_ < N2; ++i_) { r2a[i_] = *(const f32x4*)(tb_ + ((unsigned)t2_ * 32u + 16384u * (N1 + i_))); r2b[i_] = *(const f32x4*)(tb_ + ((unsigned)t2_ * 32u + 16384u * (N1 + i_) + 16u)); } \
      r2a[N2] = *(const f32x4*)tp_; r2b[N2] = *(const f32x4*)(tp_ + 32); } \
    else { _Pragma("unroll") for (int i_ = 0; i_ < N2; ++i_) { const int c_ = t2_ + 512 * (N1 + i_); r2a[i_] = *reinterpret_cast<const f32x4*>(Kn + (unsigned)((c_ >> 6) * KVW + (c_ & 63) * 8)); } \
      r2a[N2] = *reinterpret_cast<const f32x4*>(Kn + (unsigned)((t2_ >> 3) * KVW + KVR + (t2_ & 7) * 8)); } } while (0)
#define AS_CV2(j_) do { if ((j_) < PAST / 64) { _Pragma("unroll") for (int i_ = 0; i_ < N2; ++i_) cv[N1 + i_] = AS_CVL(r2a[i_], r2b[i_]); cv[8] = AS_CVP(r2a[N2], r2b[N2]); } \
    else { _Pragma("unroll") for (int i_ = 0; i_ < N2; ++i_) cv[N1 + i_] = AS_BC(r2a[i_]); cv[8] = AS_BC(r2a[N2]); } } while (0)
  float m_reg = -1e30f, l_reg = 0.f; f32x16 o[4] = {};
  AS_LD1(0); AS_LD2(0); AS_CV1(0);
#pragma unroll 1
  for (int j = 0; j < NT; ++j) {
    AS_CV2(j);
    __syncthreads();
    { const int tl = lau_v(tid);
#pragma unroll
      for (int i = 0; i < 8; ++i) { const int c = tl + 512 * i, row = c >> 6, ch = c & 63; *(bf16x8*)(lds + KIMG + (ch >> 4) * 16384 + (int)off_b(row, ch & 15)) = cv[i]; }
      { const int row = tl >> 3, cp = tl & 7; *(bf16x8*)(lds + KPE + row * 128 + 16 * (cp ^ (row & 7))) = cv[8]; } }
    __syncthreads();
    if (j + 1 < NT) AS_LD1(j + 1);
    f32x4 sa[2] = {{0.f, 0.f, 0.f, 0.f}, {0.f, 0.f, 0.f, 0.f}};
    const int xsl = lau_v(xsh);
    bf16x8 fa[2][2], fb0[2][2], fb1[2][2], fp[2];
#define AS_SLD(set, g_) do { _Pragma("unroll") for (int i_ = 0; i_ < 2; ++i_) { const int s_ = 2 * (g_) + i_; const int xs_ = (64 * (s_ & 3)) ^ xsl; \
        fa[set][i_] = *(const bf16x8*)(lds + kb0 + xs_ + (s_ >> 2) * 16384); fb0[set][i_] = *(const bf16x8*)(lds + qb0 + xs_ + (s_ >> 2) * 16384); fb1[set][i_] = *(const bf16x8*)(lds + qb0 + xs_ + (s_ >> 2) * 16384 + 4096); } } while (0)
    AS_SLD(0, 0);
#pragma unroll
    for (int g = 0; g < 8; ++g) {
      if (g < 7) AS_SLD((g + 1) & 1, g + 1); else { fp[0] = *(const bf16x8*)(lds + kpb[0]); fp[1] = *(const bf16x8*)(lds + kpb[1]); }
      __builtin_amdgcn_sched_barrier(0);
#pragma unroll
      for (int i = 0; i < 2; ++i) {
        sa[0] = __builtin_amdgcn_mfma_f32_16x16x32_bf16(fa[g & 1][i], fb0[g & 1][i], sa[0], 0, 0, 0);
        sa[1] = __builtin_amdgcn_mfma_f32_16x16x32_bf16(fa[g & 1][i], fb1[g & 1][i], sa[1], 0, 0, 0); }
      __builtin_amdgcn_sched_barrier(0);
    }
#undef AS_SLD
#pragma unroll
    for (int s = 0; s < 2; ++s) {
      sa[0] = __builtin_amdgcn_mfma_f32_16x16x32_bf16(fp[s], qpe[0][s], sa[0], 0, 0, 0);
      sa[1] = __builtin_amdgcn_mfma_f32_16x16x32_bf16(fp[s], qpe[1][s], sa[1], 0, 0, 0); }
    *(f32x4*)(lds + sxw) = sa[0]; *(f32x4*)(lds + sxw + 16 * SXLD) = sa[1];
    __syncthreads();
    if (j + 1 < NT) { AS_CV1(j + 1); AS_LD2(j + 1); }
    float sv[4][8];
#pragma unroll
    for (int ks = 0; ks < 4; ++ks) { const f32x4 x = *(const f32x4*)(lds + sxr + ks * 64), y = *(const f32x4*)(lds + sxr + ks * 64 + 16);
      sv[ks][0] = x[0]; sv[ks][1] = x[1]; sv[ks][2] = x[2]; sv[ks][3] = x[3]; sv[ks][4] = y[0]; sv[ks][5] = y[1]; sv[ks][6] = y[2]; sv[ks][7] = y[3]; }
    float pmax = sv[0][0];
#pragma unroll
    for (int ks = 0; ks < 4; ++ks)
#pragma unroll
      for (int e = 0; e < 8; ++e) pmax = fmaxf(pmax, sv[ks][e]);
    { auto rr = __builtin_amdgcn_permlane32_swap(__float_as_uint(pmax), __float_as_uint(pmax), false, false); pmax = fmaxf(__uint_as_float(rr[0]), __uint_as_float(rr[1])); }
    float mn, alpha;
    if (__builtin_expect(__all(pmax - m_reg <= THR / MLA_SCALE), 1)) { mn = m_reg; alpha = 1.f; }
    else { mn = fmaxf(m_reg, pmax); alpha = __builtin_amdgcn_exp2f((m_reg - mn) * C_EXP); m_reg = mn; }
    const float mnC = -mn * C_EXP; float ps = 0.f;
#pragma unroll
    for (int ks = 0; ks < 4; ++ks)
#pragma unroll
      for (int e = 0; e < 8; ++e) { sv[ks][e] = __builtin_amdgcn_exp2f(fmaf(sv[ks][e], C_EXP, mnC)); ps += sv[ks][e]; }
    { auto rr = __builtin_amdgcn_permlane32_swap(__float_as_uint(ps), __float_as_uint(ps), false, false); ps = __uint_as_float(rr[0]) + __uint_as_float(rr[1]); }
    l_reg = l_reg * alpha + ps;
    if (__any(alpha < 1.f)) { if (hi == 0) al_l[r32] = alpha; asm volatile("s_waitcnt lgkmcnt(0)" ::: "memory");
#pragma unroll
      for (int d = 0; d < 4; ++d)
#pragma unroll
        for (int r = 0; r < 16; ++r) o[d][r] *= al_l[crow(r, hi)]; }
    bf16x8 pa[4];
#pragma unroll
    for (int ks = 0; ks < 4; ++ks) { u32x4 w; w.x = cvt_pk_bf16(sv[ks][0], sv[ks][1]); w.y = cvt_pk_bf16(sv[ks][2], sv[ks][3]); w.z = cvt_pk_bf16(sv[ks][4], sv[ks][5]); w.w = cvt_pk_bf16(sv[ks][6], sv[ks][7]); pa[ks] = *reinterpret_cast<bf16x8*>(&w); }
#pragma unroll
    for (int d0 = 0; d0 < 4; ++d0) {
      const int xd = (64 * d0) ^ lau_v(q4s), va0 = vb[0] + xd, va1 = vb[1] + xd;
      const s16x4 l0 = tr_read<0>(va0), h0 = tr_read<0>(va1), l1 = tr_read<4096>(va0), h1 = tr_read<4096>(va1);
      const s16x4 l2 = tr_read<8192>(va0), h2 = tr_read<8192>(va1), l3 = tr_read<12288>(va0), h3 = tr_read<12288>(va1);
      asm volatile("s_waitcnt lgkmcnt(0)" ::: "memory"); __builtin_amdgcn_sched_barrier(0);
#define AS_PK(L, H) (bf16x8){L[0], L[1], L[2], L[3], H[0], H[1], H[2], H[3]}
      o[d0] = __builtin_amdgcn_mfma_f32_32x32x16_bf16(pa[0], AS_PK(l0, h0), o[d0], 0, 0, 0);
      o[d0] = __builtin_amdgcn_mfma_f32_32x32x16_bf16(pa[1], AS_PK(l1, h1), o[d0], 0, 0, 0);
      o[d0] = __builtin_amdgcn_mfma_f32_32x32x16_bf16(pa[2], AS_PK(l2, h2), o[d0], 0, 0, 0);
      o[d0] = __builtin_amdgcn_mfma_f32_32x32x16_bf16(pa[3], AS_PK(l3, h3), o[d0], 0, 0, 0);
#undef AS_PK
    }
  }
  if (hi == 0) li_l[r32] = l_reg; asm volatile("s_waitcnt lgkmcnt(0)" ::: "memory");
  { const int le = lau_v(lane), r32e = le & 31, hie = le >> 5;
#pragma unroll
    for (int r = 0; r < 16; ++r) { const int q = 32 * qh + crow(r, hie); const float rl = __builtin_amdgcn_rcpf(li_l[crow(r, hie)]);
#pragma unroll
      for (int d0 = 0; d0 < 4; ++d0) { const int cc = 32 * d0 + r32e;
        *(bf16_t*)(lds + QIMG + cq * 16384 + off_b(q, cc >> 3) + (cc & 7) * 2) = (bf16_t)(cvt_pk_bf16(o[d0][r] * rl, 0.f) & 0xffffu); } } }
  __syncthreads();
  { f32x4 ya[4] = {{0.f, 0.f, 0.f, 0.f}, {0.f, 0.f, 0.f, 0.f}, {0.f, 0.f, 0.f, 0.f}, {0.f, 0.f, 0.f, 0.f}};
    const bf16_t* wrow = lau_vp(Wv + (size_t)(16 * wid + (lau_v(lane) & 15)) * KVR + 8 * (lau_v(lane) >> 4));
    int ob[4];
#pragma unroll
    for (int s = 0; s < 4; ++s) { const int le2 = lau_v(lane); ob[s] = QIMG + off_b(le2 & 15, 4 * s + (le2 >> 4)); }
#pragma unroll
    for (int s = 0; s < 16; ++s) { const bf16x8 b = *reinterpret_cast<const bf16x8*>(wrow + 32 * s);
#pragma unroll
      for (int qb2 = 0; qb2 < 4; ++qb2) { const bf16x8 a = *(const bf16x8*)(lds + ob[s & 3] + (s >> 2) * 16384 + qb2 * 4096); ya[qb2] = __builtin_amdgcn_mfma_f32_16x16x32_bf16(a, b, ya[qb2], 0, 0, 0); } }
    { const int l2 = lau_v(lane); const unsigned yo = (unsigned)((4 * (l2 >> 4)) * DM + 16 * wid + (l2 & 15)) * 2u;
#pragma unroll
      for (int qb2 = 0; qb2 < 4; ++qb2)
#pragma unroll
        for (int e = 0; e < 4; ++e) *(bf16_t*)((char*)Yb + yo + (unsigned)((16 * qb2 + e) * DM * 2)) = (bf16_t)(cvt_pk_bf16(ya[qb2][e], 0.f) & 0xffffu); } }
  __syncthreads();
#undef AS_LD1
#undef AS_LD2
#undef AS_CV1
#undef AS_CV2
#undef AS_CVL
#undef AS_BC
#undef AS_CVP
}
}

__device__ __forceinline__ void attn_sample_phase(const Frame& F, KArgs* A_, int li) {
  const int lane = lau_v(lane_id()); unsigned char* ws = lau_s(A_->ws);
  for (int it = F.vcu; it < DECB * HEADS; it += F.G) {
    const int b = it >> 3, h = it & 7;
    attns::unit((const bf16_t*)(ws + WS_QS) + ((size_t)b * DECS * HEADS + h) * KVW, as_global(A_->in[I_CLAT]) + ((size_t)li * DECB + b) * PAST * KVR, as_global(A_->in[I_CKPE]) + ((size_t)li * DECB + b) * PAST * ROPE,
                (const bf16_t*)(ws + WS_KVN) + ((size_t)MP + (size_t)b * DECS) * KVW, (const bf16_t*)(ws + WS_WKV) + ((size_t)li * 2048 + 1024 + h * VD) * KVR,
                (bf16_t*)(ws + WS_YCAT) + ((size_t)MP + (size_t)b * DECS) * DM + h * VD, (char*)F.lds, F.wave, lane);
  }
}
namespace gla {
constexpr int QT = 0, KT = 8192, KH = 16384, VT = 24576, EL = 32768, SSX = 33280, GB = 33792;
constexpr int GON = 2 * GB, QPO = GON + 512;
static_assert(QPO + 4096 <= RING_BYTES, "gla LDS");
__device__ __forceinline__ int crow(int r, int hi) { return (r & 3) + 8 * (r >> 2) + 4 * hi; }
template <int OFF> __device__ __forceinline__ s16x4 tr_read(int a) { s16x4 r; asm volatile("ds_read_b64_tr_b16 %0, %1 offset:%2" : "=&v"(r) : "v"(a), "i"(OFF) : "memory"); return r; }
#define GLA_PK(L, H) (bf16x8){L[0], L[1], L[2], L[3], H[0], H[1], H[2], H[3]}
__device__ __forceinline__ bf16x8 cvt8(const f32x16& x, int base) {
    u32x4 w; w.x = cvt_pk_bf16(x[base + 0], x[base + 1]); w.y = cvt_pk_bf16(x[base + 2], x[base + 3]); w.z = cvt_pk_bf16(x[base + 4], x[base + 5]); w.w = cvt_pk_bf16(x[base + 6], x[base + 7]); return *reinterpret_cast<bf16x8*>(&w); }

__device__ __forceinline__ void run(unsigned char* ws, const float* s0  , float* sout, const float* gon, int row0, int h, int nch, char* lds, int wave, int lane) {
    const bool scan = wave < 4; const int vq = wave & 3;
    const int r32 = lane & 31, hi = lane >> 5, th = vq >> 1; const unsigned kd = 64u * (vq & 1) + (unsigned)lane;
    const bf16_t* FGp = (const bf16_t*)(ws + WS_FG) + (size_t)row0 * 2048 + h * 128;
    const bf16_t* QSp = (const bf16_t*)(ws + WS_QSIL) + (size_t)row0 * 2048 + h * 128;
    const bf16_t* VBp = (const bf16_t*)(ws + WS_VB) + (size_t)row0 * 2048 + h * 128;
    const bf16_t* GSp = (const bf16_t*)(ws + WS_GS) + (size_t)row0 * 2048 + h * 128;
    bf16_t* YCp = (bf16_t*)(ws + WS_YCAT) + (size_t)row0 * DM + h * 128;
    char* gb = lds;
    const int trq = (lane & 15) >> 2, trf = (2 * hi + (trq >> 1)) & 3;
    const int trb = (int)(uintptr_t)gb + (4 * hi + trq) * 64 + (((2 * ((lane >> 4) & 1) + ((lane & 3) >> 1)) ^ trf) * 16) + 8 * (lane & 1);
    float* gonL = (float*)(lds + GON);
    const int tq = vq; const unsigned dp2 = 2u * (unsigned)lane;
#define GLA_LOAD(F2, QV, VV, c_) do { const size_t ro_ = (size_t)(32 * (c_) + 8 * tq) * 2048; \
    const bf16_t* f1_ = lau_s(FGp + ro_); const bf16_t* q1_ = lau_s(QSp + ro_); const bf16_t* v1_ = lau_s(VBp + ro_); const unsigned kl_ = (unsigned)lau_v((int)dp2); \
    _Pragma("unroll") for (int i_ = 0; i_ < 8; ++i_) { F2[i_] = *(const unsigned*)(f1_ + kl_ + 2048u * i_); QV[i_] = *(const unsigned*)(q1_ + kl_ + 2048u * i_); VV[i_] = *(const unsigned*)(v1_ + kl_ + 2048u * i_); } } while (0)
#define GLA_PROD(F2, n_) do { float p0_ = 1.f, p1_ = 1.f; \
    _Pragma("unroll") for (int i_ = 0; i_ < 8; ++i_) { p0_ *= fmaxf(1.0f - bf_lo(F2[i_]), 1e-30f); p1_ *= fmaxf(1.0f - bf_hi(F2[i_]), 1e-30f); } \
    *(f32x2*)(lds + QPO + ((((n_) & 1) * 4 + tq) * 128 + (int)dp2) * 4) = (f32x2){p0_, p1_}; } while (0)
#define GLA_PREP(F2, QV, VV, par_) do { char* ib_ = gb + (par_) * GB; \
    const f32x2 g0_ = *(const f32x2*)(lds + QPO + (((par_) * 4 + 0) * 128 + (int)dp2) * 4), g1_ = *(const f32x2*)(lds + QPO + (((par_) * 4 + 1) * 128 + (int)dp2) * 4); \
    const f32x2 g2_ = *(const f32x2*)(lds + QPO + (((par_) * 4 + 2) * 128 + (int)dp2) * 4), g3_ = *(const f32x2*)(lds + QPO + (((par_) * 4 + 3) * 128 + (int)dp2) * 4); \
    _Pragma("unroll") for (int d_ = 0; d_ < 2; ++d_) { \
        const float q0_ = d_ ? g0_.y : g0_.x, q1p_ = d_ ? g1_.y : g1_.x, q2_ = d_ ? g2_.y : g2_.x, q3_ = d_ ? g3_.y : g3_.x; \
        const float pre_ = (tq > 0 ? q0_ : 1.f) * (tq > 1 ? q1p_ : 1.f) * (tq > 2 ? q2_ : 1.f), post_ = (tq < 1 ? q1p_ : 1.f) * (tq < 2 ? q2_ : 1.f) * (tq < 3 ? q3_ : 1.f); \
        float E_ = pre_; float qt_[8], kt_[8], kh_[8], fv_[8], kv_[8]; \
        _Pragma("unroll") for (int i_ = 0; i_ < 8; ++i_) { kv_[i_] = d_ ? bf_hi(F2[i_]) : bf_lo(F2[i_]); fv_[i_] = 1.0f - kv_[i_]; E_ *= fmaxf(fv_[i_], 1e-30f); const float Ec_ = fmaxf(E_, 1e-30f); \
            qt_[i_] = __uint_as_float(d_ ? (QV[i_] & 0xffff0000u) : (QV[i_] << 16)) * Ec_; kt_[i_] = kv_[i_] * __builtin_amdgcn_rcpf(Ec_); } \
        float suf_ = post_; \
        _Pragma("unroll") for (int i_ = 7; i_ >= 0; --i_) { kh_[i_] = kv_[i_] * suf_; suf_ *= fmaxf(fv_[i_], 1e-30f); } \
        if (tq == 0) *(float*)(ib_ + EL + ((int)dp2 + d_) * 4) = E_ * post_; \
        u32x4 a_, b_, c_, dd_; \
        a_.x = cvt_pk_bf16(qt_[0], qt_[1]); a_.y = cvt_pk_bf16(qt_[2], qt_[3]); a_.z = cvt_pk_bf16(qt_[4], qt_[5]); a_.w = cvt_pk_bf16(qt_[6], qt_[7]); \
        b_.x = cvt_pk_bf16(kt_[0], kt_[1]); b_.y = cvt_pk_bf16(kt_[2], kt_[3]); b_.z = cvt_pk_bf16(kt_[4], kt_[5]); b_.w = cvt_pk_bf16(kt_[6], kt_[7]); \
        c_.x = cvt_pk_bf16(kh_[0], kh_[1]); c_.y = cvt_pk_bf16(kh_[2], kh_[3]); c_.z = cvt_pk_bf16(kh_[4], kh_[5]); c_.w = cvt_pk_bf16(kh_[6], kh_[7]); \
        if (d_) { dd_.x = (VV[0] >> 16) | (VV[1] & 0xffff0000u); dd_.y = (VV[2] >> 16) | (VV[3] & 0xffff0000u); dd_.z = (VV[4] >> 16) | (VV[5] & 0xffff0000u); dd_.w = (VV[6] >> 16) | (VV[7] & 0xffff0000u); } \
        else { dd_.x = (VV[0] & 0xffffu) | (VV[1] << 16); dd_.y = (VV[2] & 0xffffu) | (VV[3] << 16); dd_.z = (VV[4] & 0xffffu) | (VV[5] << 16); dd_.w = (VV[6] & 0xffffu) | (VV[7] << 16); } \
        const int o_ = ((int)dp2 + d_) * 64 + ((tq ^ (lane & 3)) * 16);   \
        *(u32x4*)(ib_ + QT + o_) = a_; *(u32x4*)(ib_ + KT + o_) = b_; *(u32x4*)(ib_ + KH + o_) = c_; *(u32x4*)(ib_ + VT + o_) = dd_; } } while (0)
    f32x16 S[4]; f32x16 o = {}; u32x2 gsv[4] = {}; f32x4 gnr[4] = {};
#define GLA_FINAL(c_, par_) do { const float* sx_ = (const float*)(gb + (par_) * GB + SSX); \
    const float tot_ = (sx_[r32] + sx_[32 + r32]) + (sx_[64 + r32] + sx_[96 + r32]); const float rs_ = rsqrtf(tot_ * (1.0f / HI) + EPS); \
    const size_t ro_ = (size_t)(32 * (c_) + r32) * 2048; \
    _Pragma("unroll") for (int g_ = 0; g_ < 4; ++g_) { const int v0_ = 32 * vq + 8 * g_ + 4 * hi; const f32x4 gn_ = gnr[g_]; const u32x2 gw_ = gsv[g_]; \
        u32x2 w_; w_.x = cvt_pk_bf16(o[4 * g_ + 0] * rs_ * gn_[0] * bf_lo(gw_.x), o[4 * g_ + 1] * rs_ * gn_[1] * bf_hi(gw_.x)); w_.y = cvt_pk_bf16(o[4 * g_ + 2] * rs_ * gn_[2] * bf_lo(gw_.y), o[4 * g_ + 3] * rs_ * gn_[3] * bf_hi(gw_.y)); \
        *(u32x2*)(YCp + ro_ + v0_) = w_; } } while (0)
#define GLA_GSLOAD(c_) do { const size_t ro_ = (size_t)(32 * (c_) + r32) * 2048; _Pragma("unroll") for (int g_ = 0; g_ < 4; ++g_) gsv[g_] = *(const u32x2*)(GSp + ro_ + 32 * vq + 8 * g_ + 4 * hi); } while (0)
#define GLA_FR2(kt_) do { const s16x4 ql_ = tr_read<QT + (32 * kt_) * 64>(ia), qh_ = tr_read<QT + (32 * kt_ + 8) * 64>(ia), kl_ = tr_read<KT + (32 * kt_) * 64>(ia), kh2_ = tr_read<KT + (32 * kt_ + 8) * 64>(ia); \
        const s16x4 ql3_ = tr_read<QT + (32 * kt_ + 16) * 64>(ia), qh3_ = tr_read<QT + (32 * kt_ + 24) * 64>(ia), kl3_ = tr_read<KT + (32 * kt_ + 16) * 64>(ia), kh3_ = tr_read<KT + (32 * kt_ + 24) * 64>(ia); \
        asm volatile("s_waitcnt lgkmcnt(0)" ::: "memory"); __builtin_amdgcn_sched_barrier(0); \
        qf[kt_][0] = GLA_PK(ql_, qh_); qf[kt_][1] = GLA_PK(ql3_, qh3_); \
        P = __builtin_amdgcn_mfma_f32_32x32x16_bf16(GLA_PK(kl_, kh2_), qf[kt_][0], P, 0, 0, 0); P1 = __builtin_amdgcn_mfma_f32_32x32x16_bf16(GLA_PK(kl3_, kh3_), qf[kt_][1], P1, 0, 0, 0); } while (0)
#define GLA_SCAN(par_) do { const int ia = trb + (par_) * GB; const char* ib = gb + (par_) * GB; \
        bf16x8 qf[4][2]; f32x16 P = {}, P1 = {}; \
        GLA_FR2(0); GLA_FR2(1); GLA_FR2(2); GLA_FR2(3); \
        P = P + P1; \
        _Pragma("unroll") for (int r = 0; r < 16; ++r) P[r] = (crow(r, hi) <= r32) ? P[r] : 0.f; \
        o = f32x16{}; \
        _Pragma("unroll") for (int kt = 0; kt < 4; ++kt) _Pragma("unroll") for (int s2 = 0; s2 < 2; ++s2) o = __builtin_amdgcn_mfma_f32_32x32x16_bf16(cvt8(S[kt], 8 * s2), qf[kt][s2], o, 0, 0, 0); \
        const char* vrow = ib + VT + (32 * vq + r32) * 64; const int fr_ = (r32 >> 1) & 3; \
        { s16x4 vlo_[2], vhh_[2]; \
          _Pragma("unroll") for (int ks = 0; ks < 2; ++ks) { vlo_[ks] = *(const s16x4*)(vrow + (((2 * ks) ^ fr_) * 16) + 8 * hi); vhh_[ks] = *(const s16x4*)(vrow + (((2 * ks + 1) ^ fr_) * 16) + 8 * hi); } \
          __builtin_amdgcn_sched_barrier(0); \
          _Pragma("unroll") for (int ks = 0; ks < 2; ++ks) o = __builtin_amdgcn_mfma_f32_32x32x16_bf16(GLA_PK(vlo_[ks], vhh_[ks]), cvt8(P, 8 * ks), o, 0, 0, 0); } \
        { float ss = 0.f; \
          _Pragma("unroll") for (int r = 0; r < 16; ++r) ss += o[r] * o[r]; \
          auto rr = __builtin_amdgcn_permlane32_swap(__float_as_uint(ss), __float_as_uint(ss), false, false); ss = __uint_as_float(rr[0]) + __uint_as_float(rr[1]); \
          if (hi == 0) *(float*)(gb + (par_) * GB + SSX + (vq * 32 + r32) * 4) = ss; } \
          \
        { bf16x8 ka_[4][2], vb_[2]; f32x4 el_[4][4]; \
          _Pragma("unroll") for (int ks = 0; ks < 2; ++ks) vb_[ks] = *(const bf16x8*)(vrow + (((2 * ks + hi) ^ fr_) * 16)); \
          _Pragma("unroll") for (int kt = 0; kt < 4; ++kt) { \
            _Pragma("unroll") for (int ks = 0; ks < 2; ++ks) ka_[kt][ks] = *(const bf16x8*)(ib + KH + (32 * kt + r32) * 64 + (((2 * ks + hi) ^ fr_) * 16)); \
            _Pragma("unroll") for (int g = 0; g < 4; ++g) el_[kt][g] = *(const f32x4*)(ib + EL + (32 * kt + 8 * g + 4 * hi) * 4); } \
          __builtin_amdgcn_sched_barrier(0); \
          _Pragma("unroll") for (int kt = 0; kt < 4; ++kt) { \
            _Pragma("unroll") for (int g = 0; g < 4; ++g) { S[kt][4 * g + 0] *= el_[kt][g][0]; S[kt][4 * g + 1] *= el_[kt][g][1]; S[kt][4 * g + 2] *= el_[kt][g][2]; S[kt][4 * g + 3] *= el_[kt][g][3]; } \
            _Pragma("unroll") for (int ks = 0; ks < 2; ++ks) S[kt] = __builtin_amdgcn_mfma_f32_32x32x16_bf16(ka_[kt][ks], vb_[ks], S[kt], 0, 0, 0); } } } while (0)
#define GLA_BAR() do { asm volatile("s_waitcnt lgkmcnt(0)" ::: "memory"); __builtin_amdgcn_s_barrier(); asm volatile("" ::: "memory"); } while (0)
    if (scan) {
        if (s0) { const unsigned sl = (unsigned)((4 * hi) * HI + 32 * vq + r32) * 4u;
#pragma unroll
            for (int kt = 0; kt < 4; ++kt)
#pragma unroll
                for (int r = 0; r < 16; ++r) S[kt][r] = *(const float*)((const char*)s0 + sl + (unsigned)((32 * kt + (r & 3) + 8 * (r >> 2)) * HI * 4));
        } else {
#pragma unroll
            for (int kt = 0; kt < 4; ++kt) S[kt] = f32x16{};
        }
        GLA_BAR();
#pragma unroll
        for (int g = 0; g < 4; ++g) gnr[g] = *(const f32x4*)(gonL + 32 * vq + 8 * g + 4 * hi);
#pragma unroll 1
        for (int c = 0; c < nch; ++c) {
            const int par = c & 1;
            GLA_BAR();
            if (c > 0) GLA_FINAL(c - 1, par ^ 1);
            GLA_GSLOAD(c);
            GLA_SCAN(par);
        }
        GLA_BAR();
        GLA_FINAL(nch - 1, (nch - 1) & 1);
        const int le = lau_v(lane); const unsigned sl = (unsigned)((4 * (le >> 5)) * HI + 32 * vq + (le & 31)) * 4u;
#pragma unroll
        for (int kt = 0; kt < 4; ++kt)
#pragma unroll
            for (int r = 0; r < 16; ++r) *(float*)((char*)sout + sl + (unsigned)((32 * kt + (r & 3) + 8 * (r >> 2)) * HI * 4)) = S[kt][r];
    } else {
        unsigned fA[8], fB[8]; unsigned qvA[8], vvA[8], qvB[8], vvB[8];
        if (tq < 2) { const int lg = lau_v(lane); gonL[64 * tq + lg] = lau_s(gon)[64 * tq + lg]; }
        GLA_LOAD(fA, qvA, vvA, 0); if (nch > 1) GLA_LOAD(fB, qvB, vvB, 1);
        GLA_PROD(fA, 0); if (nch > 1) GLA_PROD(fB, 1);
        GLA_BAR();
        GLA_PREP(fA, qvA, vvA, 0); if (nch > 2) GLA_LOAD(fA, qvA, vvA, 2);
#pragma unroll 1
        for (int j = 0; j < nch; j += 2) {
            GLA_BAR();
            if (j + 1 < nch) GLA_PREP(fB, qvB, vvB, 1);
            if (j + 3 < nch) GLA_LOAD(fB, qvB, vvB, j + 3);
            if (j + 2 < nch) GLA_PROD(fA, j + 2);
            if (j + 1 < nch) {
                GLA_BAR();
                if (j + 2 < nch) GLA_PREP(fA, qvA, vvA, 0);
                if (j + 4 < nch) GLA_LOAD(fA, qvA, vvA, j + 4);
                if (j + 3 < nch) GLA_PROD(fB, j + 3);
            }
        }
        GLA_BAR();
    }
    __syncthreads();
#undef GLA_BAR
#undef GLA_LOAD
#undef GLA_PREP
#undef GLA_PROD
#undef GLA_FINAL
#undef GLA_GSLOAD
#undef GLA_SCAN
#undef GLA_FR2
}
#undef GLA_PK
}

__device__ __forceinline__ void gla_phase(const Frame& F, KArgs* A_, int li) {
    const int lane = lau_v(lane_id()); unsigned char* ws = lau_s(A_->ws); float* out = lau_s(A_->out);
    const float* gon = as_global(A_->in[I_GONORM]) + (size_t)li * HI;
    const int bx = (int)blockIdx.x, G = F.G, nit = BATCH * CHD + DECB * CHD;
    for (int k = 0;; ++k) {
        int item;
        if (G == 256) { if (bx < 128) { if (k > 0) break; item = bx; } else { if (k >= 4) break; item = 128 + (bx - 128) + 128 * k; } }
        else { item = bx + k * G; if (item >= nit) break; }
        const bool prompt = item < BATCH * CHD; const int it2 = prompt ? item : item - BATCH * CHD, sq = it2 >> 4, h = it2 & 15;
        if (prompt) gla::run(ws, nullptr, out + O_HGP + ((((size_t)li * BATCH + sq) * CHD + h) * HF) * HI, gon, sq * SEQ, h, SEQ / 32, (char*)F.lds, F.wave, lane);
        else gla::run(ws, as_global(A_->in[I_SHGRN]) + ((((size_t)li * DECB + sq) * CHD + h) * HF) * HI, out + O_HGS + ((((size_t)li * DECB + sq) * CHD + h) * HF) * HI, gon, MP + sq * DECS, h, DECS / 32, (char*)F.lds, F.wave, lane);
    }
}
__global__ void __launch_bounds__(NWAVES * 64, 2) mk_fwd(Args args) {
    extern __shared__ __attribute__((aligned(16))) unsigned char lds[];
    Frame F;
    F.lds = (LAS unsigned char*)lds;
    F.MISC = (volatile LAS unsigned*)(F.lds + MISC_OFF);
    F.wave = __builtin_amdgcn_readfirstlane((int)threadIdx.x >> 6);
    F.G = gridDim.x; { const int bx = blockIdx.x; F.vcu = (F.G % 8 == 0) ? (bx % 8) * (F.G / 8) + bx / 8 : bx; }
    F.ctl = (unsigned*)(args.ws + WS_CTL); F.ctlf = (float*)(args.ws + WS_CTL);
    if (threadIdx.x < 64) ((LAS unsigned*)(F.lds + MISC_OFF))[threadIdx.x] = 0u;
    __syncthreads();
    XcdBarrier bar = xcd_barrier_post(F.ctl + CW_BAR, F.MISC + 8);
#define RUN() (true)
#define SEAM() xcd_barrier(bar)

    if (RUN()) p0_prologue(F, kargs());
    SEAM();

    for (int layer = 0; layer < DEPTH; ++layer) {
        asm volatile("" : "+s"(F.lds), "+s"(F.MISC), "+s"(F.ctl), "+s"(F.ctlf), "+s"(F.wave), "+s"(F.vcu), "+s"(F.G), "+s"(bar.bar), "+s"(bar.x), "+s"(bar.st));
        const int bx = lau_si((int)blockIdx.x);
        const int li = layer >> 1;
        if ((layer & 1) == 0) {
            if (RUN()) {
                unsigned char* ws = lau_s(kargs()->ws);
                pg8::Gemm g{(const bf16_t*)(ws + WS_XB), (const bf16_t*)(ws + WS_WINA) + (size_t)li * INA_PAD * DM, DM, DM, DM};
                pg8::StaticOrder S; S.init(MT / 256, INA_PAD / 256, F.G, bx, DM, DM);
                EpiInA E{ws, as_global(kargs()->out), li, F.lds};
                pg8::gemm_phase<EpiInA, pg8::StaticOrder>(F.lds, g, S, E, F.wave);
                { const unsigned job = layer == 0 ? CJ_INA0 : CJ_INA2;
                    if (F.G == 256) { if (bx >= 136) conv_run(F, kargs(), job, (bx - 136) * NWAVES + F.wave, 120 * NWAVES); }
                    else conv_run(F, kargs(), job, bx * NWAVES + F.wave, F.G * NWAVES); }
            }
            SEAM();
            if (RUN()) {
                post_a_phase(F, kargs(), li); pool_prep_phase(F, kargs(), li);
                __syncthreads();
                unsigned char* ws = lau_s(kargs()->ws);
                pg8::Gemm g{(const bf16_t*)(ws + WS_CQB), (const bf16_t*)(ws + WS_WQB) + (size_t)li * 1536 * QR, QR, QR, QR};
                pg8::StaticOrder S; S.init(MT / 256, 1536 / 256, F.G, bx, QR, QR);
                EpiQ E{ws, li, F.lds};
                pg8::gemm_phase<EpiQ, pg8::StaticOrder>(F.lds, g, S, E, F.wave);
            }
            SEAM();
            if (RUN()) {
                unsigned char* ws = lau_s(kargs()->ws);
                { pg8::Gemm g{(const bf16_t*)(ws + WS_KVN), (const bf16_t*)(ws + WS_WKV) + (size_t)li * 2048 * KVR, KVW, KVR, KVR};
                  pg8::StaticOrder S; S.init(MP / 256, 2048 / 256, F.G, bx, KVW, KVR);
                  EpiStore<0> E{ws}; pg8::gemm_phase<EpiStore<0>, pg8::StaticOrder>(F.lds, g, S, E, F.wave); }
                { pg8::Gemm g{(const bf16_t*)(ws + WS_QNS), (const bf16_t*)(ws + WS_WUKBD) + (size_t)li * 4096 * 128, 1024, 128, 128};
                  pg8::HeadOrder S; S.init(MS / 256, 4096 / 256, F.G, (bx + 128) % F.G, 1024, 128, 128);
                  EpiStore<1> E{ws}; pg8::gemm_phase<EpiStore<1>, pg8::HeadOrder>(F.lds, g, S, E, F.wave); }
                { pg8::Gemm g{(const bf16_t*)(ws + WS_PB), (const bf16_t*)(ws + WS_WPOOL) + (size_t)li * 1024 * 256, POOLW, 256, 256};
                  pg8::GroupOrder S; S.init(MT / 256, 4, F.G, bx, POOLW, 256, 256);
                  EpiStore<2> E{ws}; pg8::gemm_phase<EpiStore<2>, pg8::GroupOrder>(F.lds, g, S, E, F.wave); }
            }
            SEAM();
            if (RUN()) { attn_sample_phase(F, kargs(), li); __syncthreads(); attn_prompt_phase(F, kargs(), 0); }
            SEAM();
        } else {
            if (RUN()) {
                unsigned char* ws = lau_s(kargs()->ws);
                pg8::Gemm g{(const bf16_t*)(ws + WS_XB), (const bf16_t*)(ws + WS_WINC) + (size_t)li * INC * DM, DM, DM, DM};
                pg8::StaticOrder S; S.init(MT / 256, INC / 256, F.G, bx, DM, DM);
                EpiInC E{ws, layer, F.lds}; pg8::gemm_phase<EpiInC, pg8::StaticOrder>(F.lds, g, S, E, F.wave);
            }
            SEAM();
            if (RUN()) { gla_phase(F, kargs(), li);
                { const unsigned job = layer == 1 ? CJ_GLA1 : CJ_GLA3;
                    if (F.G == 256) { if ((int)blockIdx.x >= 128) conv_run(F, kargs(), job, ((int)blockIdx.x - 128) * NWAVES + F.wave, 128 * NWAVES); }
                    else conv_run(F, kargs(), job, (int)blockIdx.x * NWAVES + F.wave, F.G * NWAVES); } }
            SEAM();
        }
        if (RUN()) {
            unsigned char* ws = lau_s(kargs()->ws);
            const bf16_t* W = (layer & 1) ? (const bf16_t*)(ws + WS_WOUTC) + (size_t)li * DM * DM : (const bf16_t*)(ws + WS_WOUTA) + (size_t)li * DM * DM;
            pg8::Gemm g{(const bf16_t*)(ws + WS_YCAT), W, DM, DM, DM};
            pg8::StaticOrder S; S.init(MT / 192, DM / 256, F.G, bx, DM, DM, 192);
            EpiRes<3> E{ws, as_global(kargs()->in[I_XP]), as_global(kargs()->in[I_XS]), layer == 0 ? 1 : 0, 2 * layer + 1}; pg8::gemm_phase<EpiRes<3>, pg8::StaticOrder, true, true, 3>(F.lds, g, S, E, F.wave);
        }
        SEAM();
        if (RUN()) rstd_phase(F, kargs(), 2 * layer + 1);
        SEAM();
        if (RUN()) {
            unsigned char* ws = lau_s(kargs()->ws);
            pg8::Gemm g{(const bf16_t*)(ws + WS_XB), (const bf16_t*)(ws + WS_WUP) + (size_t)layer * DFF2 * DM, DM, DM, DM};
            pg8::StaticOrder S; S.init(MT / 256, DFF2 / 256, F.G, bx, DM, DM);
            EpiUp E{ws, as_global(kargs()->out), as_global(kargs()->in[I_CONVW]) + (size_t)layer * 3 * DFF2, as_global(kargs()->in[I_CONVB]) + (size_t)layer * DFF2, as_global(kargs()->in[I_SCONV]) + (size_t)layer * DECB * 2 * DFF2, F.lds, layer}; pg8::gemm_phase<EpiUp, pg8::StaticOrder>(F.lds, g, S, E, F.wave);
            if (layer < 3) { const unsigned job = layer == 0 ? CJ_UP0 : layer == 1 ? CJ_UP1 : CJ_UP2;
                if (F.G == 256) { if (bx >= 96) conv_run(F, kargs(), job, (bx - 96) * NWAVES + F.wave, 160 * NWAVES); }
                else conv_run(F, kargs(), job, bx * NWAVES + F.wave, F.G * NWAVES); }
        }
        SEAM();
        if (RUN()) act_fix_phase(F, kargs(), layer);
        SEAM();
        if (RUN()) {
            unsigned char* ws = lau_s(kargs()->ws);
            pg8::Gemm g{(const bf16_t*)(ws + WS_ACT), (const bf16_t*)(ws + WS_WDOWN) + (size_t)layer * DM * DFF, DFF, DFF, DFF};
            pg8::StaticOrder S; S.init(MT / 192, DM / 256, F.G, bx, DFF, DFF, 192);
            EpiRes<3> E{ws, as_global(kargs()->in[I_XP]), as_global(kargs()->in[I_XS]), 0, 2 * layer + 2}; pg8::gemm_phase<EpiRes<3>, pg8::StaticOrder, true, true, 3>(F.lds, g, S, E, F.wave);
        }
        SEAM();
        if (layer + 1 < DEPTH) {
            if (RUN()) rstd_phase(F, kargs(), 2 * layer + 2);
            SEAM(); }
    }
    if (RUN()) final_phase(F, kargs());
#undef RUN
#undef SEAM
}

extern "C" void kernel_launch(void* const* d_in, const int* in_sizes, int n_in, void* d_out, int out_size, void* d_ws, size_t ws_size, hipStream_t stream) {
    static int grid = 0;
    if (grid == 0) {
        if (n_in != N_IN || (size_t)out_size != O_END || ws_size < WS_END) { fprintf(stderr, "kernel_launch: shape mismatch (n_in %d out %d ws %zu, need %d %zu %zu)\n", n_in, out_size, ws_size, (int)N_IN, (size_t)O_END, (size_t)WS_END); grid = -1; return; }
        int dev = 0, cus = 0, per_cu = 0;
        if (hipGetDevice(&dev) != hipSuccess || hipDeviceGetAttribute(&cus, hipDeviceAttributeMultiprocessorCount, dev) != hipSuccess) { grid = -1; return; }
        if (hipFuncSetAttribute((const void*)mk_fwd, hipFuncAttributeMaxDynamicSharedMemorySize, LDS_BYTES) != hipSuccess) { fprintf(stderr, "kernel_launch: hipFuncSetAttribute failed\n"); grid = -1; return; }
        if (hipOccupancyMaxActiveBlocksPerMultiprocessor(&per_cu, (const void*)mk_fwd, NWAVES * 64, LDS_BYTES) != hipSuccess || per_cu < 1) { fprintf(stderr, "kernel_launch: occupancy query reports %d\n", per_cu); }
        (void)hipGetLastError();
        grid = cus;
    }
    if (grid < 0) return;
    (void)hipMemsetAsync((char*)d_ws + WS_CTL, 0, CTL_BYTES, stream);
    Args a{};
    for (int i = 0; i < N_IN; ++i) a.in[i] = (const float*)d_in[i];
    a.out = (float*)d_out; a.ws = (unsigned char*)d_ws; a.ph_lo = 0; a.ph_hi = 1000;
    hipLaunchKernelGGL(mk_fwd, dim3(grid), dim3(NWAVES * 64), LDS_BYTES, stream, a);
    const hipError_t le = hipPeekAtLastError();
    if (le != hipSuccess) fprintf(stderr, "kernel_launch: launch failed: %s\n", hipGetErrorName(le));
}
```
